# Optimizing an MI355X kernel written in HIP

```python
import jax, jax.numpy as jnp
from jax import lax
import numpy as np

D_MODEL = 1024
BATCH = 8
SEQ = 8192
DEPTH = 4

CTX_LEN = 256
GRID_W = 64
N_MIX = 2
EPS = 1e-6

MLA_HEADS = 8
MLA_Q_LORA = 256
MLA_KV_LORA = 128
MLA_NOPE = 128
MLA_ROPE = 64
MLA_V = 128
MLA_QK = MLA_NOPE + MLA_ROPE
ROPE_BASE = 10000.0
Q_BLOCK = 128

RG_WIDTH = D_MODEL
RG_BLOCKS = 4
RG_BLOCK = RG_WIDTH // RG_BLOCKS
RG_CONV = 4
RG_CONV_LEFT = 2
RG_C = 8.0

FFN_HIDDEN = 2816
N_EXPERTS = 8
TOP_K = 2
EXPERT_HIDDEN = 3584

kernel_name = 'hybrid_mla_rglru_moe_dit'


def rms_norm(x, g):
    xf = x.astype(jnp.float32)
    y = xf * lax.rsqrt(jnp.mean(xf * xf, axis=-1, keepdims=True) + EPS)
    return (y * g.astype(jnp.float32)).astype(x.dtype)


def modulate(h, shift, scale):
    return h * (1 + scale) + shift


def ada_mod(cvec, w, b):
    return jnp.split(jax.nn.silu(cvec) @ w + b, 6, axis=-1)


def axial_rope(n_tok):
    rows = n_tok // GRID_W
    row = jnp.repeat(jnp.arange(rows, dtype=jnp.float32), GRID_W)
    col = jnp.tile(jnp.arange(GRID_W, dtype=jnp.float32), rows)
    n_freq = MLA_ROPE // 4
    inv = ROPE_BASE ** (-jnp.arange(n_freq, dtype=jnp.float32) / n_freq)
    ang = jnp.concatenate([row[:, None] * inv, col[:, None] * inv], axis=-1)
    return jnp.cos(ang), jnp.sin(ang)


def apply_rope(x, cos, sin):
    half = MLA_ROPE // 2
    c = cos[None, :, None, :].astype(x.dtype)
    s = sin[None, :, None, :].astype(x.dtype)
    x1, x2 = x[..., :half], x[..., half:]
    return jnp.concatenate([x1 * c - x2 * s, x2 * c + x1 * s], axis=-1)


def mla_q(h, w_dq, g_q, w_uq, g_qn, rope):
    b, n, _ = h.shape
    q = (rms_norm(h @ w_dq, g_q) @ w_uq).reshape(b, n, MLA_HEADS, MLA_QK)
    q = rms_norm(q, g_qn)
    if rope is not None:
        q = jnp.concatenate([q[..., :MLA_NOPE], apply_rope(q[..., MLA_NOPE:], *rope)], axis=-1)
    return q


def mla_kv(h, w_dkv, g_kv, w_ukv, g_kn, rope):
    b, n, _ = h.shape
    kv_a = h @ w_dkv
    c_kv = rms_norm(kv_a[..., :MLA_KV_LORA], g_kv)
    k_pe = kv_a[..., MLA_KV_LORA:]
    kv = (c_kv @ w_ukv).reshape(b, n, MLA_HEADS, MLA_NOPE + MLA_V)
    k = jnp.concatenate([kv[..., :MLA_NOPE],
                         jnp.broadcast_to(k_pe[:, :, None, :], (b, n, MLA_HEADS, MLA_ROPE))], axis=-1)
    k = rms_norm(k, g_kn)
    if rope is not None:
        k = jnp.concatenate([k[..., :MLA_NOPE], apply_rope(k[..., MLA_NOPE:], *rope)], axis=-1)
    return k, kv[..., MLA_NOPE:]


def attend(q, k, v):
    s = jnp.einsum('bqhd,bkhd->bhqk', q, k, preferred_element_type=jnp.float32) * (MLA_QK ** -0.5)
    p = jax.nn.softmax(s, axis=-1).astype(v.dtype)
    return jnp.einsum('bhqk,bkhd->bqhd', p, v)


def mla_mixer(hl, hc, w_dq, g_q, w_uq, w_dkv, g_kv, w_ukv, g_qn, g_kn, w_o, need_ctx):
    b, n, _ = hl.shape
    rope = axial_rope(n)
    ql = mla_q(hl, w_dq, g_q, w_uq, g_qn, rope)
    kl, vl = mla_kv(hl, w_dkv, g_kv, w_ukv, g_kn, rope)
    kc, vc = mla_kv(hc, w_dkv, g_kv, w_ukv, g_kn, None)
    k_all = jnp.concatenate([kl, kc], axis=1)
    v_all = jnp.concatenate([vl, vc], axis=1)
    nb = n // Q_BLOCK
    qb = ql.reshape(b, nb, Q_BLOCK, MLA_HEADS, MLA_QK).swapaxes(0, 1)
    ol = lax.map(lambda qi: attend(qi, k_all, v_all), qb)
    ol = ol.swapaxes(0, 1).reshape(b, n, MLA_HEADS * MLA_V) @ w_o
    oc = None
    if need_ctx:
        qc = mla_q(hc, w_dq, g_q, w_uq, g_qn, None)
        oc = attend(qc, kc, vc).reshape(b, hc.shape[1], MLA_HEADS * MLA_V) @ w_o
    return ol, oc


def centred_conv(u, w, b):
    n = u.shape[1]
    up = jnp.pad(u, ((0, 0), (RG_CONV_LEFT, RG_CONV - 1 - RG_CONV_LEFT), (0, 0)))
    out = b
    for k in range(RG_CONV):
        out = out + up[:, k:k + n] * w[k]
    return out


def block_diag(u, w, b):
    ub = u.reshape(u.shape[:-1] + (RG_BLOCKS, RG_BLOCK))
    return jnp.einsum('bnhi,hij->bnhj', ub, w).reshape(u.shape) + b


def rg_coeffs(u, w_a, b_a, w_x, b_x, lam):
    f32 = jnp.float32
    uf = u.astype(f32)
    r = jax.nn.sigmoid(block_diag(uf, w_a.astype(f32), b_a.astype(f32)))
    i = jax.nn.sigmoid(block_diag(uf, w_x.astype(f32), b_x.astype(f32)))
    log_a = -RG_C * r * jax.nn.softplus(-lam.astype(f32))
    return jnp.exp(log_a), jnp.sqrt(-jnp.expm1(2.0 * log_a)) * (i * uf)


def affine_combine(left, right):
    a1, b1 = left
    a2, b2 = right
    return a1 * a2, a2 * b1 + b2


def linear_scan(a, b, h0, reverse):
    if reverse:
        a, b = jnp.flip(a, 1), jnp.flip(b, 1)
    b = b.at[:, 0].add(a[:, 0] * h0)
    _, h = lax.associative_scan(affine_combine, (a, b), axis=1)
    return jnp.flip(h, 1) if reverse else h


def rg_direction(uc, ul, w_a, b_a, w_x, b_x, lam, reverse):
    ac, bc = rg_coeffs(uc, w_a, b_a, w_x, b_x, lam)
    hc = linear_scan(ac, bc, jnp.zeros((uc.shape[0], RG_WIDTH), jnp.float32), reverse)
    h_end = hc[:, 0] if reverse else hc[:, -1]
    al, bl = rg_coeffs(ul, w_a, b_a, w_x, b_x, lam)
    return hc, linear_scan(al, bl, h_end, reverse)


def rglru_mixer(hl, hc, w_in, w_gate, conv_w, conv_b, w_a, b_a, w_x, b_x, lam, w_out, need_ctx):
    ul = centred_conv(hl @ w_in, conv_w, conv_b)
    uc = centred_conv(hc @ w_in, conv_w, conv_b)
    hc_f, hl_f = rg_direction(uc, ul, w_a[0], b_a[0], w_x[0], b_x[0], lam[0], False)
    hc_b, hl_b = rg_direction(uc, ul, w_a[1], b_a[1], w_x[1], b_x[1], lam[1], True)
    ol = ((hl_f + hl_b).astype(hl.dtype) * jax.nn.gelu(hl @ w_gate)) @ w_out
    oc = None
    if need_ctx:
        oc = ((hc_f + hc_b).astype(hc.dtype) * jax.nn.gelu(hc @ w_gate)) @ w_out
    return ol, oc


def swiglu(h, w1, w3, w2):
    return (jax.nn.silu(h @ w1) * (h @ w3)) @ w2


def moe_swiglu(h, w_router, w1, w3, w2):
    logits = jnp.einsum('bnd,de->bne', h, w_router, preferred_element_type=jnp.float32)
    top_val, top_idx = lax.top_k(logits, TOP_K)
    gates = jax.nn.softmax(top_val, axis=-1)
    combine = jnp.einsum('bnk,bnke->bne', gates,
                         jax.nn.one_hot(top_idx, N_EXPERTS, dtype=jnp.float32)).astype(h.dtype)
    out = jnp.zeros_like(h)
    for e in range(N_EXPERTS):
        out = out + combine[..., e:e + 1] * swiglu(h, w1[e], w3[e], w2[e])
    return out


def setup_inputs(seed: int = 0) -> dict:
    key = jax.random.key(seed)
    ks = iter(jax.random.split(key, 40))
    f32 = jnp.float32
    n_a = (DEPTH + 1) // 2
    n_r = DEPTH // 2

    def nrm(shape, fan_in, gain=1.0):
        return gain * fan_in ** -0.5 * jax.random.normal(next(ks), shape, f32)

    def gain_vec(shape):
        return 1.0 + 0.05 * jax.random.normal(next(ks), shape, f32)

    def small(shape):
        return 0.02 * jax.random.normal(next(ks), shape, f32)

    x = jax.random.normal(next(ks), (BATCH, SEQ, D_MODEL), f32)
    c = jax.random.normal(next(ks), (BATCH, D_MODEL), f32)
    ctx = jax.random.normal(next(ks), (BATCH, CTX_LEN, D_MODEL), f32)
    c_ctx = jax.random.normal(next(ks), (D_MODEL,), f32)
    ada_w = nrm((DEPTH, D_MODEL, 6 * D_MODEL), D_MODEL, 0.5)
    ada_b = small((DEPTH, 6 * D_MODEL))
    norm1_g = gain_vec((DEPTH, D_MODEL))
    norm2_g = gain_vec((DEPTH, D_MODEL))
    mla_w_dq = nrm((n_a, D_MODEL, MLA_Q_LORA), D_MODEL)
    mla_g_q = gain_vec((n_a, MLA_Q_LORA))
    mla_w_uq = nrm((n_a, MLA_Q_LORA, MLA_HEADS * MLA_QK), MLA_Q_LORA)
    mla_w_dkv = nrm((n_a, D_MODEL, MLA_KV_LORA + MLA_ROPE), D_MODEL)
    mla_g_kv = gain_vec((n_a, MLA_KV_LORA))
    mla_w_ukv = nrm((n_a, MLA_KV_LORA, MLA_HEADS * (MLA_NOPE + MLA_V)), MLA_KV_LORA)
    mla_g_qn = gain_vec((n_a, MLA_QK))
    mla_g_kn = gain_vec((n_a, MLA_QK))
    mla_w_o = nrm((n_a, MLA_HEADS * MLA_V, D_MODEL), MLA_HEADS * MLA_V)
    rg_w_in = nrm((n_r, D_MODEL, RG_WIDTH), D_MODEL)
    rg_w_gate = nrm((n_r, D_MODEL, RG_WIDTH), D_MODEL)
    rg_conv_w = nrm((n_r, RG_CONV, RG_WIDTH), RG_CONV)
    rg_conv_b = small((n_r, RG_WIDTH))
    rg_w_a = nrm((n_r, 2, RG_BLOCKS, RG_BLOCK, RG_BLOCK), RG_BLOCK)
    rg_b_a = small((n_r, 2, RG_WIDTH))
    rg_w_x = nrm((n_r, 2, RG_BLOCKS, RG_BLOCK, RG_BLOCK), RG_BLOCK)
    rg_b_x = small((n_r, 2, RG_WIDTH))
    a0 = jax.random.uniform(next(ks), (n_r, 2, RG_WIDTH), f32, 0.9, 0.999)
    rg_lam = jnp.log(a0) - jnp.log1p(-a0)
    rg_w_out = nrm((n_r, RG_WIDTH, D_MODEL), RG_WIDTH)
    ffn_w1 = nrm((n_a, D_MODEL, FFN_HIDDEN), D_MODEL)
    ffn_w3 = nrm((n_a, D_MODEL, FFN_HIDDEN), D_MODEL)
    ffn_w2 = nrm((n_a, FFN_HIDDEN, D_MODEL), FFN_HIDDEN)
    moe_w_router = nrm((n_r, D_MODEL, N_EXPERTS), D_MODEL)
    moe_w1 = nrm((n_r, N_EXPERTS, D_MODEL, EXPERT_HIDDEN), D_MODEL)
    moe_w3 = nrm((n_r, N_EXPERTS, D_MODEL, EXPERT_HIDDEN), D_MODEL)
    moe_w2 = nrm((n_r, N_EXPERTS, EXPERT_HIDDEN, D_MODEL), EXPERT_HIDDEN)
    return {'x': x, 'c': c, 'ctx': ctx, 'c_ctx': c_ctx,
            'ada_w': ada_w, 'ada_b': ada_b, 'norm1_g': norm1_g, 'norm2_g': norm2_g,
            'mla_w_dq': mla_w_dq, 'mla_g_q': mla_g_q, 'mla_w_uq': mla_w_uq, 'mla_w_dkv': mla_w_dkv,
            'mla_g_kv': mla_g_kv, 'mla_w_ukv': mla_w_ukv, 'mla_g_qn': mla_g_qn, 'mla_g_kn': mla_g_kn,
            'mla_w_o': mla_w_o,
            'rg_w_in': rg_w_in, 'rg_w_gate': rg_w_gate, 'rg_conv_w': rg_conv_w, 'rg_conv_b': rg_conv_b,
            'rg_w_a': rg_w_a, 'rg_b_a': rg_b_a, 'rg_w_x': rg_w_x, 'rg_b_x': rg_b_x, 'rg_lam': rg_lam,
            'rg_w_out': rg_w_out,
            'ffn_w1': ffn_w1, 'ffn_w3': ffn_w3, 'ffn_w2': ffn_w2,
            'moe_w_router': moe_w_router, 'moe_w1': moe_w1, 'moe_w3': moe_w3, 'moe_w2': moe_w2}


def reference(x, c, ctx, c_ctx, ada_w, ada_b, norm1_g, norm2_g,
              mla_w_dq, mla_g_q, mla_w_uq, mla_w_dkv, mla_g_kv, mla_w_ukv, mla_g_qn, mla_g_kn, mla_w_o,
              rg_w_in, rg_w_gate, rg_conv_w, rg_conv_b, rg_w_a, rg_b_a, rg_w_x, rg_b_x, rg_lam, rg_w_out,
              ffn_w1, ffn_w3, ffn_w2, moe_w_router, moe_w1, moe_w3, moe_w2):
    for i in range(DEPTH):
        need_ctx = i < DEPTH - 1
        j = i // N_MIX
        sh1_l, sc1_l, g1_l, sh2_l, sc2_l, g2_l = [m[:, None, :] for m in ada_mod(c, ada_w[i], ada_b[i])]
        sh1_c, sc1_c, g1_c, sh2_c, sc2_c, g2_c = ada_mod(c_ctx, ada_w[i], ada_b[i])

        hl = modulate(rms_norm(x, norm1_g[i]), sh1_l, sc1_l)
        hc = modulate(rms_norm(ctx, norm1_g[i]), sh1_c, sc1_c)
        if i % N_MIX == 0:
            ol, oc = mla_mixer(hl, hc, mla_w_dq[j], mla_g_q[j], mla_w_uq[j], mla_w_dkv[j], mla_g_kv[j],
                               mla_w_ukv[j], mla_g_qn[j], mla_g_kn[j], mla_w_o[j], need_ctx)
        else:
            ol, oc = rglru_mixer(hl, hc, rg_w_in[j], rg_w_gate[j], rg_conv_w[j], rg_conv_b[j],
                                 rg_w_a[j], rg_b_a[j], rg_w_x[j], rg_b_x[j], rg_lam[j], rg_w_out[j], need_ctx)
        x = x + g1_l * ol

        if i % 2 == 0:
            ffn = lambda h: swiglu(h, ffn_w1[j], ffn_w3[j], ffn_w2[j])
        else:
            ffn = lambda h: moe_swiglu(h, moe_w_router[j], moe_w1[j], moe_w3[j], moe_w2[j])
        x = x + g2_l * ffn(modulate(rms_norm(x, norm2_g[i]), sh2_l, sc2_l))

        if need_ctx:
            ctx = ctx + g1_c * oc
            ctx = ctx + g2_c * ffn(modulate(rms_norm(ctx, norm2_g[i]), sh2_c, sc2_c))
    return x
```

```cpp
#include <hip/hip_runtime.h>
#include <cstdio>
#include <cstdint>

#define GAS __attribute__((address_space(1)))
#define LAS __attribute__((address_space(3)))
typedef unsigned short bf16;
typedef short bf16x8 __attribute__((ext_vector_type(8)));
typedef short s16x4 __attribute__((ext_vector_type(4)));
typedef float f32x2 __attribute__((ext_vector_type(2)));
typedef float f32x4 __attribute__((ext_vector_type(4)));
typedef float f32x16 __attribute__((ext_vector_type(16)));
typedef unsigned u32x2 __attribute__((ext_vector_type(2)));
typedef unsigned u32x4 __attribute__((ext_vector_type(4)));

constexpr int D = 1024, NB = 8, SEQ = 8192, CTXL = 256;
constexpr int TL = NB * SEQ, TC = NB * CTXL, T = TL + TC;
constexpr int NH = 8, QLORA = 256, KVLORA = 128, ROPE = 64, NOPE = 128, VD = 128, QK = 192;
constexpr int FF = 2816, NE = 8, EH = 3584;
constexpr float EPS = 1e-6f;
constexpr int NWAVES = 8, NTHR = 512;

constexpr size_t MiB = 1u << 20;
constexpr size_t WS_CTL = 0, CTL_BYTES = 1 * MiB;
constexpr size_t WS_MOD = 1 * MiB;
constexpr size_t WS_XC = 2 * MiB;
constexpr size_t WS_AGG = 10 * MiB;
constexpr size_t WS_ROUTE = 15 * MiB;
constexpr size_t WS_ROPE = 18 * MiB;
static_assert(WS_AGG + (size_t)264 * 2 * 1024 * 2 * 4 <= 14 * MiB + 512 * 1024 && WS_ROPE + (size_t)8192 * 64 * 4 <= 20 * MiB, "ws map");
constexpr size_t WS_SPT = 14 * MiB + 512 * 1024;
constexpr size_t WS_WSM = 20 * MiB;
constexpr size_t WS_WMOE = 84 * MiB;
constexpr size_t WS_H = 252 * MiB;
constexpr size_t WS_ARENA = 384 * MiB;
constexpr size_t WS_END = 384 * MiB + 600 * MiB;
constexpr size_t W_MLA = 0;
constexpr size_t W_MLA_1 = 0, W_MLA_CAT = 512 * 1024, W_MLA_O = W_MLA_CAT + 3584 * 256, W_MLA_SZ = W_MLA_O + 1024 * 1024;
constexpr size_t W_RG = 2 * W_MLA_SZ;
constexpr size_t W_RG_IG = 0, W_RG_AX = 2048 * 1024, W_RG_OUT = W_RG_AX + 16 * 256 * 256, W_RG_SZ = W_RG_OUT + 1024 * 1024;
constexpr size_t W_FFN = W_RG + 2 * W_RG_SZ;
constexpr size_t W_FFN_13 = 0, W_FFN_2 = (size_t)5632 * 1024, W_FFN_SZ = W_FFN_2 + (size_t)1024 * 2816;
static_assert((W_FFN + 2 * W_FFN_SZ) * 2 <= 64 * MiB, "small weights fit");
constexpr size_t WM_13 = 0, WM_2 = (size_t)NE * 7168 * 1024, WM_SZ = WM_2 + (size_t)NE * 1024 * 3584;
static_assert(WM_SZ * 2 <= 168 * MiB, "moe weights fit");
static_assert(WS_H + (size_t)T * 1024 * 2 <= WS_ARENA, "H fits");
constexpr size_t AR_QKVA = 0;
constexpr size_t AR_Q = 66 * MiB;
constexpr size_t AR_K = AR_Q + 198 * MiB;
constexpr size_t AR_V = AR_K + 198 * MiB;
static_assert(AR_V + 132 * MiB <= 600 * MiB, "mla arena");
constexpr size_t AR_HID = 0;
static_assert((size_t)(T + 2048) * 3584 * 2 <= 600 * MiB, "moe hid fits");
constexpr size_t AR_UPRE = 0, AR_GATE = 132 * MiB, AR_U = 264 * MiB;
constexpr int MOE_ROWS = T + 2048;
constexpr size_t RT_E = 0, RT_RANK = RT_E + (size_t)T * 2 * 4, RT_G = RT_RANK + (size_t)T * 2 * 4, RT_TOK = RT_G + (size_t)T * 2 * 4, RT_GV = RT_TOK + (size_t)MOE_ROWS * 2 * 4;
static_assert(RT_GV + (size_t)MOE_ROWS * 2 * 4 <= 3 * MiB, "routing fits");
constexpr int CW_BAR = 4096;
constexpr int CW_CNT = 16384;

constexpr int RING_BYTES = 131072;
constexpr int EPI_OFF = RING_BYTES;
constexpr int MISC_OFF = EPI_OFF + 16384;
constexpr int LDS_BYTES = MISC_OFF + 256;

__device__ __forceinline__ int opaque_tid() { int t = threadIdx.x; asm volatile("" : "+v"(t)); return t; }
#define LDS_WAIT() asm volatile("s_waitcnt lgkmcnt(0)" ::: "memory")
#define VM_WAIT() asm volatile("s_waitcnt vmcnt(0)" ::: "memory")
__device__ __forceinline__ float bf2f(unsigned v) { return __uint_as_float(v << 16); }
__device__ __forceinline__ unsigned cvtpk(float lo, float hi) { unsigned r; asm volatile("v_cvt_pk_bf16_f32 %0, %1, %2" : "=v"(r) : "v"(lo), "v"(hi)); return r; }
__device__ __forceinline__ float ex2(float x) { return __builtin_amdgcn_exp2f(x); }
__device__ __forceinline__ float fexp(float x) { return __builtin_amdgcn_exp2f(x * 1.4426950408889634f); }
__device__ __forceinline__ float sigm(float x) { return __builtin_amdgcn_rcpf(1.f + fexp(-x)); }
__device__ __forceinline__ float silu_f(float x) { return x * sigm(x); }
__device__ __forceinline__ float gelu_tanh_f(float x) { return x * sigm(1.5957691216057308f * (x + 0.044715f * x * x * x)); }
__device__ __forceinline__ float wave_sum(float v) {
#pragma unroll
    for (int o = 1; o < 64; o <<= 1) v += __shfl_xor(v, o);
    return v;
}
__device__ __forceinline__ void unpack8(u32x4 w, float (&f)[8]) {
    f[0] = bf2f(w.x & 0xffffu); f[1] = __uint_as_float(w.x & 0xffff0000u); f[2] = bf2f(w.y & 0xffffu); f[3] = __uint_as_float(w.y & 0xffff0000u);
    f[4] = bf2f(w.z & 0xffffu); f[5] = __uint_as_float(w.z & 0xffff0000u); f[6] = bf2f(w.w & 0xffffu); f[7] = __uint_as_float(w.w & 0xffff0000u);
}
__device__ __forceinline__ u32x4 pack8(const float (&f)[8]) { u32x4 w; w.x = cvtpk(f[0], f[1]); w.y = cvtpk(f[2], f[3]); w.z = cvtpk(f[4], f[5]); w.w = cvtpk(f[6], f[7]); return w; }

#define XB_TMO      128
#define XB_XCNT(j)  (256  + 64 * (j))
#define XB_XSUB(j)  (1280 + 64 * (j))
#define XB_XGEN(j)  (2304 + 64 * (j))
#define XB_TOP      3328
#define XB_TOPGEN   3392
#define XCD_BAR_WORDS 3456
#define XB_SPIN_CAP (1u << 21)
__device__ __forceinline__ unsigned xb_ld(unsigned* p)              { return __hip_atomic_load(p, __ATOMIC_RELAXED, __HIP_MEMORY_SCOPE_AGENT); }
__device__ __forceinline__ unsigned xb_add(unsigned* p, unsigned v) { return __hip_atomic_fetch_add(p, v, __ATOMIC_RELAXED, __HIP_MEMORY_SCOPE_AGENT); }
__device__ __forceinline__ unsigned xb_xcc_id() { return (unsigned)__builtin_amdgcn_s_getreg((3 << 11) | 20) & 0xFu; }
#define XB_SPIN(cond, bar) do { unsigned _sp = 0; while (cond) { __builtin_amdgcn_s_sleep(1); \
    if ((++_sp & 255u) == 0u) { if (xb_ld(&(bar)[XB_TMO])) break; if (_sp > XB_SPIN_CAP) { atomicAdd(&(bar)[XB_TMO], 1u); break; } } } } while (0)
struct XcdBarrier { unsigned* bar; unsigned x; volatile LAS unsigned* st; };
__device__ __forceinline__ XcdBarrier xcd_barrier_post(unsigned* bar, volatile LAS unsigned* st) {
    XcdBarrier b; b.bar = bar; b.x = xb_xcc_id(); b.st = st;
    if (threadIdx.x == 0) (void)xb_add(&bar[XB_XCNT(b.x)], 1u);
    return b;
}
__device__ __forceinline__ void xcd_barrier_complete(unsigned* bar, unsigned x, unsigned& nloc, unsigned& nx) {
    const unsigned G = gridDim.x * gridDim.y * gridDim.z;
    unsigned sum, cnt, mine, sp = 0u;
    for (;;) {
        sum = 0u; cnt = 0u; mine = 0u;
#pragma unroll
        for (unsigned j = 0; j < 16; ++j) { const unsigned c = xb_ld(&bar[XB_XCNT(j)]); sum += c; cnt += (c > 0u) ? 1u : 0u; mine = (j == x) ? c : mine; }
        if (sum == G) break;
        __builtin_amdgcn_s_sleep(1);
        if ((++sp & 255u) == 0u) { if (xb_ld(&bar[XB_TMO])) break; if (sp > XB_SPIN_CAP) { atomicAdd(&bar[XB_TMO], 1u); break; } }
    }
    nloc = mine > 0u ? mine : 1u; nx = cnt > 0u ? cnt : 1u;
}
__device__ __forceinline__ void xcd_barrier(const XcdBarrier& b) {
    asm volatile("s_waitcnt vmcnt(0)" ::: "memory");
    __syncthreads();
    if (threadIdx.x == 0) {
        unsigned* bar = b.bar;
        __builtin_amdgcn_s_waitcnt(0);
        unsigned nloc = b.st[0], nx = b.st[1];
        if (nloc == 0u) { xcd_barrier_complete(bar, b.x, nloc, nx); b.st[0] = nloc; b.st[1] = nx; }
        const unsigned old = xb_add(&bar[XB_XSUB(b.x)], 1u);
        const unsigned gen = old / nloc;
        if (old + 1u == (gen + 1u) * nloc) {
            __builtin_amdgcn_fence(__ATOMIC_RELEASE, "agent");
            asm volatile("s_waitcnt vmcnt(0)" ::: "memory");
            const unsigned og = xb_add(&bar[XB_TOP], 1u);
            const unsigned tg = og / nx;
            if (og + 1u == (tg + 1u) * nx) xb_add(&bar[XB_TOPGEN], 1u);
            else XB_SPIN(xb_ld(&bar[XB_TOPGEN]) == tg, bar);
            __builtin_amdgcn_fence(__ATOMIC_ACQUIRE, "agent");
            xb_add(&bar[XB_XGEN(b.x)], 1u);
            asm volatile("s_waitcnt vmcnt(0)" ::: "memory");
        } else {
            XB_SPIN(xb_ld(&bar[XB_XGEN(b.x)]) == gen, bar);
            __builtin_amdgcn_fence(__ATOMIC_ACQUIRE, "agent");
            asm volatile("s_waitcnt vmcnt(0)" ::: "memory");
        }
    }
    __syncthreads();
}

namespace pg8 {
constexpr int BM = 256, BK = 64, HALF = 128, HTB = HALF * BK * 2, STAGE_BYTES = 8 * HTB, NXCD = 8, WGM = 8;
__host__ __device__ __forceinline__ int lds_byte(int r, int c) { const int st = (r >> 4) * 2 + (c >> 5), rr = r & 15, cc = c & 31, ob = rr * 64 + cc * 2; return st * 1024 + (ob ^ (((ob >> 9) & 1) << 5)); }
__host__ __device__ __forceinline__ void stage_rc(int b, int& R, int& C) { const int st = b / 1024, sb = b % 1024, swz = sb ^ (((sb >> 9) & 1) << 5); R = (st >> 1) * 16 + swz / 64; C = (st & 1) * 32 + (swz % 64) / 2; }
__device__ __forceinline__ void tile_of(int L, int nM, int nN, int& pm, int& pn) {
    const int nwg = nM * nN; int wgid = L;
    { const int q = nwg / NXCD, r = nwg % NXCD, xcd = wgid % NXCD, off = wgid / NXCD; wgid = (xcd < r ? xcd * (q + 1) : r * (q + 1) + (xcd - r) * q) + off; }
    const int nig = WGM * nN, gid = wgid / nig, fm = gid * WGM, gsz = (nM - fm) < WGM ? (nM - fm) : WGM;
    pm = fm + ((wgid % nig) % gsz); pn = (wgid % nig) / gsz;
}
struct Unit { const char* A; const char* B; int pm, pn, t; };

template <class Epi, class Sched>
__device__ __forceinline__ void gemm_phase(LAS unsigned char* lds, const int K, const int ldb, const Sched& S, const Epi& E) {
    const int tid = opaque_tid(), wid = __builtin_amdgcn_readfirstlane(tid >> 6), lane = tid & 63, wr = wid >> 2, wc = wid & 3, fr = lane & 15, fq = lane >> 4;
    const int nt = K / BK;
    unsigned voffB[2];
#pragma unroll
    for (int i = 0; i < 2; ++i) { int R, C; stage_rc(tid * 16 + i * 8192, R, C); voffB[i] = (unsigned)(R * ldb + C) * 2u; }
#define PG8_AOFFS(u, o0, o1) do { int _t = tid; asm volatile("" : "+v"(_t)); _Pragma("unroll") for (int _i = 0; _i < 2; ++_i) { int _R, _C; stage_rc(_t * 16 + _i * 8192, _R, _C); \
        o0[_i] = S.aoff(u, _R) + (unsigned)_C * 2u; o1[_i] = S.aoff(u, HALF + _R) + (unsigned)_C * 2u; } } while (0)
    const size_t kstep = (size_t)(BK * 2);
    const size_t hstepB = (size_t)HALF * ldb * 2;
    const unsigned ldsw = (unsigned)wid * 1024u;
    const int aoff = lds_byte(wr * 64 + fr, fq * 8), boff = lds_byte(wc * 32 + fr, fq * 8);
#define PG8_SA(b, h) (((b) * 2 + (h)) * HTB)
#define PG8_SB(b, h) ((4 + (b) * 2 + (h)) * HTB)
#define PG8_STAGE(bufoff, gbase, voff) do { _Pragma("unroll") for (int _i = 0; _i < 2; ++_i) { unsigned _o = (voff)[_i]; asm volatile("" : "+v"(_o));     \
        __builtin_amdgcn_global_load_lds((const unsigned*)((const char*)(gbase) + _o), (LAS unsigned*)(lds + (bufoff) + ldsw + _i * 8192), 16, 0, 0); } } while (0)
#define PG8_LDA(dst, b, h) do { _Pragma("unroll") for (int m = 0; m < 4; ++m) _Pragma("unroll") for (int k = 0; k < 2; ++k) dst[m][k] = *(const LAS bf16x8*)(lds + PG8_SA(b, h) + aoff + m * 2048 + k * 1024); } while (0)
#define PG8_LDB(dst, b, h) do { _Pragma("unroll") for (int n = 0; n < 2; ++n) _Pragma("unroll") for (int k = 0; k < 2; ++k) dst[n][k] = *(const LAS bf16x8*)(lds + PG8_SB(b, h) + boff + n * 2048 + k * 1024); } while (0)
#define PG8_MMA(ai, bj, At, Bt) do { __builtin_amdgcn_s_setprio(1); _Pragma("unroll") for (int m = 0; m < 4; ++m) _Pragma("unroll") for (int n = 0; n < 2; ++n) _Pragma("unroll") for (int k = 0; k < 2; ++k) \
        acc[ai][bj][m][n] = __builtin_amdgcn_mfma_f32_16x16x32_bf16(Bt[n][k], At[m][k], acc[ai][bj][m][n], 0, 0, 0); __builtin_amdgcn_s_setprio(0); } while (0)
#define PG8_WAIT_V(n) asm volatile("s_waitcnt vmcnt(" #n ")" ::: "memory")
#define PG8_WAIT_L(n) asm volatile("s_waitcnt lgkmcnt(" #n ")" ::: "memory")
#define PG8_BAR __builtin_amdgcn_s_barrier()
#define PG8_SCHED __builtin_amdgcn_sched_barrier(0)
    Unit cur, nxt; int ui = 0;
    if (!S.next(0, cur)) return;
    f32x4 acc[2][2][4][2];
    E.init(acc, cur, wr, wc, fr, fq);
    bf16x8 At[4][2], B0[2][2], B1[2][2];
    unsigned vA0[2], vA1[2], nA0[2], nA1[2];
    PG8_AOFFS(cur, vA0, vA1);
    const char* cA = cur.A; const char* cB = cur.B;
    PG8_STAGE(PG8_SB(0, 0), cB, voffB); PG8_STAGE(PG8_SB(0, 1), cB + hstepB, voffB); PG8_STAGE(PG8_SA(0, 0), cA, vA0); PG8_STAGE(PG8_SA(0, 1), cA, vA1);
    if (wr == 1) PG8_BAR;
    PG8_WAIT_V(2); PG8_BAR;
    PG8_STAGE(PG8_SB(1, 0), cB + kstep, voffB); PG8_STAGE(PG8_SA(1, 0), cA + kstep, vA0); PG8_STAGE(PG8_SB(1, 1), cB + hstepB + kstep, voffB);
    PG8_WAIT_V(6); PG8_BAR;
    for (;;) {
        const bool has_next = S.next(ui + 1, nxt);
        if (Sched::UNIT_A && has_next) { PG8_AOFFS(nxt, nA0, nA1); }
        else {
#pragma unroll
            for (int i = 0; i < 2; ++i) { nA0[i] = vA0[i]; nA1[i] = vA1[i]; }
        }
        const char* nA = has_next ? nxt.A : cA; const char* nB = has_next ? nxt.B : cB;
        for (int t = 0; t < nt; t += 2) {
            const bool last = (t == nt - 2);
            const char* a1 = cA + (size_t)(t + 1) * kstep;
            const char* a2 = last ? nA : cA + (size_t)(t + 2) * kstep; const char* b2 = last ? nB : cB + (size_t)(t + 2) * kstep;
            const char* a3 = a2 + kstep; const char* b3 = b2 + kstep;
            unsigned w0[2], w1[2];
#pragma unroll
            for (int i = 0; i < 2; ++i) { w0[i] = last ? nA0[i] : vA0[i]; w1[i] = last ? nA1[i] : vA1[i]; }
            PG8_LDB(B0, 0, 0); PG8_LDB(B1, 0, 1); PG8_SCHED; PG8_LDA(At, 0, 0); PG8_STAGE(PG8_SA(1, 1), a1, vA1);
            PG8_WAIT_V(8); PG8_WAIT_L(0); PG8_BAR; PG8_MMA(0, 0, At, B0); PG8_MMA(0, 1, At, B1); PG8_BAR; PG8_SCHED;
            PG8_LDA(At, 0, 1); PG8_STAGE(PG8_SB(0, 0), b2, voffB); PG8_STAGE(PG8_SB(0, 1), b2 + hstepB, voffB); PG8_STAGE(PG8_SA(0, 0), a2, w0);
            PG8_WAIT_V(8); PG8_WAIT_L(0); PG8_BAR; PG8_MMA(1, 0, At, B0); PG8_MMA(1, 1, At, B1); PG8_BAR; PG8_SCHED;
            PG8_LDB(B0, 1, 0); PG8_LDB(B1, 1, 1); PG8_SCHED; PG8_LDA(At, 1, 0); PG8_STAGE(PG8_SA(0, 1), a2, w1);
            PG8_WAIT_V(8); PG8_WAIT_L(0); PG8_BAR; PG8_MMA(0, 0, At, B0); PG8_MMA(0, 1, At, B1); PG8_BAR; PG8_SCHED;
            PG8_LDA(At, 1, 1); PG8_STAGE(PG8_SB(1, 0), b3, voffB); PG8_STAGE(PG8_SB(1, 1), b3 + hstepB, voffB); PG8_STAGE(PG8_SA(1, 0), a3, w0);
            PG8_WAIT_V(8); PG8_WAIT_L(0); PG8_BAR; PG8_MMA(1, 0, At, B0); PG8_MMA(1, 1, At, B1); PG8_BAR; PG8_SCHED;
        }
        if (wr == 0) PG8_BAR;
        { int l2 = lane; asm volatile("" : "+v"(l2));
          E(acc, cur, wr, wc, l2 & 15, l2 >> 4, l2, wid);
          if (!has_next) break;
          E.init(acc, nxt, wr, wc, l2 & 15, l2 >> 4); }
        cur = nxt; cA = nA; cB = nB; ++ui;
#pragma unroll
        for (int i = 0; i < 2; ++i) { vA0[i] = nA0[i]; vA1[i] = nA1[i]; }
        if (wr == 1) PG8_BAR;
    }
    PG8_WAIT_V(0);
    PG8_BAR;
#undef PG8_AOFFS
#undef PG8_SA
#undef PG8_SB
#undef PG8_STAGE
#undef PG8_LDA
#undef PG8_LDB
#undef PG8_MMA
#undef PG8_WAIT_V
#undef PG8_WAIT_L
#undef PG8_BAR
#undef PG8_SCHED
}
}
using pg8::Unit;

__host__ __device__ __forceinline__ int phys_of_logical(int ll) { return (ll & ~31) | (((ll >> 2) & 1) << 4) | (((ll >> 3) & 3) << 2) | (ll & 3); }
__host__ __device__ __forceinline__ int phys_of_pair(int hl, int n) { return 128 * ((hl >> 2) & 1) + 32 * (hl >> 5) + 16 * n + 4 * ((hl >> 3) & 3) + (hl & 3); }

struct Args { const float* in[34]; float* out; unsigned char* ws; };
struct Frame {
    LAS unsigned char* lds;
    int tid, lane, wave, vcu, G, bx;
};
typedef const Args __attribute__((address_space(4)))* KArgs;
#define ARGS() ({ KArgs _p = (KArgs)__builtin_amdgcn_kernarg_segment_ptr(); asm volatile("" : "+s"(_p)); _p; })
__device__ __forceinline__ int row_vec(int row) { return row < TL ? (row >> 13) : NB; }

struct SchedPlain {
    static constexpr bool UNIT_A = false;
    const char* A; const char* B; int lda2, ldb2, nM, nN, G, c, tsplit;
    __device__ __forceinline__ bool next(int i, Unit& u) const {
        const int L = i * G + c; if (L >= nM * nN) return false;
        pg8::tile_of(L, nM, nN, u.pm, u.pn); u.t = u.pn >= tsplit ? 1 : 0;
        u.A = A + (size_t)u.pm * 256 * lda2; u.B = B + (size_t)u.pn * 256 * ldb2; return true;
    }
    __device__ __forceinline__ unsigned aoff(const Unit&, int r) const { return (unsigned)(r * lda2); }
};
struct SchedA3 {
    static constexpr bool UNIT_A = false;
    const char* A; const char* B; int nM, G, c;
    __device__ __forceinline__ bool next(int i, Unit& u) const {
        const int L = i * G + c; if (L >= nM * 14) return false;
        pg8::tile_of(L, nM, 14, u.pm, u.pn); u.t = u.pn < 6 ? 0 : (u.pn < 10 ? 1 : 2);
        u.A = A + (size_t)u.pm * 256 * 1024 + (u.pn < 6 ? 0 : 512); u.B = B + (size_t)u.pn * 256 * 512; return true;
    }
    __device__ __forceinline__ unsigned aoff(const Unit&, int r) const { return (unsigned)(r * 1024); }
};
__device__ __forceinline__ int scan_pos(int r) { return (((r >> 6) & 1) * 16 + (r & 15)) * 8 + ((r >> 7) * 4 + ((r >> 4) & 3)); }
struct SchedScan {
    static constexpr bool UNIT_A = true;
    const char* A; const char* B; int nM, nN, dfix, G, c;
    __device__ __forceinline__ bool next(int i, Unit& u) const {
        const int L = i * G + c; if (L >= nM * nN) return false;
        pg8::tile_of(L, nM, nN, u.pm, u.pn); if (nN == 8) u.pn += 8 * dfix;
        u.t = u.pn >> 3;
        u.A = A + (size_t)u.pm * 256 * 2048 + ((u.pn >> 1) & 3) * 512; u.B = B + (size_t)u.pn * 256 * 512; return true;
    }
    __device__ __forceinline__ unsigned aoff(const Unit& u, int r) const { const int s = scan_pos(r); return (unsigned)((u.t ? 255 - s : s) * 2048); }
};
struct MoeTiles { int ts[NE + 1]; };
__device__ __forceinline__ void moe_tiles(const unsigned* cnt, MoeTiles& mt) {
    int a = 0;
#pragma unroll
    for (int e = 0; e < NE; ++e) { mt.ts[e] = a; a += (int)((cnt[64 * e] + 255u) >> 8); }
    mt.ts[NE] = a;
}
__device__ __forceinline__ int moe_ts_of(const MoeTiles& mt, int e) { int r = 0;
#pragma unroll
    for (int k = 0; k < NE; ++k) r = (e == k) ? mt.ts[k] : r;
    return r; }
__device__ __forceinline__ int moe_expert_of(const MoeTiles& mt, int pm) { int e = 0;
#pragma unroll
    for (int k = 1; k < NE; ++k) e += (pm >= mt.ts[k]) ? 1 : 0;
    return e; }
struct SchedMoeUp {
    static constexpr bool UNIT_A = true;
    const char* A; const char* B; const int* tok; MoeTiles mt; int G, c;
    __device__ __forceinline__ bool next(int i, Unit& u) const {
        const int nM = mt.ts[NE]; const int L = i * G + c; if (L >= nM * 28) return false;
        pg8::tile_of(L, nM, 28, u.pm, u.pn); u.t = moe_expert_of(mt, u.pm);
        u.A = A; u.B = B + ((size_t)u.t * 7168 + (size_t)u.pn * 256) * 2048; return true;
    }
    __device__ __forceinline__ unsigned aoff(const Unit& u, int r) const { int tk = tok[u.pm * 256 + r]; tk = tk < 0 ? 0 : tk; return (unsigned)tk * 2048u; }
};
struct SchedMoeDown {
    static constexpr bool UNIT_A = false;
    const char* A; const char* B; MoeTiles mt; int G, c;
    __device__ __forceinline__ bool next(int i, Unit& u) const {
        const int nM = mt.ts[NE]; const int L = i * G + c; if (L >= nM * 4) return false;
        pg8::tile_of(L, nM, 4, u.pm, u.pn); u.t = moe_expert_of(mt, u.pm);
        u.A = A + (size_t)u.pm * 256 * 7168; u.B = B + ((size_t)u.t * 1024 + (size_t)u.pn * 256) * 7168; return true;
    }
    __device__ __forceinline__ unsigned aoff(const Unit&, int r) const { return (unsigned)(r * 7168); }
};

typedef f32x4 Acc[2][2][4][2];
struct EpiZero {
    __device__ __forceinline__ void init(Acc& acc, const Unit&, int, int, int, int) const {
#pragma unroll
        for (int a = 0; a < 2; ++a)
#pragma unroll
            for (int b = 0; b < 2; ++b)
#pragma unroll
                for (int m = 0; m < 4; ++m)
#pragma unroll
                    for (int n = 0; n < 2; ++n) acc[a][b][m][n] = (f32x4){0.f, 0.f, 0.f, 0.f};
    }
};
template <int LDC, int BS, int ACT>
__device__ __forceinline__ void epi_store_tile(const Acc& acc, bf16* dst, int pm, int ct, int wr, int wc, int fr, int fq) {
    bf16* p0 = dst + (size_t)(pm * 256 + wr * 64 + fr) * LDC + ct * (2 * BS) + wc * 32 + fq * 8;
#pragma unroll
    for (int ai = 0; ai < 2; ++ai)
#pragma unroll
        for (int m = 0; m < 4; ++m) { bf16* rowp = p0 + (size_t)(ai * 128 + m * 16) * LDC;
#pragma unroll
            for (int bj = 0; bj < 2; ++bj) { f32x4 v0 = acc[ai][bj][m][0], v1 = acc[ai][bj][m][1];
                if (ACT) {
#pragma unroll
                    for (int j = 0; j < 4; ++j) { v0[j] = gelu_tanh_f(v0[j]); v1[j] = gelu_tanh_f(v1[j]); } }
                u32x4 w; w.x = cvtpk(v0[0], v0[1]); w.y = cvtpk(v0[2], v0[3]); w.z = cvtpk(v1[0], v1[1]); w.w = cvtpk(v1[2], v1[3]);
                *(u32x4*)(rowp + bj * BS) = w; } }
}
struct EpiStore1 : EpiZero {
    bf16* b0;
    __device__ __forceinline__ void operator()(const Acc& acc, const Unit& u, int wr, int wc, int fr, int fq, int, int) const { epi_store_tile<512, 128, 0>(acc, b0, u.pm, u.pn, wr, wc, fr, fq); }
};
struct EpiStoreQKV : EpiZero {
    bf16* q; bf16* k; bf16* v;
    __device__ __forceinline__ void operator()(const Acc& acc, const Unit& u, int wr, int wc, int fr, int fq, int, int) const {
        if (u.t == 0) epi_store_tile<1536, 128, 0>(acc, q, u.pm, u.pn, wr, wc, fr, fq);
        else if (u.t == 1) epi_store_tile<1536, 192, 0>(acc, k, u.pm, u.pn - 6, wr, wc, fr, fq);
        else epi_store_tile<1024, 128, 0>(acc, v, u.pm, u.pn - 10, wr, wc, fr, fq);
    }
};
struct EpiStoreUG : EpiZero {
    bf16* up; bf16* gate;
    __device__ __forceinline__ void operator()(const Acc& acc, const Unit& u, int wr, int wc, int fr, int fq, int, int) const {
        if (u.t == 0) epi_store_tile<1024, 128, 0>(acc, up, u.pm, u.pn, wr, wc, fr, fq);
        else epi_store_tile<1024, 128, 1>(acc, gate, u.pm, u.pn - 4, wr, wc, fr, fq);
    }
};
struct EpiResid : EpiZero {
    const float* inL; const float* inC; float* outL; float* outC; const float* gate;
    __device__ __forceinline__ void operator()(const Acc& acc, const Unit& u, int wr, int wc, int fr, int fq, int, int) const {
        const int rt = u.pm * 256; const bool lat = rt < TL;
        const float* ib = lat ? inL + (size_t)rt * D : inC + (size_t)(rt - TL) * D; float* ob = lat ? outL + (size_t)rt * D : outC + (size_t)(rt - TL) * D;
        const float* g = gate + (size_t)row_vec(rt) * 6144;
        const int col0 = u.pn * 256 + wc * 32 + 4 * fq, r0 = wr * 64 + fr;
        f32x4 gv[2][2];
#pragma unroll
        for (int bj = 0; bj < 2; ++bj)
#pragma unroll
            for (int n = 0; n < 2; ++n) gv[bj][n] = *(const f32x4*)(g + col0 + bj * 128 + n * 16);
        const float* ip = ib + (size_t)r0 * D + col0; float* op = ob + (size_t)r0 * D + col0;
#pragma unroll
        for (int ai = 0; ai < 2; ++ai)
#pragma unroll
            for (int m = 0; m < 4; ++m) { const int off = (ai * 128 + m * 16) * D;
                f32x4 x[2][2];
#pragma unroll
                for (int bj = 0; bj < 2; ++bj)
#pragma unroll
                    for (int n = 0; n < 2; ++n) x[bj][n] = *(const f32x4*)(ip + off + bj * 128 + n * 16);
#pragma unroll
                for (int bj = 0; bj < 2; ++bj)
#pragma unroll
                    for (int n = 0; n < 2; ++n) *(f32x4*)(op + off + bj * 128 + n * 16) = x[bj][n] + gv[bj][n] * acc[ai][bj][m][n];
                asm volatile("" ::: "memory"); }
    }
};
struct EpiSwiglu : EpiZero {
    bf16* hid; int ld;
    __device__ __forceinline__ void operator()(const Acc& acc, const Unit& u, int wr, int wc, int fr, int fq, int, int) const {
        const int row0 = u.pm * 256 + wr * 64 + fr, col0 = u.pn * 128 + wc * 32 + fq * 8;
#pragma unroll
        for (int ai = 0; ai < 2; ++ai)
#pragma unroll
            for (int m = 0; m < 4; ++m) { float v[8];
#pragma unroll
                for (int bj = 0; bj < 2; ++bj)
#pragma unroll
                    for (int j = 0; j < 4; ++j) v[bj * 4 + j] = silu_f(acc[ai][bj][m][0][j]) * acc[ai][bj][m][1][j];
                *(u32x4*)(hid + (size_t)(row0 + ai * 128 + m * 16) * ld + col0) = pack8(v); }
    }
};
struct EpiMoeDown : EpiZero {
    float* xL; float* xC; const float* g2; const int* tok; const float* gv;
    __device__ __forceinline__ void operator()(const Acc& acc, const Unit& u, int wr, int wc, int fr, int fq, int, int) const {
        const int p0 = u.pm * 256 + wr * 64 + fr, col0 = u.pn * 256 + wc * 32 + 4 * fq;
#pragma unroll
        for (int ai = 0; ai < 2; ++ai)
#pragma unroll
            for (int m = 0; m < 4; ++m) { const int pos = p0 + ai * 128 + m * 16; const int tk = tok[pos];
                if (tk >= 0) { const float gt = gv[pos]; float* xr = (tk < TL ? xL + (size_t)tk * D : xC + (size_t)(tk - TL) * D) + col0; const float* gr = g2 + (size_t)row_vec(tk) * 6144 + col0;
                    f32x4 x[2][2], g[2][2];
#pragma unroll
                    for (int bj = 0; bj < 2; ++bj)
#pragma unroll
                        for (int n = 0; n < 2; ++n) { x[bj][n] = *(const f32x4*)(xr + bj * 128 + n * 16); g[bj][n] = *(const f32x4*)(gr + bj * 128 + n * 16); }
#pragma unroll
                    for (int bj = 0; bj < 2; ++bj)
#pragma unroll
                        for (int n = 0; n < 2; ++n) *(f32x4*)(xr + bj * 128 + n * 16) = x[bj][n] + (g[bj][n] * gt) * acc[ai][bj][m][n]; }
                asm volatile("" ::: "memory"); }
    }
};
__device__ __forceinline__ int chain_tile(int b, int d, int p) { return p == 0 ? 256 + b : (d ? b * 32 + 32 - p : b * 32 + p - 1); }
template <int PASS, int DIR> struct EpiScan {
    const bf16* U; const float* ba; const float* bx; const float* lam;
    float* agg;
    bf16* hs; const bf16* gate;
    LAS unsigned char* scr;
    __device__ __forceinline__ void init(Acc& acc, const Unit& u, int, int wc, int, int fq) const {
        const int d = DIR < 0 ? (u.pn >> 3) : DIR, ch0 = ((u.pn >> 1) & 3) * 256 + (u.pn & 1) * 128 + wc * 32 + fq * 8;
#pragma unroll
        for (int bj = 0; bj < 2; ++bj) { const f32x4 a = *(const f32x4*)(ba + d * 1024 + ch0 + bj * 4), x = *(const f32x4*)(bx + d * 1024 + ch0 + bj * 4);
#pragma unroll
            for (int ai = 0; ai < 2; ++ai)
#pragma unroll
                for (int m = 0; m < 4; ++m) { acc[ai][bj][m][0] = a; acc[ai][bj][m][1] = x; } }
    }
    __device__ __forceinline__ void operator()(Acc& acc, const Unit& u, int wr, int wc, int fr, int fq, int lane, int wid) const {
        const int d = DIR < 0 ? (u.pn >> 3) : DIR, chb = ((u.pn >> 1) & 3) * 256 + (u.pn & 1) * 128, hl0 = wc * 32 + fq * 8, ch0 = chb + hl0;
        LAS float* carry = (LAS float*)scr; LAS f32x2* hagg = (LAS f32x2*)(scr + 1024);
        const int tid = wid * 64 + lane;
        if (PASS == 2 && tid < 128) {
            const int pm = u.pm; const int b = pm < 256 ? (pm >> 5) : pm - 256; const int q = pm < 256 ? (d ? 32 - (pm & 31) : 1 + (pm & 31)) : 0;
            float h = 0.f;
            for (int p = 0; p < q; ++p) { const f32x2 ab = *(const f32x2*)(agg + (((size_t)chain_tile(b, d, p) * 2 + d) * 1024 + chb + tid) * 2); h = ab.x * h + ab.y; }
            carry[tid] = h;
        }
        float sp[8];
        { const f32x4 s0v = *(const f32x4*)(lam + d * 1024 + ch0), s1v = *(const f32x4*)(lam + d * 1024 + ch0 + 4);
          sp[0] = s0v[0]; sp[1] = s0v[1]; sp[2] = s0v[2]; sp[3] = s0v[3]; sp[4] = s1v[0]; sp[5] = s1v[1]; sp[6] = s1v[2]; sp[7] = s1v[3]; }
        const int s0 = (wr * 16 + fr) * 8;
        const int rowb = u.pm * 256 + (d ? 255 - s0 : s0), rstep = d ? -1 : 1;
        float Ar[8], Br[8];
#pragma unroll
        for (int c = 0; c < 8; ++c) { Ar[c] = 1.f; Br[c] = 0.f; }
#pragma unroll
        for (int ai = 0; ai < 2; ++ai)
#pragma unroll
            for (int m = 0; m < 4; ++m) { const int trow = rowb + (ai * 4 + m) * rstep;
                float uf[8]; unpack8(*(const u32x4*)(U + (size_t)trow * D + ch0), uf);
#pragma unroll
                for (int bj = 0; bj < 2; ++bj)
#pragma unroll
                    for (int j = 0; j < 4; ++j) { const int c = bj * 4 + j;
                        const float r = sigm(acc[ai][bj][m][0][j]), ig = sigm(acc[ai][bj][m][1][j]);
                        const float a = ex2(sp[c] * r); const float bb = sqrtf(fmaxf(1.f - a * a, 0.f)) * (ig * uf[c]);
                        acc[ai][bj][m][0][j] = a; acc[ai][bj][m][1][j] = bb;
                        Br[c] = a * Br[c] + bb; Ar[c] = Ar[c] * a; }
                asm volatile("" ::: "memory"); }
#pragma unroll
        for (int dl = 1; dl < 16; dl <<= 1) {
#pragma unroll
            for (int c = 0; c < 8; ++c) { const float ap = __shfl_up(Ar[c], dl, 16), bp = __shfl_up(Br[c], dl, 16);
                if (fr >= dl) { Br[c] = Ar[c] * bp + Br[c]; Ar[c] = Ar[c] * ap; } }
        }
        if (wr == 0 && fr == 15) {
#pragma unroll
            for (int c = 0; c < 8; ++c) hagg[hl0 + c] = (f32x2){Ar[c], Br[c]};
        }
        LDS_WAIT(); __builtin_amdgcn_s_barrier(); asm volatile("" ::: "memory");
        if (PASS == 1) {
            if (wr == 1 && fr == 15) {
#pragma unroll
                for (int c = 0; c < 8; ++c) { const f32x2 h0 = hagg[hl0 + c]; *(f32x2*)(agg + (((size_t)u.pm * 2 + d) * 1024 + ch0 + c) * 2) = (f32x2){h0.x * Ar[c], Ar[c] * h0.y + Br[c]}; }
            }
        } else {
            float h[8];
#pragma unroll
            for (int c = 0; c < 8; ++c) { float ae = __shfl_up(Ar[c], 1, 16), be = __shfl_up(Br[c], 1, 16); if (fr == 0) { ae = 1.f; be = 0.f; }
                float hin = carry[hl0 + c]; if (wr == 1) { const f32x2 h0 = hagg[hl0 + c]; hin = h0.x * hin + h0.y; }
                h[c] = ae * hin + be; }
#pragma unroll
            for (int ai = 0; ai < 2; ++ai)
#pragma unroll
                for (int m = 0; m < 4; ++m) { const int trow = rowb + (ai * 4 + m) * rstep;
#pragma unroll
                    for (int bj = 0; bj < 2; ++bj)
#pragma unroll
                        for (int j = 0; j < 4; ++j) { const int c = bj * 4 + j; h[c] = acc[ai][bj][m][0][j] * h[c] + acc[ai][bj][m][1][j]; }
                    bf16* hp = hs + (size_t)trow * D + ch0;
                    if (d == 0) { *(u32x4*)hp = pack8(h); }
                    else { float hf[8], gf[8], o[8]; unpack8(*(const u32x4*)hp, hf); unpack8(*(const u32x4*)(gate + (size_t)trow * D + ch0), gf);
#pragma unroll
                        for (int c = 0; c < 8; ++c) o[c] = (hf[c] + h[c]) * gf[c];
                        *(u32x4*)hp = pack8(o); }
                    asm volatile("" ::: "memory"); }
        }
    }
};

namespace att {
constexpr int KVBLK = 64, KSTR = 400;
constexpr int SHM_V = KVBLK * 128 * 2, SHM_K = KVBLK * KSTR;
constexpr int LDS_ATT = 2 * SHM_V + 2 * SHM_K + NWAVES * 64 * 4;
static_assert(LDS_ATT <= RING_BYTES, "attention LDS");
constexpr float SCALE = 0.07216878364870322f;
constexpr float THR = 8.f;
#define SBAR() __builtin_amdgcn_sched_barrier(0)
__device__ __forceinline__ int crow(int r, int hi) { return (r & 3) + 8 * (r >> 2) + 4 * hi; }
__device__ __forceinline__ void partialSM(f32x16& p0, f32x16& p1, float& m_reg, float& mn, float& alpha) {
  constexpr float C = SCALE * 1.4426950408889634f;
  float pmax = p0[0];
#pragma unroll
  for (int r = 1; r < 16; ++r) pmax = fmaxf(pmax, p0[r]);
#pragma unroll
  for (int r = 0; r < 16; ++r) pmax = fmaxf(pmax, p1[r]);
  { auto rr = __builtin_amdgcn_permlane32_swap(__float_as_uint(pmax), __float_as_uint(pmax), false, false);
    pmax = fmaxf(__uint_as_float(rr[0]), __uint_as_float(rr[1])); }
  if (__builtin_expect(__all(pmax - m_reg <= THR / SCALE), 1)) { mn = m_reg; alpha = 1.f; }
  else { mn = fmaxf(m_reg, pmax); alpha = __builtin_amdgcn_exp2f((m_reg - mn) * C); m_reg = mn; }
  float mnC = -mn * C;
#pragma unroll
  for (int r = 0; r < 16; ++r) p0[r] = fmaf(p0[r], C, mnC);
#pragma unroll
  for (int r = 0; r < 16; ++r) p1[r] = fmaf(p1[r], C, mnC);
#pragma unroll
  for (int r = 0; r < 16; ++r) p0[r] = __builtin_amdgcn_exp2f(p0[r]);
}
__device__ __forceinline__ void finishSM(f32x16& p0, f32x16& p1, float alpha, float& l_reg, bf16x8& pa0, bf16x8& pa1, bf16x8& pa2, bf16x8& pa3) {
#pragma unroll
  for (int r = 0; r < 16; ++r) p1[r] = __builtin_amdgcn_exp2f(p1[r]);
  float ps = 0;
#pragma unroll
  for (int r = 0; r < 16; ++r) ps += p0[r];
#pragma unroll
  for (int r = 0; r < 16; ++r) ps += p1[r];
  { auto rr = __builtin_amdgcn_permlane32_swap(__float_as_uint(ps), __float_as_uint(ps), false, false);
    ps = __uint_as_float(rr[0]) + __uint_as_float(rr[1]); }
  l_reg = l_reg * alpha + ps;
#define PK4(P, BASE, OUT) do { unsigned a0 = cvtpk(P[BASE + 0], P[BASE + 1]), a1 = cvtpk(P[BASE + 2], P[BASE + 3]);   \
    unsigned b0 = cvtpk(P[BASE + 4], P[BASE + 5]), b1 = cvtpk(P[BASE + 6], P[BASE + 7]);                              \
    auto r0 = __builtin_amdgcn_permlane32_swap(a0, b0, false, false); auto r1 = __builtin_amdgcn_permlane32_swap(a1, b1, false, false); \
    u32x4 w = {r0[0], r1[0], r0[1], r1[1]}; OUT = *reinterpret_cast<bf16x8*>(&w); } while (0)
  PK4(p0, 0, pa0); PK4(p0, 8, pa1); PK4(p1, 0, pa2); PK4(p1, 8, pa3);
#undef PK4
}
__device__ __forceinline__ void qkt(f32x16& p0, f32x16& p1, const char* Ks, const bf16x8* qr, int r32, int hi) {
  p0 = f32x16{}; p1 = f32x16{};
#pragma unroll
  for (int d0 = 0; d0 < 12; ++d0) { const int cb = (d0 * 16 + hi * 8) * 2;
    bf16x8 b0 = *reinterpret_cast<const bf16x8*>(Ks + r32 * KSTR + cb);
    bf16x8 b1 = *reinterpret_cast<const bf16x8*>(Ks + (32 + r32) * KSTR + cb);
    p0 = __builtin_amdgcn_mfma_f32_32x32x16_bf16(b0, qr[d0], p0, 0, 0, 0);
    p1 = __builtin_amdgcn_mfma_f32_32x32x16_bf16(b1, qr[d0], p1, 0, 0, 0); }
}
__device__ __forceinline__ int v_st(int k, int c) { const int kk = (k & ~0xC) | ((k & 4) << 1) | ((k & 8) >> 1); return ((kk >> 3) * 4 + (c >> 5)) * 512 + ((kk & 7) * 32 + (c & 31)) * 2; }
__device__ __forceinline__ int v_rd_base(int lane) { return ((lane & 3) << 3) | (((lane >> 2) & 3) << 6) | (((lane >> 4) & 1) << 5) | (((lane >> 5) & 1) << 8); }
constexpr int v_rd_off(int d0, int ks, int half) { return d0 * 512 + ks * 4096 + half * 2048; }
template <int OFF> __device__ __forceinline__ s16x4 tr_read(int vb) {
  s16x4 r; asm volatile("ds_read_b64_tr_b16 %0, %1 offset:%2" : "=&v"(r) : "v"(vb), "i"(OFF) : "memory"); return r;
}
template <int D0> __device__ __forceinline__ void pv_one(f32x16& od, int vb, bf16x8 pa0, bf16x8 pa1, bf16x8 pa2, bf16x8 pa3) {
  const s16x4 l0 = tr_read<v_rd_off(D0, 0, 0)>(vb), h0 = tr_read<v_rd_off(D0, 0, 1)>(vb), l1 = tr_read<v_rd_off(D0, 1, 0)>(vb), h1 = tr_read<v_rd_off(D0, 1, 1)>(vb);
  const s16x4 l2 = tr_read<v_rd_off(D0, 2, 0)>(vb), h2 = tr_read<v_rd_off(D0, 2, 1)>(vb), l3 = tr_read<v_rd_off(D0, 3, 0)>(vb), h3 = tr_read<v_rd_off(D0, 3, 1)>(vb);
  asm volatile("s_waitcnt lgkmcnt(0)" ::: "memory"); SBAR();
#define PK(L, H) (bf16x8){L[0], L[1], L[2], L[3], H[0], H[1], H[2], H[3]}
  od = __builtin_amdgcn_mfma_f32_32x32x16_bf16(pa0, PK(l0, h0), od, 0, 0, 0);
  od = __builtin_amdgcn_mfma_f32_32x32x16_bf16(pa1, PK(l1, h1), od, 0, 0, 0);
  od = __builtin_amdgcn_mfma_f32_32x32x16_bf16(pa2, PK(l2, h2), od, 0, 0, 0);
  od = __builtin_amdgcn_mfma_f32_32x32x16_bf16(pa3, PK(l3, h3), od, 0, 0, 0);
#undef PK
}
__device__ __forceinline__ void pv_d0(f32x16* o, int vb, bf16x8 pa0, bf16x8 pa1, bf16x8 pa2, bf16x8 pa3) {
  pv_one<0>(o[0], vb, pa0, pa1, pa2, pa3); pv_one<1>(o[1], vb, pa0, pa1, pa2, pa3); pv_one<2>(o[2], vb, pa0, pa1, pa2, pa3); pv_one<3>(o[3], vb, pa0, pa1, pa2, pa3);
}
__device__ __forceinline__ void attn_body(const bf16* __restrict__ Qb, const bf16* __restrict__ KA, const bf16* __restrict__ VA, const bf16* __restrict__ KB2, const bf16* __restrict__ VB2,
                                          int nA, int seq, bf16* __restrict__ Ob, char* lds) {
  constexpr int LDQ = 1536, LDK = 1536, LDV = 1024, LDO = 1024;
  const int tid = opaque_tid(), wid = tid >> 6, lane = tid & 63, r32 = lane & 31, hi = lane >> 5;
  char* V_lds = lds; char* K_lds = lds + 2 * SHM_V;
  float* ws = (float*)(lds + 2 * SHM_V + 2 * SHM_K) + wid * 64; float* li_l = ws; float* al_l = ws + 32;
  float m_reg = -1e30f, l_reg = 0; f32x16 o[4] = {}; bf16x8 qr[12];
  const bf16* Qw = Qb + (long)(wid * 32 + r32) * LDQ + hi * 8;
#pragma unroll
  for (int d0 = 0; d0 < 12; ++d0) qr[d0] = *reinterpret_cast<const bf16x8*>(Qw + d0 * 16);
  const int sr = tid >> 4, sc = (tid & 15) * 8, vst0 = v_st(sr, sc), vst1 = v_st(32 + sr, sc);
  const int kgo = (tid >> 3) * LDK + (tid & 7) * 8, klo = (tid >> 3) * KSTR + (tid & 7) * 16;
  const int vb0 = (int)(uintptr_t)V_lds + v_rd_base(lane);
  bf16x8 vs0, vs1, ks0, ks1, ks2;
#define SLOAD(k0) do { const bool inA = (k0) < nA; const bf16* Kp = inA ? KA + (long)(k0) * LDK : KB2 + (long)((k0) - nA) * LDK; const bf16* Vp = inA ? VA + (long)(k0) * LDV : VB2 + (long)((k0) - nA) * LDV; \
    vs0 = *reinterpret_cast<const bf16x8*>(Vp + (long)sr * LDV + sc); vs1 = *reinterpret_cast<const bf16x8*>(Vp + (long)(32 + sr) * LDV + sc); \
    ks0 = *reinterpret_cast<const bf16x8*>(Kp + kgo); ks1 = *reinterpret_cast<const bf16x8*>(Kp + kgo + 64); ks2 = *reinterpret_cast<const bf16x8*>(Kp + kgo + 128); } while (0)
#define SWRITE(b) do { *(bf16x8*)(V_lds + (b) * SHM_V + vst0) = vs0; *(bf16x8*)(V_lds + (b) * SHM_V + vst1) = vs1; \
    *(bf16x8*)(K_lds + (b) * SHM_K + klo) = ks0; *(bf16x8*)(K_lds + (b) * SHM_K + klo + 128) = ks1; *(bf16x8*)(K_lds + (b) * SHM_K + klo + 256) = ks2; } while (0)
#define SWAIT() asm volatile("s_waitcnt vmcnt(0)" ::: "memory")
#define RESC(a) do { if (__any((a) < 1.f)) { if (hi == 0) al_l[r32] = (a); asm volatile("s_waitcnt lgkmcnt(0)" ::: "memory"); \
    _Pragma("unroll") for (int d = 0; d < 4; ++d) _Pragma("unroll") for (int r = 0; r < 16; ++r) o[d][r] *= al_l[crow(r, hi)]; } } while (0)
  f32x16 pA0, pA1, pB0, pB1; float mnA, mnB, alA, alB; bf16x8 pa0, pa1, pa2, pa3; const int NT = seq / KVBLK;
  SLOAD(0); SWAIT(); SWRITE(0); __syncthreads();
  qkt(pA0, pA1, K_lds, qr, r32, hi); partialSM(pA0, pA1, m_reg, mnA, alA);
  SLOAD(KVBLK);
  SWAIT(); SWRITE(1); __syncthreads();
  for (int j = 1; j + 1 < NT; j += 2) {
    SBAR(); qkt(pB0, pB1, K_lds + SHM_K, qr, r32, hi);
    finishSM(pA0, pA1, alA, l_reg, pa0, pa1, pa2, pa3); SBAR();
    SLOAD((j + 1) * KVBLK); SBAR();
    pv_d0(o, vb0, pa0, pa1, pa2, pa3); partialSM(pB0, pB1, m_reg, mnB, alB);
    __syncthreads(); SWAIT(); SWRITE(0);
    RESC(alB); __syncthreads();
    SBAR(); qkt(pA0, pA1, K_lds, qr, r32, hi);
    finishSM(pB0, pB1, alB, l_reg, pa0, pa1, pa2, pa3); SBAR();
    SLOAD((j + 2) * KVBLK); SBAR();
    pv_d0(o, vb0 + SHM_V, pa0, pa1, pa2, pa3); partialSM(pA0, pA1, m_reg, mnA, alA);
    __syncthreads(); SWAIT(); SWRITE(1);
    RESC(alA); __syncthreads();
  }
  SBAR(); qkt(pB0, pB1, K_lds + SHM_K, qr, r32, hi);
  finishSM(pA0, pA1, alA, l_reg, pa0, pa1, pa2, pa3); SBAR();
  pv_d0(o, vb0, pa0, pa1, pa2, pa3); partialSM(pB0, pB1, m_reg, mnB, alB);
  __syncthreads(); RESC(alB);
  finishSM(pB0, pB1, alB, l_reg, pa0, pa1, pa2, pa3); SBAR();
  pv_d0(o, vb0 + SHM_V, pa0, pa1, pa2, pa3);
  if (hi == 0) li_l[r32] = l_reg; asm volatile("s_waitcnt lgkmcnt(0)" ::: "memory");
  float rli[16];
#pragma unroll
  for (int r = 0; r < 16; ++r) rli[r] = __builtin_amdgcn_rcpf(li_l[crow(r, hi)]);
  bf16* Ow = Ob + (long)(wid * 32) * LDO;
#pragma unroll
  for (int r = 0; r < 16; ++r) { const int orow = crow(r, hi);
#pragma unroll
    for (int d0 = 0; d0 < 4; ++d0) Ow[(long)orow * LDO + d0 * 32 + r32] = (bf16)(cvtpk(o[d0][r] * rli[r], 0.f) & 0xffffu); }
#undef SLOAD
#undef SWRITE
#undef SWAIT
#undef RESC
}
}

template <class Map>
__device__ __forceinline__ void conv_item(const float* W, int Ksrc, int N, bf16* WT, int Kd, LAS float* scr, int item, int lane, const Map& map) {
    const int nblk = N / 32, kb = item / nblk, nb = item % nblk, k0 = 64 * kb, n0 = 32 * nb;
    const bool live = k0 < Ksrc;
#pragma unroll 8
    for (int i = 0; i < 32; ++i) { const int kk = 2 * i + (lane >> 5); scr[kk * 33 + (lane & 31)] = live ? W[(size_t)(k0 + kk) * N + n0 + (lane & 31)] : 0.f; }
    LDS_WAIT(); asm volatile("" ::: "memory");
    const int c = lane & 7;
#pragma unroll
    for (int j = 0; j < 4; ++j) { const int n = (lane >> 3) + 8 * j; const LAS float* s = scr + (8 * c) * 33 + n;
        u32x4 o; o.x = cvtpk(s[0 * 33], s[1 * 33]); o.y = cvtpk(s[2 * 33], s[3 * 33]); o.z = cvtpk(s[4 * 33], s[5 * 33]); o.w = cvtpk(s[6 * 33], s[7 * 33]);
        *(u32x4*)(WT + (size_t)map(n0 + n) * Kd + k0 + 8 * c) = o; }
    LDS_WAIT(); asm volatile("" ::: "memory");
}
struct MapNat { int off; __device__ __forceinline__ int operator()(int n) const { return off + n; } };
struct MapLog { int off; __device__ __forceinline__ int operator()(int n) const { return off + (n & ~255) + phys_of_logical(n & 255); } };
struct MapPair { int off, nsel; __device__ __forceinline__ int operator()(int n) const { return off + (n >> 7) * 256 + phys_of_pair(n & 127, nsel); } };
struct MapUkv { __device__ __forceinline__ int operator()(int n) const { const int h = n >> 8, w = n & 255; const int l = h * 128 + (w & 127); return (w < 128 ? 1536 : 2560) + (l & ~255) + phys_of_logical(l & 255); } };

template <class Map>
__device__ __forceinline__ void conv_job(Frame& F, int& cursor, const float* W, int Ksrc, int N, bf16* WT, int Kd, const Map& map) {
    LAS float* scr = (LAS float*)(F.lds + F.wave * 16384);
    const int gw = F.vcu * NWAVES + F.wave, NGW = F.G * NWAVES;
    const int nitems = (Kd / 64) * (N / 32);
    int first = (gw - cursor) % NGW; if (first < 0) first += NGW;
    for (int it = first; it < nitems; it += NGW) conv_item(W, Ksrc, N, WT, Kd, scr, it, F.lane, map);
    cursor = (cursor + nitems) % NGW;
}
__device__ __forceinline__ void conv_moe_layer(Frame& F, int& cur, int j) {
    KArgs ap = ARGS(); const float* w1 = ap->in[31]; const float* w3 = ap->in[32]; const float* w2 = ap->in[33];
    bf16* wm = (bf16*)(ap->ws + WS_WMOE);
    for (int e = 0; e < NE; ++e) {
        conv_job(F, cur, w1 + ((size_t)j * NE + e) * 1024 * EH, 1024, EH, wm + WM_13 + (size_t)e * 7168 * 1024, 1024, MapPair{0, 0});
        conv_job(F, cur, w3 + ((size_t)j * NE + e) * 1024 * EH, 1024, EH, wm + WM_13 + (size_t)e * 7168 * 1024, 1024, MapPair{0, 1});
        conv_job(F, cur, w2 + ((size_t)j * NE + e) * EH * 1024, EH, 1024, wm + WM_2 + (size_t)e * 1024 * 3584, 3584, MapNat{0});
    }
}
__device__ __forceinline__ void rope_sincos(int pos, int f, float& c, float& s) {
    const double inv = exp2(-(double)f * (13.287712379549449 / 16.0));
    const double a = (double)pos * inv;
    const double k = rint(a * 0.6366197723675814);
    const double x = fma(-k, 1.5707963267948966, a) - k * 6.123233995736766e-17;
    const double x2 = x * x;
    const double sn = x * (1.0 + x2 * (-1.0 / 6 + x2 * (1.0 / 120 + x2 * (-1.0 / 5040 + x2 * (1.0 / 362880 + x2 * (-1.0 / 39916800 + x2 * (1.0 / 6227020800.0)))))));
    const double cs = 1.0 + x2 * (-0.5 + x2 * (1.0 / 24 + x2 * (-1.0 / 720 + x2 * (1.0 / 40320 + x2 * (-1.0 / 3628800 + x2 * (1.0 / 479001600.0 + x2 * (-1.0 / 87178291200.0)))))));
    const int q = ((int)k) & 3;
    const double sv = (q == 0) ? sn : (q == 1) ? cs : (q == 2) ? -sn : -cs;
    const double cv = (q == 0) ? cs : (q == 1) ? -sn : (q == 2) ? -cs : sn;
    c = (float)cv; s = (float)sv;
}
__device__ __forceinline__ void prologue(Frame& F) {
    int cur = 0;
    {
        LAS float* sl = (LAS float*)F.lds;
        LAS float* red = (LAS float*)(F.lds + 40960);
        KArgs a = ARGS();
        const float* c = a->in[1]; const float* cc = a->in[3]; const float* aw = a->in[4]; const float* ab = a->in[5];
        float* mod = (float*)(a->ws + WS_MOD);
        bool have = false;
        for (int uidx = F.bx; uidx < 4 * 48; uidx += F.G) {
            if (!have) { for (int i = F.tid; i < 9 * 1024; i += NTHR) { const float x = i < 8192 ? c[i] : cc[i - 8192]; sl[i] = x / (1.f + expf(-x)); } __syncthreads(); have = true; }
            const int li = uidx / 48, cb = (uidx % 48) * 128, cg = F.tid & 31, ks = F.tid >> 5;
            float accv[9][4];
#pragma unroll
            for (int v = 0; v < 9; ++v)
#pragma unroll
                for (int q = 0; q < 4; ++q) accv[v][q] = 0.f;
            const float* wp = aw + ((size_t)li * 1024 + ks * 64) * 6144 + cb + cg * 4;
#pragma unroll 4
            for (int k = 0; k < 64; ++k) { const f32x4 w = *(const f32x4*)(wp + (size_t)k * 6144);
#pragma unroll
                for (int v = 0; v < 9; ++v) { const float sv = sl[v * 1024 + ks * 64 + k]; accv[v][0] += sv * w[0]; accv[v][1] += sv * w[1]; accv[v][2] += sv * w[2]; accv[v][3] += sv * w[3]; } }
#pragma unroll
            for (int v = 0; v < 9; ++v) *(LAS f32x4*)(red + (ks * 9 + v) * 128 + cg * 4) = (f32x4){accv[v][0], accv[v][1], accv[v][2], accv[v][3]};
            __syncthreads();
            for (int o = F.tid; o < 9 * 128; o += NTHR) { const int v = o >> 7, n = o & 127; float s = ab[(size_t)li * 6144 + cb + n];
#pragma unroll
                for (int k2 = 0; k2 < 16; ++k2) s += red[(k2 * 9 + v) * 128 + n];
                mod[((size_t)li * 9 + v) * 6144 + cb + n] = s; }
            __syncthreads();
        }
        __syncthreads();
    }
    {
        KArgs a = ARGS(); float* rt = (float*)(a->ws + WS_ROPE);
        for (int i = F.bx * NTHR + F.tid; i < SEQ * 32; i += F.G * NTHR) { const int pos = i >> 5, jj = i & 31; float cs, sn; rope_sincos(jj < 16 ? (pos >> 6) : (pos & 63), jj & 15, cs, sn); rt[2 * i] = cs; rt[2 * i + 1] = sn; }
    }
    {
        KArgs a = ARGS(); float* spt = (float*)(a->ws + WS_SPT); const float* lam = a->in[25];
        for (int i = F.bx * NTHR + F.tid; i < 2 * 2 * 1024; i += F.G * NTHR) spt[i] = -8.0f * 1.4426950408889634f * log1pf(expf(-lam[i]));
    }
#pragma unroll 1
    for (int j = 0; j < 2; ++j) {
        KArgs ap = ARGS(); bf16* wsm = (bf16*)(ap->ws + WS_WSM);
        bf16* wm = wsm + W_MLA + j * W_MLA_SZ;
        conv_job(F, cur, ap->in[8] + (size_t)j * 1024 * 256, 1024, 256, wm + W_MLA_1, 1024, MapLog{0});
        conv_job(F, cur, ap->in[11] + (size_t)j * 1024 * 192, 1024, 192, wm + W_MLA_1, 1024, MapLog{256});
        conv_job(F, cur, ap->in[10] + (size_t)j * 256 * 1536, 256, 1536, wm + W_MLA_CAT, 256, MapLog{0});
        conv_job(F, cur, ap->in[13] + (size_t)j * 128 * 2048, 128, 2048, wm + W_MLA_CAT, 256, MapUkv{});
        conv_job(F, cur, ap->in[16] + (size_t)j * 1024 * 1024, 1024, 1024, wm + W_MLA_O, 1024, MapNat{0});
        bf16* wr = wsm + W_RG + j * W_RG_SZ;
        conv_job(F, cur, ap->in[17] + (size_t)j * 1024 * 1024, 1024, 1024, wr + W_RG_IG, 1024, MapLog{0});
        conv_job(F, cur, ap->in[18] + (size_t)j * 1024 * 1024, 1024, 1024, wr + W_RG_IG, 1024, MapLog{1024});
        for (int dh = 0; dh < 8; ++dh) {
            conv_job(F, cur, ap->in[21] + ((size_t)j * 8 + dh) * 65536, 256, 256, wr + W_RG_AX + (size_t)dh * 2 * 65536, 256, MapPair{0, 0});
            conv_job(F, cur, ap->in[23] + ((size_t)j * 8 + dh) * 65536, 256, 256, wr + W_RG_AX + (size_t)dh * 2 * 65536, 256, MapPair{0, 1});
        }
        conv_job(F, cur, ap->in[26] + (size_t)j * 1024 * 1024, 1024, 1024, wr + W_RG_OUT, 1024, MapNat{0});
        bf16* wf = wsm + W_FFN + j * W_FFN_SZ;
        conv_job(F, cur, ap->in[27] + (size_t)j * 1024 * FF, 1024, FF, wf + W_FFN_13, 1024, MapPair{0, 0});
        conv_job(F, cur, ap->in[28] + (size_t)j * 1024 * FF, 1024, FF, wf + W_FFN_13, 1024, MapPair{0, 1});
        conv_job(F, cur, ap->in[29] + (size_t)j * FF * 1024, FF, 1024, wf + W_FFN_2, FF, MapNat{0});
        { const int gw = F.vcu * NWAVES + F.wave, NGW = F.G * NWAVES;
          for (int r = gw; r < 64; r += NGW) { const int row = 256 + phys_of_logical(192 + r); bf16* p = wm + W_MLA_1 + (size_t)row * 1024;
              for (int k = F.lane * 8; k < 1024; k += 512) *(u32x4*)(p + k) = (u32x4){0u, 0u, 0u, 0u}; } }
    }
    conv_moe_layer(F, cur, 0);
}

template <bool ROUTE>
__device__ __forceinline__ void norm_pass(Frame& F, const float* xL, const float* xC, int nrows, const float* g, const float* mod  , int chunk_sh, bf16* H,
                                          const float* wrt, unsigned* cnt, int* rE, int* rRank, float* rG) {
    const int gw = F.vcu * NWAVES + F.wave, NGW = F.G * NWAVES, lane = F.lane;
    for (int row = gw; row < nrows; row += NGW) {
        const float* xr = row < TL ? xL + (size_t)row * D : xC + (size_t)(row - TL) * D;
        const float* mv = mod + (size_t)row_vec(row) * 6144 + chunk_sh * 1024;
        f32x4 v[4]; float s = 0.f;
#pragma unroll
        for (int j = 0; j < 4; ++j) { v[j] = *(const f32x4*)(xr + 4 * lane + 256 * j); s += (v[j][0] * v[j][0] + v[j][1] * v[j][1]) + (v[j][2] * v[j][2] + v[j][3] * v[j][3]); }
        const float rstd = rsqrtf(wave_sum(s) * (1.f / D) + EPS);
        float lg[8];
        if (ROUTE) {
#pragma unroll
            for (int e = 0; e < 8; ++e) lg[e] = 0.f; }
#pragma unroll
        for (int j = 0; j < 4; ++j) { const int c = 4 * lane + 256 * j; const f32x4 gg = *(const f32x4*)(g + c), sh = *(const f32x4*)(mv + c), sc = *(const f32x4*)(mv + 1024 + c);
            f32x4 h = (v[j] * rstd) * gg * (sc + 1.f) + sh; v[j] = h;
            if (ROUTE) {
#pragma unroll
                for (int q = 0; q < 4; ++q) { const f32x4 w0 = *(const f32x4*)(wrt + (size_t)(c + q) * 8), w1 = *(const f32x4*)(wrt + (size_t)(c + q) * 8 + 4);
                    lg[0] += h[q] * w0[0]; lg[1] += h[q] * w0[1]; lg[2] += h[q] * w0[2]; lg[3] += h[q] * w0[3]; lg[4] += h[q] * w1[0]; lg[5] += h[q] * w1[1]; lg[6] += h[q] * w1[2]; lg[7] += h[q] * w1[3]; } }
            *(u32x2*)(H + (size_t)row * D + c) = (u32x2){cvtpk(h[0], h[1]), cvtpk(h[2], h[3])}; }
        if (ROUTE) {
#pragma unroll
            for (int e = 0; e < 8; ++e) lg[e] = wave_sum(lg[e]);
            int e1 = 0; float l1 = lg[0];
#pragma unroll
            for (int e = 1; e < 8; ++e) if (lg[e] > l1) { l1 = lg[e]; e1 = e; }
            int e2 = -1; float l2 = -3.0e38f;
#pragma unroll
            for (int e = 0; e < 8; ++e) if (e != e1 && lg[e] > l2) { l2 = lg[e]; e2 = e; }
            const float ga = 1.f / (1.f + expf(l2 - l1)), gb = 1.f - ga;
            const int ea = e1 < e2 ? e1 : e2, eb = e1 < e2 ? e2 : e1; const float g0 = e1 < e2 ? ga : gb, g1 = e1 < e2 ? gb : ga;
            if (lane == 0) {
                const unsigned r0 = __hip_atomic_fetch_add(cnt + 64 * ea, 1u, __ATOMIC_RELAXED, __HIP_MEMORY_SCOPE_AGENT);
                const unsigned r1 = __hip_atomic_fetch_add(cnt + 64 * (8 + eb), 1u, __ATOMIC_RELAXED, __HIP_MEMORY_SCOPE_AGENT);
                rE[2 * row] = ea; rE[2 * row + 1] = eb; rRank[2 * row] = (int)r0; rRank[2 * row + 1] = (int)r1; rG[2 * row] = g0; rG[2 * row + 1] = g1;
            }
        }
    }
}
__device__ __forceinline__ void moe_lists(Frame& F, int nrows, const unsigned* cnt, const int* rE, const int* rRank, const float* rG, int* tok, float* gvv) {
    const int gt = F.bx * NTHR + F.tid, NGT = F.G * NTHR;
    LAS int* tb = (LAS int*)F.lds;
    if (F.tid == 0) {
#pragma unroll 1
        for (int s = 0; s < 2; ++s) { int a = 0;
#pragma unroll 1
            for (int e = 0; e < NE; ++e) { tb[s * 8 + e] = a * 256; a += (int)((cnt[64 * (s * 8 + e)] + 255u) >> 8); } }
    }
    __syncthreads();
    for (int i = gt; i < nrows * 2; i += NGT) { const int s = i & 1, row = i >> 1, e = rE[i]; const int pos = tb[s * 8 + e] + rRank[i];
        tok[s * MOE_ROWS + pos] = row; gvv[s * MOE_ROWS + pos] = rG[i]; }
#pragma unroll 1
    for (int se = 0; se < 16; ++se) { const int c = (int)cnt[64 * se], base = tb[se], end = (c + 255) & ~255, so = (se >> 3) * MOE_ROWS;
        for (int p = c + gt; p < end; p += NGT) { tok[so + base + p] = -1; gvv[so + base + p] = 0.f; } }
    __syncthreads();
}
__device__ __forceinline__ void qkva_norm_pass(Frame& F, int nrows, bf16* QKVA, const float* gq, const float* gkv) {
    const int gw = F.vcu * NWAVES + F.wave, NGW = F.G * NWAVES, lane = F.lane;
    for (int row = gw; row < nrows; row += NGW) {
        bf16* p = QKVA + (size_t)row * 512 + lane * 8; float f[8]; unpack8(*(const u32x4*)p, f);
        float s = 0.f;
#pragma unroll
        for (int i = 0; i < 8; ++i) s += f[i] * f[i];
        const float sq = wave_sum(lane < 32 ? s : 0.f), sc = wave_sum((lane >= 32 && lane < 48) ? s : 0.f);
        if (lane < 48) { const float rstd = lane < 32 ? rsqrtf(sq * (1.f / 256) + EPS) : rsqrtf(sc * (1.f / 128) + EPS); const float* g = lane < 32 ? gq + lane * 8 : gkv + (lane - 32) * 8;
#pragma unroll
            for (int i = 0; i < 8; ++i) f[i] = f[i] * rstd * g[i];
            *(u32x4*)p = pack8(f); }
    }
}
__device__ __forceinline__ void qk_final_pass(Frame& F, int nrows, bf16* Qb, bf16* Kb, const bf16* QKVA, const float* gqn, const float* gkn, const float* rope) {
    const int gw = F.vcu * NWAVES + F.wave, NGW = F.G * NWAVES, lane = F.lane;
    const int grp = lane < 24 ? 0 : (lane < 48 ? 1 : 2), gl = lane - 24 * grp;
    const bool act = grp < 2;
    const int d0 = gl * 8;
    const int partner = (gl >= 16 && gl < 20) ? lane + 4 : ((gl >= 20 && gl < 24) ? lane - 4 : lane);
    for (int row = gw; row < nrows; row += NGW) {
        const bool lat = row < TL; const int pos = row & (SEQ - 1);
        float cs[8], sn[8];
        if (act && gl >= 16 && lat) { const int jb = (gl & 3) * 8;
#pragma unroll
            for (int i = 0; i < 8; ++i) { const f32x2 t = *(const f32x2*)(rope + ((size_t)pos * 32 + jb + i) * 2); cs[i] = t.x; sn[i] = t.y; } }
        else {
#pragma unroll
            for (int i = 0; i < 8; ++i) { cs[i] = 1.f; sn[i] = 0.f; } }
#pragma unroll 1
        for (int which = 0; which < 2; ++which) {
            const float* gn = which ? gkn : gqn;
#pragma unroll 1
            for (int hp = 0; hp < 4; ++hp) {
                const int h = hp * 2 + (grp & 1);
                bf16* base = (which ? Kb : Qb) + (size_t)row * 1536 + h * 192 + d0;
                float f[8];
                if (act) { const bf16* src = (which && gl >= 16) ? QKVA + (size_t)row * 512 + 384 + (gl - 16) * 8 : base; unpack8(*(const u32x4*)src, f); }
                else {
#pragma unroll
                    for (int i = 0; i < 8; ++i) f[i] = 0.f; }
                float s = 0.f;
#pragma unroll
                for (int i = 0; i < 8; ++i) s += f[i] * f[i];
                const float s0 = wave_sum(grp == 0 ? s : 0.f), s1 = wave_sum(grp == 1 ? s : 0.f);
                const float rstd = rsqrtf((grp == 0 ? s0 : s1) * (1.f / 192) + EPS);
                float o[8];
#pragma unroll
                for (int i = 0; i < 8; ++i) { f[i] = f[i] * rstd * gn[(act ? d0 : 0) + i]; }
#pragma unroll
                for (int i = 0; i < 8; ++i) { const float other = __shfl(f[i], partner);
                    o[i] = (gl >= 16 && gl < 20) ? f[i] * cs[i] - other * sn[i] : ((gl >= 20 && gl < 24) ? f[i] * cs[i] + other * sn[i] : f[i]); }
                if (act) *(u32x4*)base = pack8(o);
            }
        }
    }
}
__device__ __forceinline__ void conv_pass(Frame& F, int nrows, const bf16* UP, bf16* U, const float* cw, const float* cb) {
    const int gw = F.vcu * NWAVES + F.wave, NGW = F.G * NWAVES, lane = F.lane;
    for (int row = gw; row < nrows; row += NGW) {
        const int len = row < TL ? SEQ : CTXL; const int n = row < TL ? (row & (SEQ - 1)) : ((row - TL) & (CTXL - 1));
#pragma unroll
        for (int half = 0; half < 2; ++half) { const int c = lane * 8 + half * 512;
            float o[8];
#pragma unroll
            for (int i = 0; i < 8; ++i) o[i] = cb[c + i];
#pragma unroll
            for (int k = 0; k < 4; ++k) { const int nn = n + k - 2;
                if (nn >= 0 && nn < len) { float f[8]; unpack8(*(const u32x4*)(UP + (size_t)(row + k - 2) * D + c), f);
#pragma unroll
                    for (int i = 0; i < 8; ++i) o[i] += f[i] * cw[k * 1024 + c + i]; } }
            *(u32x4*)(U + (size_t)row * D + c) = pack8(o); }
    }
}

#ifdef PROBE
constexpr int CW_PROBE = 20480;
__device__ __forceinline__ void probe_buf(int id, const void* p, size_t nelem, bool f32v, unsigned* word) {
    int bxx = blockIdx.x; asm volatile("" : "+s"(bxx));
    const unsigned gt = (unsigned)bxx * NTHR + (unsigned)opaque_tid(), NGT = gridDim.x * NTHR;
    const unsigned nw = (unsigned)(f32v ? nelem : nelem / 2);
    const unsigned* q = (const unsigned*)p;
    bool bad = false;
    if (f32v) { for (unsigned i = gt; i < nw; i += NGT) bad |= ((q[i] & 0x7f800000u) == 0x7f800000u); }
    else { for (unsigned i = gt; i < nw; i += NGT) { const unsigned w = q[i]; bad |= ((w & 0x7f80u) == 0x7f80u) | ((w & 0x7f800000u) == 0x7f800000u); } }
    if (bad) atomicMax(word, (unsigned)(1000 - id));
}
#define PROBE_CHECK(id, ptr, nelem, f32v) do { KArgs ap = ARGS(); probe_buf(id, ptr, nelem, f32v, (unsigned*)WSP(WS_CTL) + CW_PROBE); } while (0)
#else
#define PROBE_CHECK(id, ptr, nelem, f32v) do { } while (0)
#endif
#ifndef PH_MASK
#define PH_MASK 0xffffffffu
#endif
#define PH(k) ((((unsigned)(PH_MASK)) >> (k)) & 1u)
__global__ void __launch_bounds__(NTHR, 2) fwd_kernel(Args args) {
    extern __shared__ __attribute__((aligned(16))) unsigned char lds_raw[];
#define MKFRAME() Frame F; F.lds = (LAS unsigned char*)lds_raw; F.tid = opaque_tid(); F.lane = F.tid & 63; F.wave = __builtin_amdgcn_readfirstlane(F.tid >> 6); \
    F.G = gridDim.x; F.bx = blockIdx.x; asm volatile("" : "+s"(F.G), "+s"(F.bx)); F.vcu = (F.bx & 7) * (F.G >> 3) + (F.bx >> 3)
    volatile LAS unsigned* MISC = (volatile LAS unsigned*)((LAS unsigned char*)lds_raw + MISC_OFF);
    if (threadIdx.x < 64) MISC[threadIdx.x] = 0u;
    __syncthreads();
    (void)xcd_barrier_post((unsigned*)(args.ws + WS_CTL) + CW_BAR, MISC + 8);
#define GRID_BAR() do { KArgs _ap = ARGS(); XcdBarrier _b; _b.bar = (unsigned*)(_ap->ws + WS_CTL) + CW_BAR; _b.x = xb_xcc_id(); _b.st = (volatile LAS unsigned*)((LAS unsigned char*)lds_raw + MISC_OFF) + 8; xcd_barrier(_b); } while (0)
#define RING ((LAS unsigned char*)lds_raw)
#define EPISCR ((LAS unsigned char*)lds_raw + EPI_OFF)
#define WSP(off) (ap->ws + (off))
#define MODP(li) ((const float*)WSP(WS_MOD) + (size_t)(li) * 9 * 6144)
#define XLP (ap->out)
#define XCP ((float*)WSP(WS_XC))
#define HP ((bf16*)WSP(WS_H))
#define ARP(off) ((bf16*)(WSP(WS_ARENA) + (off)))
#define WSMP ((bf16*)WSP(WS_WSM))

    if constexpr (PH(0)) { MKFRAME(); prologue(F); }
    GRID_BAR();
            PROBE_CHECK(1, WSP(WS_MOD), (size_t)4 * 9 * 6144, true); PROBE_CHECK(2, WSP(WS_ROPE), (size_t)SEQ * 64, true); PROBE_CHECK(3, WSP(WS_WSM), (W_FFN + 2 * W_FFN_SZ), false); PROBE_CHECK(4, WSP(WS_WMOE), WM_SZ, false);

#pragma unroll 1
    for (int j = 0; j < 2; ++j) {
        {
            const int li = 2 * j;
            if constexpr (PH(1)) { KArgs ap = ARGS(); MKFRAME();
                norm_pass<false>(F, j == 0 ? ap->in[0] : XLP, j == 0 ? ap->in[2] : XCP, T, ap->in[6] + li * 1024, MODP(li), 0, HP, nullptr, nullptr, nullptr, nullptr, nullptr);
                if (j == 1) { int cur = 0; conv_moe_layer(F, cur, 1); } }
            GRID_BAR();
            PROBE_CHECK(10 + 20 * j, HP, (size_t)T * 1024, false);
            if constexpr (PH(2)) { KArgs ap = ARGS(); MKFRAME();
              SchedPlain S{(const char*)HP, (const char*)(WSMP + W_MLA + j * W_MLA_SZ + W_MLA_1), 2048, 2048, T / 256, 2, F.G, F.bx, 1 << 30};
              EpiStore1 E{{}, ARP(AR_QKVA)};
              pg8::gemm_phase(RING, 1024, 1024, S, E); }
            GRID_BAR();
            PROBE_CHECK(11 + 20 * j, ARP(AR_QKVA), (size_t)T * 512, false);
            if constexpr (PH(3)) { KArgs ap = ARGS(); MKFRAME(); qkva_norm_pass(F, T, ARP(AR_QKVA), ap->in[9] + j * 256, ap->in[12] + j * 128); }
            GRID_BAR();
            PROBE_CHECK(12 + 20 * j, ARP(AR_QKVA), (size_t)T * 512, false);
            if constexpr (PH(4)) { KArgs ap = ARGS(); MKFRAME();
              SchedA3 S{(const char*)ARP(AR_QKVA), (const char*)(WSMP + W_MLA + j * W_MLA_SZ + W_MLA_CAT), T / 256, F.G, F.bx};
              EpiStoreQKV E{{}, ARP(AR_Q), ARP(AR_K), ARP(AR_V)};
              pg8::gemm_phase(RING, 256, 256, S, E); }
            GRID_BAR();
            PROBE_CHECK(13 + 20 * j, ARP(AR_Q), (size_t)T * 1536, false); PROBE_CHECK(14 + 20 * j, ARP(AR_V), (size_t)T * 1024, false);
            if constexpr (PH(5)) { KArgs ap = ARGS(); MKFRAME(); qk_final_pass(F, T, ARP(AR_Q), ARP(AR_K), ARP(AR_QKVA), ap->in[14] + j * 192, ap->in[15] + j * 192, (const float*)WSP(WS_ROPE)); }
            GRID_BAR();
            PROBE_CHECK(15 + 20 * j, ARP(AR_Q), (size_t)T * 1536, false); PROBE_CHECK(16 + 20 * j, ARP(AR_K), (size_t)T * 1536, false);
            if constexpr (PH(6)) { KArgs ap = ARGS(); MKFRAME(); bf16* AO = HP; const bf16* Qb = ARP(AR_Q); const bf16* Kb = ARP(AR_K); const bf16* Vb = ARP(AR_V);
              const int nlat = NB * NH * 32, ntot = nlat + NB * NH;
              for (int u = F.vcu; u < ntot; u += F.G) {
                  __syncthreads();
                  if (u < nlat) { const int bh = u >> 5, qb = u & 31, b = bh >> 3, h = bh & 7; const size_t r0 = (size_t)b * SEQ, rc = (size_t)TL + (size_t)b * CTXL, rq = r0 + qb * 256;
                      att::attn_body(Qb + rq * 1536 + h * 192, Kb + r0 * 1536 + h * 192, Vb + r0 * 1024 + h * 128, Kb + rc * 1536 + h * 192, Vb + rc * 1024 + h * 128, SEQ, SEQ + CTXL, AO + rq * 1024 + h * 128, (char*)lds_raw);
                  } else { const int bh = u - nlat, b = bh >> 3, h = bh & 7; const size_t rc = (size_t)TL + (size_t)b * CTXL;
                      att::attn_body(Qb + rc * 1536 + h * 192, Kb + rc * 1536 + h * 192, Vb + rc * 1024 + h * 128, Kb + rc * 1536 + h * 192, Vb + rc * 1024 + h * 128, CTXL, CTXL, AO + rc * 1024 + h * 128, (char*)lds_raw);
                  }
              }
              __syncthreads(); }
            GRID_BAR();
            PROBE_CHECK(17 + 20 * j, HP, (size_t)T * 1024, false);
            if constexpr (PH(7)) { KArgs ap = ARGS(); MKFRAME();
              SchedPlain S{(const char*)HP, (const char*)(WSMP + W_MLA + j * W_MLA_SZ + W_MLA_O), 2048, 2048, T / 256, 4, F.G, F.bx, 1 << 30};
              EpiResid E{{}, j == 0 ? ap->in[0] : XLP, j == 0 ? ap->in[2] : XCP, XLP, XCP, MODP(li) + 2 * 1024};
              pg8::gemm_phase(RING, 1024, 1024, S, E); }
            GRID_BAR();
            PROBE_CHECK(18 + 20 * j, XLP, (size_t)TL * 1024, true); PROBE_CHECK(19 + 20 * j, XCP, (size_t)TC * 1024, true);
            if constexpr (PH(8)) { KArgs ap = ARGS(); MKFRAME(); norm_pass<false>(F, XLP, XCP, T, ap->in[7] + li * 1024, MODP(li), 3, HP, nullptr, nullptr, nullptr, nullptr, nullptr); }
            GRID_BAR();
            PROBE_CHECK(20 + 20 * j, HP, (size_t)T * 1024, false);
            if constexpr (PH(9)) { KArgs ap = ARGS(); MKFRAME();
              SchedPlain S{(const char*)HP, (const char*)(WSMP + W_FFN + j * W_FFN_SZ + W_FFN_13), 2048, 2048, T / 256, 22, F.G, F.bx, 1 << 30};
              EpiSwiglu E{{}, ARP(AR_HID), FF};
              pg8::gemm_phase(RING, 1024, 1024, S, E); }
            GRID_BAR();
            PROBE_CHECK(21 + 20 * j, ARP(AR_HID), (size_t)T * FF, false);
            if constexpr (PH(10)) { KArgs ap = ARGS(); MKFRAME();
              SchedPlain S{(const char*)ARP(AR_HID), (const char*)(WSMP + W_FFN + j * W_FFN_SZ + W_FFN_2), FF * 2, FF * 2, T / 256, 4, F.G, F.bx, 1 << 30};
              EpiResid E{{}, XLP, XCP, XLP, XCP, MODP(li) + 5 * 1024};
              pg8::gemm_phase(RING, FF, FF, S, E); }
            GRID_BAR();
            PROBE_CHECK(22 + 20 * j, XLP, (size_t)TL * 1024, true);
        }
        {
            const int li = 2 * j + 1;
            const int nrows_out = li < 3 ? T : TL;
            if constexpr (PH(11)) { KArgs ap = ARGS(); MKFRAME(); norm_pass<false>(F, XLP, XCP, T, ap->in[6] + li * 1024, MODP(li), 0, HP, nullptr, nullptr, nullptr, nullptr, nullptr); }
            GRID_BAR();
            PROBE_CHECK(50 + 20 * j, HP, (size_t)T * 1024, false);
            if constexpr (PH(12)) { KArgs ap = ARGS(); MKFRAME();
              SchedPlain S{(const char*)HP, (const char*)(WSMP + W_RG + j * W_RG_SZ + W_RG_IG), 2048, 2048, T / 256, 8, F.G, F.bx, 4};
              EpiStoreUG E{{}, ARP(AR_UPRE), ARP(AR_GATE)};
              pg8::gemm_phase(RING, 1024, 1024, S, E); }
            GRID_BAR();
            PROBE_CHECK(51 + 20 * j, ARP(AR_UPRE), (size_t)T * 1024, false); PROBE_CHECK(52 + 20 * j, ARP(AR_GATE), (size_t)T * 1024, false);
            if constexpr (PH(13)) { KArgs ap = ARGS(); MKFRAME(); conv_pass(F, T, ARP(AR_UPRE), ARP(AR_U), ap->in[19] + j * 4096, ap->in[20] + j * 1024); }
            GRID_BAR();
            PROBE_CHECK(53 + 20 * j, ARP(AR_U), (size_t)T * 1024, false);
            if constexpr (PH(14)) { KArgs ap = ARGS(); MKFRAME();
              SchedScan S{(const char*)ARP(AR_U), (const char*)(WSMP + W_RG + j * W_RG_SZ + W_RG_AX), T / 256, 16, 0, F.G, F.bx};
              EpiScan<1, -1> E{ARP(AR_U), ap->in[22] + j * 2048, ap->in[24] + j * 2048, (const float*)WSP(WS_SPT) + j * 2048, (float*)WSP(WS_AGG), nullptr, nullptr, EPISCR};
              pg8::gemm_phase(RING, 256, 256, S, E); }
            GRID_BAR();
            PROBE_CHECK(54 + 20 * j, WSP(WS_AGG), (size_t)264 * 2 * 1024 * 2, true);
            if constexpr (PH(15)) { KArgs ap = ARGS(); MKFRAME();
              SchedScan S{(const char*)ARP(AR_U), (const char*)(WSMP + W_RG + j * W_RG_SZ + W_RG_AX), nrows_out / 256, 8, 0, F.G, F.bx};
              EpiScan<2, 0> E{ARP(AR_U), ap->in[22] + j * 2048, ap->in[24] + j * 2048, (const float*)WSP(WS_SPT) + j * 2048, (float*)WSP(WS_AGG), HP, ARP(AR_GATE), EPISCR};
              pg8::gemm_phase(RING, 256, 256, S, E); }
            GRID_BAR();
            PROBE_CHECK(55 + 20 * j, HP, (size_t)nrows_out * 1024, false);
            if constexpr (PH(16)) { KArgs ap = ARGS(); MKFRAME();
              SchedScan S{(const char*)ARP(AR_U), (const char*)(WSMP + W_RG + j * W_RG_SZ + W_RG_AX), nrows_out / 256, 8, 1, F.G, F.bx};
              EpiScan<2, 1> E{ARP(AR_U), ap->in[22] + j * 2048, ap->in[24] + j * 2048, (const float*)WSP(WS_SPT) + j * 2048, (float*)WSP(WS_AGG), HP, ARP(AR_GATE), EPISCR};
              pg8::gemm_phase(RING, 256, 256, S, E); }
            GRID_BAR();
            PROBE_CHECK(56 + 20 * j, HP, (size_t)nrows_out * 1024, false);
            if constexpr (PH(17)) { KArgs ap = ARGS(); MKFRAME();
              SchedPlain S{(const char*)HP, (const char*)(WSMP + W_RG + j * W_RG_SZ + W_RG_OUT), 2048, 2048, nrows_out / 256, 4, F.G, F.bx, 1 << 30};
              EpiResid E{{}, XLP, XCP, XLP, XCP, MODP(li) + 2 * 1024};
              pg8::gemm_phase(RING, 1024, 1024, S, E); }
            GRID_BAR();
            PROBE_CHECK(57 + 20 * j, XLP, (size_t)TL * 1024, true);
#define CNTP ((unsigned*)WSP(WS_CTL) + CW_CNT + j * 16 * 64)
#define RTP(off) (WSP(WS_ROUTE) + (off))
            if constexpr (PH(18)) { KArgs ap = ARGS(); MKFRAME();
              norm_pass<true>(F, XLP, XCP, nrows_out, ap->in[7] + li * 1024, MODP(li), 3, HP, ap->in[30] + (size_t)j * 1024 * 8, CNTP, (int*)RTP(RT_E), (int*)RTP(RT_RANK), (float*)RTP(RT_G)); }
            GRID_BAR();
            PROBE_CHECK(58 + 20 * j, HP, (size_t)nrows_out * 1024, false);
            if constexpr (PH(19)) { KArgs ap = ARGS(); MKFRAME(); moe_lists(F, nrows_out, CNTP, (const int*)RTP(RT_E), (const int*)RTP(RT_RANK), (const float*)RTP(RT_G), (int*)RTP(RT_TOK), (float*)RTP(RT_GV)); }
            GRID_BAR();
#pragma unroll 1
            for (int s = 0; s < 2; ++s) {
                if constexpr (PH(20)) { KArgs ap = ARGS(); MKFRAME(); MoeTiles mt; moe_tiles(CNTP + 64 * 8 * s, mt);
                  SchedMoeUp S{(const char*)HP, (const char*)((bf16*)WSP(WS_WMOE) + WM_13), (const int*)RTP(RT_TOK) + s * MOE_ROWS, mt, F.G, F.bx};
                  EpiSwiglu E{{}, ARP(AR_HID), EH};
                  pg8::gemm_phase(RING, 1024, 1024, S, E); }
                GRID_BAR();
                if constexpr (PH(21)) { KArgs ap = ARGS(); MKFRAME(); MoeTiles mt; moe_tiles(CNTP + 64 * 8 * s, mt);
                  SchedMoeDown S{(const char*)ARP(AR_HID), (const char*)((bf16*)WSP(WS_WMOE) + WM_2), mt, F.G, F.bx};
                  EpiMoeDown E{{}, XLP, XCP, MODP(li) + 5 * 1024, (const int*)RTP(RT_TOK) + s * MOE_ROWS, (const float*)RTP(RT_GV) + s * MOE_ROWS};
                  pg8::gemm_phase(RING, EH, EH, S, E); }
                GRID_BAR();
            PROBE_CHECK(60 + 20 * j + s, XLP, (size_t)TL * 1024, true);
            }
        }
    }
#ifdef PROBE
    {
        KArgs ap = ARGS(); const unsigned w = *((volatile unsigned*)WSP(WS_CTL) + CW_PROBE); const int id = w ? 1000 - (int)w : 89;
        float* o = ap->out; const unsigned gt = blockIdx.x * NTHR + (unsigned)opaque_tid(), NGT = gridDim.x * NTHR;
        for (unsigned i = gt; i < (unsigned)TL * D; i += NGT) o[i] = (i == 0) ? (float)(10 + id) * 1.0e4f : 0.f;
    }
#endif
}

extern "C" void kernel_launch(void* const* d_in, const int* in_sizes, int n_in, void* d_out, int out_size, void* d_ws, size_t ws_size, hipStream_t stream) {
    static int grid = 0;
    if (grid == 0) {
        if (n_in != 34 || out_size != TL * D || ws_size < WS_END) { fprintf(stderr, "kernel_launch: unexpected shapes: n_in %d out %d ws %zu (need %zu)\n", n_in, out_size, ws_size, (size_t)WS_END); grid = -1; return; }
        int dev = 0, cus = 0, per_cu = 0;
        if (hipGetDevice(&dev) != hipSuccess || hipDeviceGetAttribute(&cus, hipDeviceAttributeMultiprocessorCount, dev) != hipSuccess) { grid = -1; return; }
        if (hipFuncSetAttribute((const void*)fwd_kernel, hipFuncAttributeMaxDynamicSharedMemorySize, LDS_BYTES) != hipSuccess) { fprintf(stderr, "kernel_launch: hipFuncSetAttribute failed\n"); grid = -1; return; }
        if (hipOccupancyMaxActiveBlocksPerMultiprocessor(&per_cu, (const void*)fwd_kernel, NTHR, LDS_BYTES) != hipSuccess || per_cu < 1) { fprintf(stderr, "kernel_launch: occupancy query says %d\n", per_cu); (void)hipGetLastError(); }
        grid = cus & ~7;
    }
    if (grid < 0) return;
    (void)hipMemsetAsync((char*)d_ws + WS_CTL, 0, CTL_BYTES, stream);
    Args a{};
    for (int i = 0; i < 34; ++i) a.in[i] = (const float*)d_in[i];
    a.out = (float*)d_out; a.ws = (unsigned char*)d_ws;
    hipLaunchKernelGGL(fwd_kernel, dim3(grid), dim3(NTHR), LDS_BYTES, stream, a);
    const hipError_t le = hipPeekAtLastError();
    if (le != hipSuccess) fprintf(stderr, "kernel_launch: launch failed: %s\n", hipGetErrorName(le));
}
```

```cpp
#include <hip/hip_runtime.h>
#include <cstdio>
#include <cstdint>

#define GAS __attribute__((address_space(1)))
#define LAS __attribute__((address_space(3)))
typedef unsigned short bf16;
typedef short bf16x8 __attribute__((ext_vector_type(8)));
typedef short s16x4 __attribute__((ext_vector_type(4)));
typedef float f32x2 __attribute__((ext_vector_type(2)));
typedef float f32x4 __attribute__((ext_vector_type(4)));
typedef float f32x16 __attribute__((ext_vector_type(16)));
typedef unsigned u32x2 __attribute__((ext_vector_type(2)));
typedef unsigned u32x4 __attribute__((ext_vector_type(4)));
typedef int i32x4 __attribute__((ext_vector_type(4)));
typedef int i32x8 __attribute__((ext_vector_type(8)));

constexpr int D = 1024, NB = 8, SEQ = 8192, CTXL = 256;
constexpr int TL = NB * SEQ, TC = NB * CTXL, T = TL + TC;
constexpr int NH = 8, QLORA = 256, KVLORA = 128, ROPE = 64, NOPE = 128, VD = 128, QK = 192;
constexpr int FF = 2816, NE = 8, EH = 3584;
constexpr float EPS = 1e-6f;
constexpr int NWAVES = 8, NTHR = 512;

constexpr size_t MiB = 1u << 20;
constexpr size_t WS_CTL = 0, CTL_BYTES = 1 * MiB;
constexpr size_t WS_MOD = 1 * MiB;
constexpr size_t WS_XC = 2 * MiB;
constexpr size_t WS_AGG = 10 * MiB;
constexpr size_t WS_ROUTE = 15 * MiB;
constexpr size_t WS_ROPE = 18 * MiB;
static_assert(WS_AGG + (size_t)264 * 2 * 1024 * 2 * 4 <= 14 * MiB + 512 * 1024 && WS_ROPE + (size_t)8192 * 64 * 4 <= 20 * MiB, "ws map");
constexpr size_t WS_SPT = 14 * MiB + 512 * 1024;
constexpr size_t WS_WSM = 20 * MiB;
constexpr size_t WS_WMOE = 84 * MiB;
constexpr size_t WS_XB = 172 * MiB;
constexpr size_t WS_H = 304 * MiB;
constexpr size_t WS_ARENA = 436 * MiB;
constexpr size_t WS_END = 436 * MiB + 600 * MiB;
constexpr size_t W_MLA = 0;
constexpr size_t W_MLA_1 = 0, W_MLA_CAT = 512 * 1024, W_MLA_O = W_MLA_CAT + 3584 * 256, W_MLA_SZ = W_MLA_O + 1024 * 1024;
constexpr size_t W_RG = 2 * W_MLA_SZ;
constexpr size_t W_RG_IG = 0, W_RG_AX = 2048 * 1024, W_RG_OUT = W_RG_AX + 16 * 256 * 256, W_RG_SZ = W_RG_OUT + 1024 * 1024;
constexpr size_t W_FFN = W_RG + 2 * W_RG_SZ;
constexpr size_t W_FFN_13 = 0, W_FFN_2 = (size_t)5632 * 1024, W_FFN_SZ = W_FFN_2 + (size_t)1024 * 2816;
static_assert((W_FFN + 2 * W_FFN_SZ) * 2 <= 64 * MiB, "small weights fit");
constexpr size_t WM_13 = 0, WM_2 = (size_t)NE * 7168 * 1024, WM_SZ = WM_2 + (size_t)NE * 1024 * 3584;
static_assert(WM_SZ <= 88 * MiB && WS_WMOE + 88 * MiB <= WS_XB && WS_XB + (size_t)T * 1024 * 2 <= WS_H, "moe weights (fp8) and the residual stream fit");
static_assert(WS_H + (size_t)T * 1024 * 2 <= WS_ARENA, "H fits");
constexpr size_t AR_QKVA = 0;
constexpr size_t AR_Q = 66 * MiB;
constexpr size_t AR_K = AR_Q + 198 * MiB;
constexpr size_t AR_V = AR_K + 198 * MiB;
static_assert(AR_V + 132 * MiB <= 600 * MiB, "mla arena");
constexpr size_t AR_HID = 0;
static_assert((size_t)(T + 2048) * 3584 * 2 <= 600 * MiB, "moe hid fits");
constexpr size_t AR_UPRE = 0, AR_GATE = 132 * MiB, AR_U = 264 * MiB;
constexpr size_t AR_PART = 480 * MiB;
static_assert(AR_PART + 64 * MiB <= 600 * MiB && (size_t)(T + 2048) * 3584 * 2 <= AR_PART, "partials");
constexpr int MOE_ROWS = T + 2048;
constexpr size_t RT_E = 0, RT_RANK = RT_E + (size_t)T * 2 * 4, RT_G = RT_RANK + (size_t)T * 2 * 4, RT_TOK = RT_G + (size_t)T * 2 * 4, RT_GV = RT_TOK + (size_t)MOE_ROWS * 2 * 4;
constexpr size_t RT_BLK = RT_GV + (size_t)MOE_ROWS * 2 * 4;
static_assert(RT_BLK + 256 * 16 * 4 <= 3 * MiB, "routing fits");
constexpr int CW_BAR = 4096;
constexpr int CW_SCANF = 32768;
constexpr int CW_ERR = 24000;
constexpr int CW_CNT = 16384;

constexpr int RING_BYTES = 131072;
constexpr int EPI_OFF = RING_BYTES;
constexpr int MISC_OFF = EPI_OFF + 16384;
constexpr int LDS_BYTES = MISC_OFF + 256;

__device__ __forceinline__ int opaque_tid() { int t = threadIdx.x; asm volatile("" : "+v"(t)); return t; }
#define LDS_WAIT() asm volatile("s_waitcnt lgkmcnt(0)" ::: "memory")
#define VM_WAIT() asm volatile("s_waitcnt vmcnt(0)" ::: "memory")
__device__ __forceinline__ float bf2f(unsigned v) { return __uint_as_float(v << 16); }
__device__ __forceinline__ unsigned cvtpk(float lo, float hi) { unsigned r; asm volatile("v_cvt_pk_bf16_f32 %0, %1, %2" : "=v"(r) : "v"(lo), "v"(hi)); return r; }
__device__ __forceinline__ unsigned pk4_fp8(float a, float b, float c, float d) {
    a = __builtin_amdgcn_fmed3f(a, -448.f, 448.f); b = __builtin_amdgcn_fmed3f(b, -448.f, 448.f); c = __builtin_amdgcn_fmed3f(c, -448.f, 448.f); d = __builtin_amdgcn_fmed3f(d, -448.f, 448.f);
    int w = 0; w = __builtin_amdgcn_cvt_pk_fp8_f32(a, b, w, false); w = __builtin_amdgcn_cvt_pk_fp8_f32(c, d, w, true); return (unsigned)w;
}
constexpr float ATT_QS = 0.322672506f, ATT_KS = ATT_QS, ATT_VS = 4.f, ATT_PS = 16.f;
__host__ __device__ __forceinline__ int k8_pos(int d) { const int d0 = d >> 4, hi = (d >> 3) & 1, e = d & 7; return 64 * (d0 >> 2) + 32 * hi + 8 * (d0 & 3) + e; }
__host__ __device__ __forceinline__ int v8_pos(int k) { const int g = k >> 5, kk = k & 31, hi = (kk >> 2) & 1, r = (kk & 3) + 4 * (kk >> 3); return 32 * hi + 16 * g + r; }
constexpr int FFN_F8_MASK = 2;
constexpr float F8_ACT = 8.f, F8_WGT = 64.f, F8_INV = 1.f / (F8_ACT * F8_WGT);
__device__ __forceinline__ float ex2(float x) { return __builtin_amdgcn_exp2f(x); }
__device__ __forceinline__ float fexp(float x) { return __builtin_amdgcn_exp2f(x * 1.4426950408889634f); }
__device__ __forceinline__ float sigm(float x) { return __builtin_amdgcn_rcpf(1.f + fexp(-x)); }
__device__ __forceinline__ float silu_f(float x) { return x * sigm(x); }
__device__ __forceinline__ float gelu_tanh_f(float x) { return x * sigm(1.5957691216057308f * (x + 0.044715f * x * x * x)); }
template <int K> __device__ __forceinline__ float lane_xor(float v) {
    return __int_as_float(__builtin_amdgcn_ds_swizzle(__float_as_int(v), 0x1f | (K << 10)));
}
__device__ __forceinline__ float half_sum(float v) {
    auto rr = __builtin_amdgcn_permlane32_swap(__float_as_uint(v), __float_as_uint(v), false, false); return __uint_as_float(rr[0]) + __uint_as_float(rr[1]);
}
__device__ __forceinline__ float wave_sum(float v) {
    v += lane_xor<1>(v); v += lane_xor<2>(v); v += lane_xor<4>(v); v += lane_xor<8>(v); v += lane_xor<16>(v); return half_sum(v);
}
template <int N> __device__ __forceinline__ float row_shr(float v, float fill) {
    return __int_as_float(__builtin_amdgcn_update_dpp(__float_as_int(fill), __float_as_int(v), 0x110 + N, 0xf, 0xf, false));
}
__device__ __forceinline__ void unpack8(u32x4 w, float (&f)[8]) {
    f[0] = bf2f(w.x & 0xffffu); f[1] = __uint_as_float(w.x & 0xffff0000u); f[2] = bf2f(w.y & 0xffffu); f[3] = __uint_as_float(w.y & 0xffff0000u);
    f[4] = bf2f(w.z & 0xffffu); f[5] = __uint_as_float(w.z & 0xffff0000u); f[6] = bf2f(w.w & 0xffffu); f[7] = __uint_as_float(w.w & 0xffff0000u);
}
__device__ __forceinline__ u32x4 pack8(const float (&f)[8]) { u32x4 w; w.x = cvtpk(f[0], f[1]); w.y = cvtpk(f[2], f[3]); w.z = cvtpk(f[4], f[5]); w.w = cvtpk(f[6], f[7]); return w; }

#define XB_TMO      128
#define XB_XCNT(j)  (256  + 64 * (j))
#define XB_XSUB(j)  (1280 + 64 * (j))
#define XB_XGEN(j)  (2304 + 64 * (j))
#define XB_TOP      3328
#define XB_TOPGEN   3392
#define XCD_BAR_WORDS 3456
#define XB_SPIN_CAP (1u << 21)
__device__ __forceinline__ unsigned xb_ld(unsigned* p)              { return __hip_atomic_load(p, __ATOMIC_RELAXED, __HIP_MEMORY_SCOPE_AGENT); }
__device__ __forceinline__ unsigned xb_add(unsigned* p, unsigned v) { return __hip_atomic_fetch_add(p, v, __ATOMIC_RELAXED, __HIP_MEMORY_SCOPE_AGENT); }
__device__ __forceinline__ unsigned xb_xcc_id() { return (unsigned)__builtin_amdgcn_s_getreg((3 << 11) | 20) & 0xFu; }
#define XB_SPIN(cond, bar) do { unsigned _sp = 0; while (cond) { __builtin_amdgcn_s_sleep(1); \
    if ((++_sp & 255u) == 0u) { if (xb_ld(&(bar)[XB_TMO])) break; if (_sp > XB_SPIN_CAP) { atomicAdd(&(bar)[XB_TMO], 1u); break; } } } } while (0)
struct XcdBarrier { unsigned* bar; unsigned x; volatile LAS unsigned* st; };
__device__ __forceinline__ XcdBarrier xcd_barrier_post(unsigned* bar, volatile LAS unsigned* st) {
    XcdBarrier b; b.bar = bar; b.x = xb_xcc_id(); b.st = st;
    if (threadIdx.x == 0) (void)xb_add(&bar[XB_XCNT(b.x)], 1u);
    return b;
}
__device__ __forceinline__ void xcd_barrier_complete(unsigned* bar, unsigned x, unsigned& nloc, unsigned& nx) {
    const unsigned G = gridDim.x * gridDim.y * gridDim.z;
    unsigned sum, cnt, mine, sp = 0u;
    for (;;) {
        sum = 0u; cnt = 0u; mine = 0u;
#pragma unroll
        for (unsigned j = 0; j < 16; ++j) { const unsigned c = xb_ld(&bar[XB_XCNT(j)]); sum += c; cnt += (c > 0u) ? 1u : 0u; mine = (j == x) ? c : mine; }
        if (sum == G) break;
        __builtin_amdgcn_s_sleep(1);
        if ((++sp & 255u) == 0u) { if (xb_ld(&bar[XB_TMO])) break; if (sp > XB_SPIN_CAP) { atomicAdd(&bar[XB_TMO], 1u); break; } }
    }
    nloc = mine > 0u ? mine : 1u; nx = cnt > 0u ? cnt : 1u;
}
__device__ __forceinline__ void xcd_barrier(const XcdBarrier& b) {
    asm volatile("s_waitcnt vmcnt(0)" ::: "memory");
    __syncthreads();
    if (threadIdx.x == 0) {
        unsigned* bar = b.bar;
        __builtin_amdgcn_s_waitcnt(0);
        unsigned nloc = b.st[0], nx = b.st[1];
        if (nloc == 0u) { xcd_barrier_complete(bar, b.x, nloc, nx); b.st[0] = nloc; b.st[1] = nx; }
        const unsigned old = xb_add(&bar[XB_XSUB(b.x)], 1u);
        const unsigned gen = old / nloc;
        if (old + 1u == (gen + 1u) * nloc) {
            __builtin_amdgcn_fence(__ATOMIC_RELEASE, "agent");
            asm volatile("s_waitcnt vmcnt(0)" ::: "memory");
            const unsigned og = xb_add(&bar[XB_TOP], 1u);
            const unsigned tg = og / nx;
            if (og + 1u == (tg + 1u) * nx) xb_add(&bar[XB_TOPGEN], 1u);
            else XB_SPIN(xb_ld(&bar[XB_TOPGEN]) == tg, bar);
            __builtin_amdgcn_fence(__ATOMIC_ACQUIRE, "agent");
            xb_add(&bar[XB_XGEN(b.x)], 1u);
            asm volatile("s_waitcnt vmcnt(0)" ::: "memory");
        } else {
            XB_SPIN(xb_ld(&bar[XB_XGEN(b.x)]) == gen, bar);
            __builtin_amdgcn_fence(__ATOMIC_ACQUIRE, "agent");
            asm volatile("s_waitcnt vmcnt(0)" ::: "memory");
        }
    }
    __syncthreads();
}

namespace pg8 {
constexpr int BM = 256, BK = 64, HALF = 128, HTB = HALF * BK * 2, STAGE_BYTES = 8 * HTB, NXCD = 8, WGM = 4;
__host__ __device__ __forceinline__ int lds_byte(int r, int c) { const int st = (r >> 4) * 2 + (c >> 5), rr = r & 15, cc = c & 31, ob = rr * 64 + cc * 2; return st * 1024 + (ob ^ (((ob >> 9) & 1) << 5)); }
__host__ __device__ __forceinline__ void stage_rc(int b, int& R, int& C) { const int st = b / 1024, sb = b % 1024, swz = sb ^ (((sb >> 9) & 1) << 5); R = (st >> 1) * 16 + swz / 64; C = (st & 1) * 32 + (swz % 64) / 2; }
__device__ __forceinline__ void tile_of(int L, int nM, int nN, int& pm, int& pn) {
    const int nwg = nM * nN; int wgid = L;
    { const int q = nwg / NXCD, r = nwg % NXCD, xcd = wgid % NXCD, off = wgid / NXCD; wgid = (xcd < r ? xcd * (q + 1) : r * (q + 1) + (xcd - r) * q) + off; }
    const int nig = WGM * nN, gid = wgid / nig, fm = gid * WGM, gsz = (nM - fm) < WGM ? (nM - fm) : WGM;
    pm = fm + ((wgid % nig) % gsz); pn = (wgid % nig) / gsz;
}
struct Unit { const char* A; const char* B; int pm, pn, t, nt, sub; };

template <class Epi, class Sched, bool FP8>
__device__ __forceinline__ void gemm_phase_impl(LAS unsigned char* lds, const int ldbB, const Sched& S, const Epi& E) {
    const int tid = opaque_tid(), wid = __builtin_amdgcn_readfirstlane(tid >> 6), lane = tid & 63, wr = wid >> 2, wc = wid & 3, fr = lane & 15, fq = lane >> 4;
    unsigned voffB[2];
#pragma unroll
    for (int i = 0; i < 2; ++i) { int R, C; stage_rc(tid * 16 + i * 8192, R, C); voffB[i] = (unsigned)(R * ldbB + C * 2); }
#define PG8_AOFFS(u, o0, o1) do { int _t = tid; asm volatile("" : "+v"(_t)); _Pragma("unroll") for (int _i = 0; _i < 2; ++_i) { int _R, _C; stage_rc(_t * 16 + _i * 8192, _R, _C); \
        o0[_i] = S.aoff(u, _R) + (unsigned)_C * 2u; o1[_i] = S.aoff(u, HALF + _R) + (unsigned)_C * 2u; } } while (0)
    const size_t kstep = (size_t)(BK * 2);
    const size_t hstepB = (size_t)HALF * ldbB;
    const unsigned ldsw = (unsigned)wid * 1024u;
    const int aoff = lds_byte(wr * 64 + fr, fq * 8), boff = lds_byte(wc * 32 + fr, fq * 8);
#define PG8_SA(b, h) (((b) * 2 + (h)) * HTB)
#define PG8_SB(b, h) ((4 + (b) * 2 + (h)) * HTB)
#define PG8_STAGE(bufoff, gbase, voff) do { _Pragma("unroll") for (int _i = 0; _i < 2; ++_i) { unsigned _o = (voff)[_i]; asm volatile("" : "+v"(_o));     \
        __builtin_amdgcn_global_load_lds((const unsigned*)((const char*)(gbase) + _o), (LAS unsigned*)(lds + (bufoff) + ldsw + _i * 8192), 16, 0, 0); } } while (0)
#define PG8_LDA(dst, b, h) do { if constexpr (FP8) { _Pragma("unroll") for (int m = 0; m < 4; ++m) { dst##8[m].lo = *(const LAS i32x4*)(lds + PG8_SA(b, h) + aoff + m * 2048); dst##8[m].hi = *(const LAS i32x4*)(lds + PG8_SA(b, h) + aoff + m * 2048 + 1024); } } \
        else { _Pragma("unroll") for (int m = 0; m < 4; ++m) _Pragma("unroll") for (int k = 0; k < 2; ++k) dst[m][k] = *(const LAS bf16x8*)(lds + PG8_SA(b, h) + aoff + m * 2048 + k * 1024); } } while (0)
#define PG8_LDB(dst, b, h) do { if constexpr (FP8) { _Pragma("unroll") for (int n = 0; n < 2; ++n) { dst##8[n].lo = *(const LAS i32x4*)(lds + PG8_SB(b, h) + boff + n * 2048); dst##8[n].hi = *(const LAS i32x4*)(lds + PG8_SB(b, h) + boff + n * 2048 + 1024); } } \
        else { _Pragma("unroll") for (int n = 0; n < 2; ++n) _Pragma("unroll") for (int k = 0; k < 2; ++k) dst[n][k] = *(const LAS bf16x8*)(lds + PG8_SB(b, h) + boff + n * 2048 + k * 1024); } } while (0)
#define PG8_CAT(x0, x1) __builtin_shufflevector(__builtin_bit_cast(i32x4, x0), __builtin_bit_cast(i32x4, x1), 0, 1, 2, 3, 4, 5, 6, 7)
#define PG8_MMA(ai, bj, At, Bt) do { __builtin_amdgcn_s_setprio(1); \
        if constexpr (FP8) { _Pragma("unroll") for (int m = 0; m < 4; ++m) _Pragma("unroll") for (int n = 0; n < 2; ++n) \
            asm volatile("v_mfma_f32_16x16x128_f8f6f4 %0, %1, %2, %0" : "+v"(acc[ai][bj][m][n]) : "v"(Bt##8[n]), "v"(At##8[m])); } \
        else { _Pragma("unroll") for (int m = 0; m < 4; ++m) _Pragma("unroll") for (int n = 0; n < 2; ++n) _Pragma("unroll") for (int k = 0; k < 2; ++k) \
            acc[ai][bj][m][n] = __builtin_amdgcn_mfma_f32_16x16x32_bf16(Bt[n][k], At[m][k], acc[ai][bj][m][n], 0, 0, 0); } \
        __builtin_amdgcn_s_setprio(0); } while (0)
#define PG8_WAIT_V(n) asm volatile("s_waitcnt vmcnt(" #n ")" ::: "memory")
#define PG8_WAIT_L(n) asm volatile("s_waitcnt lgkmcnt(" #n ")" ::: "memory")
#define PG8_BAR __builtin_amdgcn_s_barrier()
#define PG8_SCHED __builtin_amdgcn_sched_barrier(0)
    Unit cur, nxt; int ui = 0;
    if (!S.next(0, cur)) return;
    f32x4 acc[2][2][4][2];
    E.init(acc, cur, wr, wc, fr, fq);
    bf16x8 At[4][2], B0[2][2], B1[2][2];
    i32x8 At8[4], B08[2], B18[2];
    unsigned vA0[2], vA1[2], nA0[2], nA1[2];
    PG8_AOFFS(cur, vA0, vA1);
    const char* cA = cur.A; const char* cB = cur.B;
    PG8_STAGE(PG8_SB(0, 0), cB, voffB); PG8_STAGE(PG8_SB(0, 1), cB + hstepB, voffB); PG8_STAGE(PG8_SA(0, 0), cA, vA0); PG8_STAGE(PG8_SA(0, 1), cA, vA1);
    if (wr == 1) PG8_BAR;
    PG8_WAIT_V(2); PG8_BAR;
    PG8_STAGE(PG8_SB(1, 0), cB + kstep, voffB); PG8_STAGE(PG8_SA(1, 0), cA + kstep, vA0); PG8_STAGE(PG8_SB(1, 1), cB + hstepB + kstep, voffB);
    PG8_WAIT_V(6); PG8_BAR;
    for (;;) {
        const bool has_next = S.next(ui + 1, nxt);
        if (Sched::UNIT_A && has_next) { PG8_AOFFS(nxt, nA0, nA1); }
        else {
#pragma unroll
            for (int i = 0; i < 2; ++i) { nA0[i] = vA0[i]; nA1[i] = vA1[i]; }
        }
        const char* nA = has_next ? nxt.A : cA; const char* nB = has_next ? nxt.B : cB;
        const int nt = cur.nt;
        for (int t = 0; t < nt; t += 2) {
            const bool last = (t == nt - 2);
            const char* a1 = cA + (size_t)(t + 1) * kstep;
            const char* a2 = last ? nA : cA + (size_t)(t + 2) * kstep; const char* b2 = last ? nB : cB + (size_t)(t + 2) * kstep;
            const char* a3 = a2 + kstep; const char* b3 = b2 + kstep;
            unsigned w0[2], w1[2];
#pragma unroll
            for (int i = 0; i < 2; ++i) { w0[i] = last ? nA0[i] : vA0[i]; w1[i] = last ? nA1[i] : vA1[i]; }
            PG8_LDB(B0, 0, 0); PG8_LDB(B1, 0, 1); PG8_SCHED; PG8_LDA(At, 0, 0); PG8_STAGE(PG8_SA(1, 1), a1, vA1);
            PG8_WAIT_V(8); PG8_WAIT_L(0); PG8_BAR; PG8_MMA(0, 0, At, B0); PG8_MMA(0, 1, At, B1); PG8_BAR; PG8_SCHED;
            PG8_LDA(At, 0, 1); PG8_STAGE(PG8_SB(0, 0), b2, voffB); PG8_STAGE(PG8_SB(0, 1), b2 + hstepB, voffB); PG8_STAGE(PG8_SA(0, 0), a2, w0);
            PG8_WAIT_V(8); PG8_WAIT_L(0); PG8_BAR; PG8_MMA(1, 0, At, B0); PG8_MMA(1, 1, At, B1); PG8_BAR; PG8_SCHED;
            PG8_LDB(B0, 1, 0); PG8_LDB(B1, 1, 1); PG8_SCHED; PG8_LDA(At, 1, 0); PG8_STAGE(PG8_SA(0, 1), a2, w1);
            PG8_WAIT_V(8); PG8_WAIT_L(0); PG8_BAR; PG8_MMA(0, 0, At, B0); PG8_MMA(0, 1, At, B1); PG8_BAR; PG8_SCHED;
            PG8_LDA(At, 1, 1); PG8_STAGE(PG8_SB(1, 0), b3, voffB); PG8_STAGE(PG8_SB(1, 1), b3 + hstepB, voffB); PG8_STAGE(PG8_SA(1, 0), a3, w0);
            PG8_WAIT_V(8); PG8_WAIT_L(0); PG8_BAR; PG8_MMA(1, 0, At, B0); PG8_MMA(1, 1, At, B1); PG8_BAR; PG8_SCHED;
        }
        if (wr == 0) PG8_BAR;
        if constexpr (FP8) asm volatile("s_nop 15\n\ts_nop 15" ::: "memory");
        { int l2 = lane; asm volatile("" : "+v"(l2));
          E(acc, cur, wr, wc, l2 & 15, l2 >> 4, l2, wid);
          if (!has_next) break;
          E.init(acc, nxt, wr, wc, l2 & 15, l2 >> 4); }
        cur = nxt; cA = nA; cB = nB; ++ui;
#pragma unroll
        for (int i = 0; i < 2; ++i) { vA0[i] = nA0[i]; vA1[i] = nA1[i]; }
        if (wr == 1) PG8_BAR;
    }
    PG8_WAIT_V(0);
    PG8_BAR;
#undef PG8_AOFFS
#undef PG8_CAT
#undef PG8_SA
#undef PG8_SB
#undef PG8_STAGE
#undef PG8_LDA
#undef PG8_LDB
#undef PG8_MMA
#undef PG8_WAIT_V
#undef PG8_WAIT_L
#undef PG8_BAR
#undef PG8_SCHED
}
template <class Epi, class Sched> __device__ __forceinline__ void gemm_phase(LAS unsigned char* lds, const int, const int ldb, const Sched& S, const Epi& E) { gemm_phase_impl<Epi, Sched, false>(lds, ldb * 2, S, E); }
template <class Epi, class Sched> __device__ __forceinline__ void gemm_phase_f8(LAS unsigned char* lds, const int ldbB, const Sched& S, const Epi& E) { gemm_phase_impl<Epi, Sched, true>(lds, ldbB, S, E); }
}
using pg8::Unit;

__host__ __device__ __forceinline__ int phys_of_logical(int ll) { return (ll & ~31) | (((ll >> 2) & 1) << 4) | (((ll >> 3) & 3) << 2) | (ll & 3); }
__host__ __device__ __forceinline__ int phys_of_pair(int hl, int n) { return 128 * ((hl >> 2) & 1) + 32 * (hl >> 5) + 16 * n + 4 * ((hl >> 3) & 3) + (hl & 3); }

struct Args { const float* in[34]; float* out; unsigned char* ws; };
struct Frame {
    LAS unsigned char* lds;
    int tid, lane, wave, vcu, G, bx;
};
typedef const Args __attribute__((address_space(4)))* KArgs;
#define ARGS() ({ KArgs _p = (KArgs)__builtin_amdgcn_kernarg_segment_ptr(); asm volatile("" : "+s"(_p)); _p; })
__device__ __forceinline__ int row_vec(int row) { return row < TL ? (row >> 13) : NB; }

struct Split { int F, Lf, S; };
__device__ __forceinline__ Split make_split(int U, int G, int pairs, bool enable) {
    Split sp; sp.F = enable ? (U / G) * G : U; sp.Lf = U - sp.F; int S = sp.Lf ? G / sp.Lf : 1; S = S > 8 ? 8 : S; S = S > pairs ? pairs : S; sp.S = S < 1 ? 1 : S;
    if (sp.S == 1) { sp.F = U; sp.Lf = 0; }
    return sp;
}
struct SchedPlain {
    static constexpr bool UNIT_A = false;
    const char* A; const char* B; int lda2, ldb2, nM, nN, G, c, tsplit, ntf; Split sp;
    __device__ __forceinline__ bool next(int i, Unit& u) const {
        const int L = i * G + c; int ui, p0 = 0, p1 = ntf >> 1; u.sub = -1;
        if (L < sp.F) ui = L;
        else { const int q = L - sp.F; if (q >= sp.Lf * sp.S) return false; const int l = q % sp.Lf, si = q / sp.Lf; ui = sp.F + l; u.sub = l * sp.S + si; p0 = si * p1 / sp.S; p1 = (si + 1) * p1 / sp.S; }
        pg8::tile_of(ui, nM, nN, u.pm, u.pn); u.t = u.pn >= tsplit ? 1 : 0; u.nt = 2 * (p1 - p0);
        u.A = A + (size_t)u.pm * 256 * lda2 + p0 * 256; u.B = B + (size_t)u.pn * 256 * ldb2 + p0 * 256; return true;
    }
    __device__ __forceinline__ unsigned aoff(const Unit&, int r) const { return (unsigned)(r * lda2); }
};
struct SchedA3 {
    static constexpr bool UNIT_A = false;
    const char* A; const char* B; int nM, G, c;
    __device__ __forceinline__ bool next(int i, Unit& u) const {
        const int L = i * G + c; if (L >= nM * 14) return false;
        pg8::tile_of(L, nM, 14, u.pm, u.pn); u.t = u.pn < 6 ? 0 : (u.pn < 10 ? 1 : 2); u.nt = 4; u.sub = -1;
        u.A = A + (size_t)u.pm * 256 * 1024 + (u.pn < 6 ? 0 : 512); u.B = B + (size_t)u.pn * 256 * 512; return true;
    }
    __device__ __forceinline__ unsigned aoff(const Unit&, int r) const { return (unsigned)(r * 1024); }
};
__device__ __forceinline__ int scan_pos(int r) { return (((r >> 6) & 1) * 16 + (r & 15)) * 8 + ((r >> 7) * 4 + ((r >> 4) & 3)); }
__device__ __forceinline__ int chain_tile(int b, int d, int p) { return p == 0 ? 256 + b : (d ? b * 32 + 32 - p : b * 32 + p - 1); }
struct SchedScan {
    static constexpr bool UNIT_A = true;
    const char* A; const char* B; int d, G, c;
    __device__ __forceinline__ bool next(int i, Unit& u) const {
        const int L = i * G + c; if (L >= 33 * 64) return false;
        const int q = L >> 6, b = (L >> 3) & 7, hh = L & 7;
        u.pm = chain_tile(b, d, q); u.pn = d * 8 + hh; u.t = q; u.nt = 4; u.sub = -1;
        u.A = A + (size_t)u.pm * 256 * 2048 + (hh >> 1) * 512; u.B = B + (size_t)u.pn * 256 * 512; return true;
    }
    __device__ __forceinline__ unsigned aoff(const Unit&, int r) const { const int s = scan_pos(r); return (unsigned)((d ? 255 - s : s) * 2048); }
};
struct MoeTiles { int ts[NE + 1]; };
__device__ __forceinline__ void moe_tiles(const unsigned* cnt, MoeTiles& mt) {
    int a = 0;
#pragma unroll
    for (int e = 0; e < NE; ++e) { mt.ts[e] = a; a += (int)((cnt[64 * e] + 255u) >> 8); }
    mt.ts[NE] = a;
}
__device__ __forceinline__ int moe_ts_of(const MoeTiles& mt, int e) { int r = 0;
#pragma unroll
    for (int k = 0; k < NE; ++k) r = (e == k) ? mt.ts[k] : r;
    return r; }
__device__ __forceinline__ int moe_expert_of(const MoeTiles& mt, int pm) { int e = 0;
#pragma unroll
    for (int k = 1; k < NE; ++k) e += (pm >= mt.ts[k]) ? 1 : 0;
    return e; }
struct SchedMoeUp {
    static constexpr bool UNIT_A = true;
    const char* A; const char* B; const int* tok; MoeTiles mt; int G, c;
    __device__ __forceinline__ bool next(int i, Unit& u) const {
        const int nM = mt.ts[NE]; const int L = i * G + c; if (L >= nM * 28) return false;
        pg8::tile_of(L, nM, 28, u.pm, u.pn); u.t = moe_expert_of(mt, u.pm); u.nt = 8; u.sub = -1;
        u.A = A; u.B = B + ((size_t)u.t * 7168 + (size_t)u.pn * 256) * 1024; return true;
    }
    __device__ __forceinline__ unsigned aoff(const Unit& u, int r) const { int tk = tok[u.pm * 256 + r]; tk = tk < 0 ? 0 : tk; return (unsigned)tk * 1024u; }
};
struct SchedMoeDown {
    static constexpr bool UNIT_A = false;
    const char* A; const char* B; MoeTiles mt; int G, c; Split sp;
    __device__ __forceinline__ bool next(int i, Unit& u) const {
        const int nM = mt.ts[NE]; const int L = i * G + c; int ui, p0 = 0, p1 = 14; u.sub = -1;
        if (L < sp.F) ui = L;
        else { const int q = L - sp.F; if (q >= sp.Lf * sp.S) return false; const int l = q % sp.Lf, si = q / sp.Lf; ui = sp.F + l; u.sub = l * sp.S + si; p0 = si * 14 / sp.S; p1 = (si + 1) * 14 / sp.S; }
        pg8::tile_of(ui, nM, 4, u.pm, u.pn); u.t = moe_expert_of(mt, u.pm); u.nt = 2 * (p1 - p0);
        u.A = A + (size_t)u.pm * 256 * 3584 + p0 * 256; u.B = B + ((size_t)u.t * 1024 + (size_t)u.pn * 256) * 3584 + p0 * 256; return true;
    }
    __device__ __forceinline__ unsigned aoff(const Unit&, int r) const { return (unsigned)(r * 3584); }
};

typedef f32x4 Acc[2][2][4][2];
struct EpiZero {
    __device__ __forceinline__ void init(Acc& acc, const Unit&, int, int, int, int) const {
#pragma unroll
        for (int a = 0; a < 2; ++a)
#pragma unroll
            for (int b = 0; b < 2; ++b)
#pragma unroll
                for (int m = 0; m < 4; ++m)
#pragma unroll
                    for (int n = 0; n < 2; ++n) acc[a][b][m][n] = (f32x4){0.f, 0.f, 0.f, 0.f};
    }
};
template <int LDC, int BS, int ACT>
__device__ __forceinline__ void epi_store_tile(const Acc& acc, bf16* dst, int pm, int ct, int wr, int wc, int fr, int fq) {
    bf16* p0 = dst + (size_t)(pm * 256 + wr * 64 + fr) * LDC + ct * (2 * BS) + wc * 32 + fq * 8;
#pragma unroll
    for (int ai = 0; ai < 2; ++ai)
#pragma unroll
        for (int m = 0; m < 4; ++m) { bf16* rowp = p0 + (size_t)(ai * 128 + m * 16) * LDC;
#pragma unroll
            for (int bj = 0; bj < 2; ++bj) { f32x4 v0 = acc[ai][bj][m][0], v1 = acc[ai][bj][m][1];
                if (ACT) {
#pragma unroll
                    for (int j = 0; j < 4; ++j) { v0[j] = gelu_tanh_f(v0[j]); v1[j] = gelu_tanh_f(v1[j]); } }
                u32x4 w; w.x = cvtpk(v0[0], v0[1]); w.y = cvtpk(v0[2], v0[3]); w.z = cvtpk(v1[0], v1[1]); w.w = cvtpk(v1[2], v1[3]);
                *(u32x4*)(rowp + bj * BS) = w; } }
}
struct EpiStore1 : EpiZero {
    bf16* b0; const float* gq; const float* gkv; LAS unsigned char* scr;
    __device__ __forceinline__ void operator()(const Acc& acc, const Unit& u, int wr, int wc, int fr, int fq, int, int) const {
        LAS float* P = (LAS float*)scr;
        const bool qt = u.pn == 0;
#pragma unroll
        for (int ai = 0; ai < 2; ++ai)
#pragma unroll
            for (int m = 0; m < 4; ++m) { float s = 0.f;
#pragma unroll
                for (int bj = 0; bj < 2; ++bj)
#pragma unroll
                    for (int n = 0; n < 2; ++n) { const f32x4 x = acc[ai][bj][m][n]; const float t = (x[0] * x[0] + x[1] * x[1]) + (x[2] * x[2] + x[3] * x[3]); s += (qt || bj == 0) ? t : 0.f; }
                s += lane_xor<16>(s); s = half_sum(s);
                if (fq == 0) P[(ai * 128 + wr * 64 + m * 16 + fr) * 4 + wc] = s; }
        LDS_WAIT(); __builtin_amdgcn_s_barrier(); asm volatile("" ::: "memory");
        const int cl = wc * 32 + fq * 8;
        float g0[8], g1[8];
#pragma unroll
        for (int i = 0; i < 8; ++i) { g0[i] = qt ? gq[cl + i] : gkv[cl + i]; g1[i] = qt ? gq[128 + cl + i] : 1.f; }
        bf16* p0 = b0 + (size_t)(u.pm * 256 + wr * 64 + fr) * 512 + u.pn * 256 + cl;
#pragma unroll
        for (int ai = 0; ai < 2; ++ai)
#pragma unroll
            for (int m = 0; m < 4; ++m) { const int r = ai * 128 + wr * 64 + m * 16 + fr; const f32x4 pv = *(const LAS f32x4*)(P + r * 4);
                const float rstd = rsqrtf(((pv[0] + pv[1]) + (pv[2] + pv[3])) * (qt ? 1.f / 256 : 1.f / 128) + EPS); const float r1 = qt ? rstd : 1.f;
                bf16* rowp = p0 + (size_t)(ai * 128 + m * 16) * 512;
                { const f32x4 v0 = acc[ai][0][m][0], v1 = acc[ai][0][m][1];
                  u32x4 w; w.x = cvtpk(v0[0] * rstd * g0[0], v0[1] * rstd * g0[1]); w.y = cvtpk(v0[2] * rstd * g0[2], v0[3] * rstd * g0[3]); w.z = cvtpk(v1[0] * rstd * g0[4], v1[1] * rstd * g0[5]); w.w = cvtpk(v1[2] * rstd * g0[6], v1[3] * rstd * g0[7]);
                  *(u32x4*)rowp = w; }
                { const f32x4 v0 = acc[ai][1][m][0], v1 = acc[ai][1][m][1];
                  u32x4 w; w.x = cvtpk(v0[0] * r1 * g1[0], v0[1] * r1 * g1[1]); w.y = cvtpk(v0[2] * r1 * g1[2], v0[3] * r1 * g1[3]); w.z = cvtpk(v1[0] * r1 * g1[4], v1[1] * r1 * g1[5]); w.w = cvtpk(v1[2] * r1 * g1[6], v1[3] * r1 * g1[7]);
                  *(u32x4*)(rowp + 128) = w; } }
    }
};
struct EpiStoreQKV : EpiZero {
    bf16* q; unsigned char* k; unsigned char* v; const bf16* qkva; const float* gkn; const float* rope; LAS unsigned char* scr;
    __device__ __forceinline__ void operator()(const Acc& acc, const Unit& u, int wr, int wc, int fr, int fq, int lane, int wid) const {
        if (u.t == 0) { epi_store_tile<1536, 128, 0>(acc, q, u.pm, u.pn, wr, wc, fr, fq); return; }
        if (u.t == 2) {
            const int vt = u.pn - 10, pm = u.pm; const int kb0 = pm < 256 ? (pm >> 5) * 132 + (pm & 31) * 4 : (pm - 256) * 132 + 128;
#pragma unroll
            for (int ai = 0; ai < 2; ++ai)
#pragma unroll
                for (int bj = 0; bj < 2; ++bj) { unsigned char* vb = v + (((size_t)(kb0 + 2 * ai + wr) * 8 + (2 * vt + bj)) * 128 + wc * 32 + fq * 8) * 64;
#pragma unroll
                    for (int m = 0; m < 4; ++m) { const int kp = v8_pos(16 * m + fr);
#pragma unroll
                        for (int n = 0; n < 2; ++n) { const f32x4 x = acc[ai][bj][m][n] * ATT_VS; const unsigned w = pk4_fp8(x[0], x[1], x[2], x[3]);
#pragma unroll
                            for (int jj = 0; jj < 4; ++jj) vb[(4 * n + jj) * 64 + kp] = (unsigned char)(w >> (8 * jj)); } } }
            return; }
        LAS float* P = (LAS float*)scr;
        LAS float* PE = P + 2048;
        const int hp = u.pn - 6, rt = u.pm * 256, tid = wid * 64 + lane;
#pragma unroll
        for (int ai = 0; ai < 2; ++ai)
#pragma unroll
            for (int m = 0; m < 4; ++m)
#pragma unroll
                for (int bj = 0; bj < 2; ++bj) { const f32x4 x0 = acc[ai][bj][m][0], x1 = acc[ai][bj][m][1];
                    float s = ((x0[0] * x0[0] + x0[1] * x0[1]) + (x0[2] * x0[2] + x0[3] * x0[3])) + ((x1[0] * x1[0] + x1[1] * x1[1]) + (x1[2] * x1[2] + x1[3] * x1[3]));
                    s += lane_xor<16>(s); s = half_sum(s);
                    if (fq == 0) P[((ai * 128 + wr * 64 + m * 16 + fr) * 2 + bj) * 4 + wc] = s; }
        const int prow = tid >> 1, half = tid & 1; const int grow = rt + prow;
        u32x4 kw[4];
#pragma unroll
        for (int i = 0; i < 4; ++i) kw[i] = *(const u32x4*)(qkva + (size_t)grow * 512 + 384 + half * 32 + i * 8);
        { float s = 0.f;
#pragma unroll
          for (int i = 0; i < 4; ++i) { float f[8]; unpack8(kw[i], f);
#pragma unroll
              for (int e = 0; e < 8; ++e) s += f[e] * f[e]; }
          s += lane_xor<1>(s);
          if (half == 0) PE[prow] = s; }
        LDS_WAIT(); __builtin_amdgcn_s_barrier(); asm volatile("" ::: "memory");
        { const int cl = wc * 32 + fq * 8; float g[8];
#pragma unroll
          for (int i = 0; i < 8; ++i) g[i] = gkn[cl + i] * ATT_KS;
          unsigned char* p0 = k + (size_t)(rt + wr * 64 + fr) * 1536 + (2 * hp) * 192 + k8_pos(cl);
#pragma unroll
          for (int ai = 0; ai < 2; ++ai)
#pragma unroll
            for (int m = 0; m < 4; ++m) { const int r = ai * 128 + wr * 64 + m * 16 + fr; const float pe = PE[r];
#pragma unroll
                for (int bj = 0; bj < 2; ++bj) { const f32x4 pv = *(const LAS f32x4*)(P + (r * 2 + bj) * 4);
                    const float rstd = rsqrtf((((pv[0] + pv[1]) + (pv[2] + pv[3])) + pe) * (1.f / 192) + EPS);
                    const f32x4 v0 = acc[ai][bj][m][0], v1 = acc[ai][bj][m][1];
                    *(u32x2*)(p0 + (size_t)(ai * 128 + m * 16) * 1536 + bj * 192) = (u32x2){pk4_fp8(v0[0] * rstd * g[0], v0[1] * rstd * g[1], v0[2] * rstd * g[2], v0[3] * rstd * g[3]),
                                                                                           pk4_fp8(v1[0] * rstd * g[4], v1[1] * rstd * g[5], v1[2] * rstd * g[6], v1[3] * rstd * g[7])}; } } }
        { const bool lat = grow < TL; const int pos = grow & (SEQ - 1); const float pe = PE[prow];
          float rs[2];
#pragma unroll
          for (int bj = 0; bj < 2; ++bj) { const f32x4 pv = *(const LAS f32x4*)(P + (prow * 2 + bj) * 4); rs[bj] = rsqrtf((((pv[0] + pv[1]) + (pv[2] + pv[3])) + pe) * (1.f / 192) + EPS) * ATT_KS; }
#pragma unroll
          for (int i = 0; i < 4; ++i) { float f[8]; unpack8(kw[i], f);
              float y[8];
#pragma unroll
              for (int e = 0; e < 8; ++e) { const float gv = gkn[128 + half * 32 + i * 8 + e]; const float x = f[e] * gv; const float other = lane_xor<1>(x);
                  float c = 1.f, sn = 0.f; if (lat) { const f32x2 cs = *(const f32x2*)(rope + ((size_t)pos * 32 + i * 8 + e) * 2); c = cs.x; sn = cs.y; }
                  y[e] = half == 0 ? x * c - other * sn : x * c + other * sn; }
              unsigned char* kp = k + (size_t)grow * 1536 + (2 * hp) * 192 + k8_pos(128 + half * 32 + i * 8);
              *(u32x2*)kp = (u32x2){pk4_fp8(y[0] * rs[0], y[1] * rs[0], y[2] * rs[0], y[3] * rs[0]), pk4_fp8(y[4] * rs[0], y[5] * rs[0], y[6] * rs[0], y[7] * rs[0])};
              *(u32x2*)(kp + 192) = (u32x2){pk4_fp8(y[0] * rs[1], y[1] * rs[1], y[2] * rs[1], y[3] * rs[1]), pk4_fp8(y[4] * rs[1], y[5] * rs[1], y[6] * rs[1], y[7] * rs[1])}; } }
    }
};
struct EpiStoreUG : EpiZero {
    bf16* up; bf16* gate;
    __device__ __forceinline__ void operator()(const Acc& acc, const Unit& u, int wr, int wc, int fr, int fq, int, int) const {
        if (u.t == 0) epi_store_tile<1024, 128, 0>(acc, up, u.pm, u.pn, wr, wc, fr, fq);
        else epi_store_tile<1024, 128, 1>(acc, gate, u.pm, u.pn - 4, wr, wc, fr, fq);
    }
};
__device__ __forceinline__ void store_partial(const Acc& acc, float* part, int sub, int wr, int wc, int fr, int fq) {
    float* p0 = part + (size_t)sub * 65536 + (wr * 64 + fr) * 256 + wc * 32 + 4 * fq;
#pragma unroll
    for (int ai = 0; ai < 2; ++ai)
#pragma unroll
        for (int m = 0; m < 4; ++m)
#pragma unroll
            for (int bj = 0; bj < 2; ++bj)
#pragma unroll
                for (int n = 0; n < 2; ++n) *(f32x4*)(p0 + (ai * 128 + m * 16) * 256 + bj * 128 + n * 16) = acc[ai][bj][m][n];
}
struct EpiResid : EpiZero {
    const float* inL; const float* inC; bf16* xb; const float* gate; float* part; float scale;
    __device__ __forceinline__ void operator()(const Acc& acc, const Unit& u, int wr, int wc, int fr, int fq, int, int) const {
        if (u.sub >= 0) { store_partial(acc, part, u.sub, wr, wc, fr, fq); return; }
        const int rt = u.pm * 256; const bool lat = rt < TL; const bool f32in = inL != nullptr;
        const float* ib = f32in ? (lat ? inL + (size_t)rt * D : inC + (size_t)(rt - TL) * D) : nullptr;
        const float* g = gate + (size_t)row_vec(rt) * 6144;
        const int col0 = u.pn * 256 + wc * 32 + 4 * fq, r0 = wr * 64 + fr;
        f32x4 gv[2][2];
#pragma unroll
        for (int bj = 0; bj < 2; ++bj)
#pragma unroll
            for (int n = 0; n < 2; ++n) gv[bj][n] = *(const f32x4*)(g + col0 + bj * 128 + n * 16) * scale;
        bf16* op = xb + (size_t)(rt + r0) * D + col0;
#pragma unroll
        for (int ai = 0; ai < 2; ++ai)
#pragma unroll
            for (int m = 0; m < 4; ++m) { const int off = (ai * 128 + m * 16) * D;
                f32x4 x[2][2];
                if (f32in) {
#pragma unroll
                    for (int bj = 0; bj < 2; ++bj)
#pragma unroll
                        for (int n = 0; n < 2; ++n) x[bj][n] = *(const f32x4*)(ib + (size_t)r0 * D + col0 + off + bj * 128 + n * 16);
                } else {
#pragma unroll
                    for (int bj = 0; bj < 2; ++bj)
#pragma unroll
                        for (int n = 0; n < 2; ++n) { const u32x2 w = *(const u32x2*)(op + off + bj * 128 + n * 16); x[bj][n] = (f32x4){bf2f(w.x & 0xffffu), __uint_as_float(w.x & 0xffff0000u), bf2f(w.y & 0xffffu), __uint_as_float(w.y & 0xffff0000u)}; }
                }
#pragma unroll
                for (int bj = 0; bj < 2; ++bj)
#pragma unroll
                    for (int n = 0; n < 2; ++n) { const f32x4 y = x[bj][n] + gv[bj][n] * acc[ai][bj][m][n]; *(u32x2*)(op + off + bj * 128 + n * 16) = (u32x2){cvtpk(y[0], y[1]), cvtpk(y[2], y[3])}; }
                asm volatile("" ::: "memory"); }
    }
};
struct EpiSwiglu : EpiZero {
    bf16* hid; int ld;
    __device__ __forceinline__ void operator()(const Acc& acc, const Unit& u, int wr, int wc, int fr, int fq, int, int) const {
        const int row0 = u.pm * 256 + wr * 64 + fr, col0 = u.pn * 128 + wc * 32 + fq * 8;
#pragma unroll
        for (int ai = 0; ai < 2; ++ai)
#pragma unroll
            for (int m = 0; m < 4; ++m) { float v[8];
#pragma unroll
                for (int bj = 0; bj < 2; ++bj)
#pragma unroll
                    for (int j = 0; j < 4; ++j) v[bj * 4 + j] = silu_f(acc[ai][bj][m][0][j]) * acc[ai][bj][m][1][j];
                *(u32x4*)(hid + (size_t)(row0 + ai * 128 + m * 16) * ld + col0) = pack8(v); }
    }
};
struct EpiSwiglu8 : EpiZero {
    unsigned char* hid; int ld;
    __device__ __forceinline__ void operator()(const Acc& acc, const Unit& u, int wr, int wc, int fr, int fq, int, int) const {
        const int row0 = u.pm * 256 + wr * 64 + fr, col0 = u.pn * 128 + wc * 32 + fq * 8;
#pragma unroll
        for (int ai = 0; ai < 2; ++ai)
#pragma unroll
            for (int m = 0; m < 4; ++m) { float v[8];
#pragma unroll
                for (int bj = 0; bj < 2; ++bj)
#pragma unroll
                    for (int j = 0; j < 4; ++j) v[bj * 4 + j] = silu_f(acc[ai][bj][m][0][j] * F8_INV) * (acc[ai][bj][m][1][j] * (F8_INV * F8_ACT));
                *(u32x2*)(hid + (size_t)(row0 + ai * 128 + m * 16) * ld + col0) = (u32x2){pk4_fp8(v[0], v[1], v[2], v[3]), pk4_fp8(v[4], v[5], v[6], v[7])}; }
    }
};
struct EpiMoeDown : EpiZero {
    bf16* xb; float* fin; const float* g2; const int* tok; const float* gv; float* part;
    __device__ __forceinline__ void operator()(const Acc& acc, const Unit& u, int wr, int wc, int fr, int fq, int, int) const {
        if (u.sub >= 0) { store_partial(acc, part, u.sub, wr, wc, fr, fq); return; }
        const int p0 = u.pm * 256 + wr * 64 + fr, col0 = u.pn * 256 + wc * 32 + 4 * fq;
        int tk[2][4]; float gt[2][4];
#pragma unroll
        for (int ai = 0; ai < 2; ++ai)
#pragma unroll
            for (int m = 0; m < 4; ++m) { const int pos = p0 + ai * 128 + m * 16; tk[ai][m] = tok[pos]; gt[ai][m] = gv[pos] * F8_INV; }
#pragma unroll
        for (int ai = 0; ai < 2; ++ai) {
            u32x2 xw[4][2][2];
#pragma unroll
            for (int m = 0; m < 4; ++m) { const bf16* xr = xb + (size_t)(tk[ai][m] >= 0 ? tk[ai][m] : 0) * D + col0;
#pragma unroll
                for (int bj = 0; bj < 2; ++bj)
#pragma unroll
                    for (int n = 0; n < 2; ++n) xw[m][bj][n] = *(const u32x2*)(xr + bj * 128 + n * 16); }
#pragma unroll
            for (int m = 0; m < 4; ++m) { const int t = tk[ai][m];
                if (t >= 0) { bf16* xr = xb + (size_t)t * D + col0; const float* gr = g2 + (size_t)row_vec(t) * 6144 + col0; const float gtv = gt[ai][m];
#pragma unroll
                    for (int bj = 0; bj < 2; ++bj)
#pragma unroll
                        for (int n = 0; n < 2; ++n) { const u32x2 w = xw[m][bj][n]; const f32x4 x = (f32x4){bf2f(w.x & 0xffffu), __uint_as_float(w.x & 0xffff0000u), bf2f(w.y & 0xffffu), __uint_as_float(w.y & 0xffff0000u)};
                            const f32x4 g = *(const f32x4*)(gr + bj * 128 + n * 16);
                            const f32x4 y = x + (g * gtv) * acc[ai][bj][m][n];
                            if (fin) *(f32x4*)(fin + (size_t)t * D + col0 + bj * 128 + n * 16) = y; else *(u32x2*)(xr + bj * 128 + n * 16) = (u32x2){cvtpk(y[0], y[1]), cvtpk(y[2], y[3])}; } }
            }
            asm volatile("" ::: "memory"); }
    }
};
template <int DIR> struct EpiScan {
    const bf16* U; const float* ba; const float* bx; const float* lam;
    float* agg;
    unsigned* flags;
    unsigned* err;
    bf16* hs; const bf16* gate;
    int apply_ctx;
    LAS unsigned char* scr;
    __device__ __forceinline__ void init(Acc& acc, const Unit& u, int, int wc, int, int fq) const {
        const int d = DIR, ch0 = ((u.pn >> 1) & 3) * 256 + (u.pn & 1) * 128 + wc * 32 + fq * 8;
        const LAS float* tab = (const LAS float*)(scr + 4096);
#pragma unroll
        for (int bj = 0; bj < 2; ++bj) { const f32x4 a = *(const LAS f32x4*)(tab + ch0 + bj * 4), x = *(const LAS f32x4*)(tab + 1024 + ch0 + bj * 4);
#pragma unroll
            for (int ai = 0; ai < 2; ++ai)
#pragma unroll
                for (int m = 0; m < 4; ++m) { acc[ai][bj][m][0] = a; acc[ai][bj][m][1] = x; } }
    }
    __device__ __forceinline__ void operator()(Acc& acc, const Unit& u, int wr, int wc, int fr, int fq, int lane, int wid) const {
        const int d = DIR, hh = u.pn & 7, chb = (hh >> 1) * 256 + (hh & 1) * 128, hl0 = wc * 32 + fq * 8, ch0 = chb + hl0;
        LAS float* carry = (LAS float*)scr; LAS f32x2* hagg = (LAS f32x2*)(scr + 1024);
        const int tid = wid * 64 + lane;
        float sp[8];
        { const LAS float* tab = (const LAS float*)(scr + 4096); const f32x4 s0v = *(const LAS f32x4*)(tab + 2048 + ch0), s1v = *(const LAS f32x4*)(tab + 2048 + ch0 + 4);
          sp[0] = s0v[0]; sp[1] = s0v[1]; sp[2] = s0v[2]; sp[3] = s0v[3]; sp[4] = s1v[0]; sp[5] = s1v[1]; sp[6] = s1v[2]; sp[7] = s1v[3]; }
        const int s0 = (wr * 16 + fr) * 8;
        const int rowb = u.pm * 256 + (d ? 255 - s0 : s0), rstep = d ? -1 : 1;
        float Ar[8], Br[8];
#pragma unroll
        for (int c = 0; c < 8; ++c) { Ar[c] = 1.f; Br[c] = 0.f; }
#pragma unroll
        for (int ai = 0; ai < 2; ++ai)
#pragma unroll
            for (int m = 0; m < 4; ++m) { const int trow = rowb + (ai * 4 + m) * rstep;
                float uf[8]; unpack8(*(const u32x4*)(U + (size_t)trow * D + ch0), uf);
#pragma unroll
                for (int bj = 0; bj < 2; ++bj)
#pragma unroll
                    for (int j = 0; j < 4; ++j) { const int c = bj * 4 + j;
                        const float r = sigm(acc[ai][bj][m][0][j]), ig = sigm(acc[ai][bj][m][1][j]);
                        const float a = ex2(sp[c] * r); const float bb = sqrtf(fmaxf(1.f - a * a, 0.f)) * (ig * uf[c]);
                        acc[ai][bj][m][0][j] = a; acc[ai][bj][m][1][j] = bb;
                        Br[c] = a * Br[c] + bb; Ar[c] = Ar[c] * a; }
                asm volatile("" ::: "memory"); }
#define SCAN_STEP(DL) do { _Pragma("unroll") for (int c = 0; c < 8; ++c) { const float ap = row_shr<DL>(Ar[c], 1.f), bp = row_shr<DL>(Br[c], 0.f);     \
            Br[c] = Ar[c] * bp + Br[c]; Ar[c] = Ar[c] * ap; } } while (0)
        SCAN_STEP(1); SCAN_STEP(2); SCAN_STEP(4); SCAN_STEP(8);
#undef SCAN_STEP
        if (wr == 0 && fr == 15) {
#pragma unroll
            for (int c = 0; c < 8; ++c) hagg[hl0 + c] = (f32x2){Ar[c], Br[c]};
        }
        LDS_WAIT(); __builtin_amdgcn_s_barrier(); asm volatile("" ::: "memory");
        if (wr == 1 && fr == 15) {
#pragma unroll
            for (int c = 0; c < 8; ++c) { const f32x2 h0 = hagg[hl0 + c]; const float ta = h0.x * Ar[c], tb = Ar[c] * h0.y + Br[c];
                __hip_atomic_store((unsigned long long*)(agg + (((size_t)u.pm * 2 + d) * 1024 + ch0 + c) * 2), ((unsigned long long)__float_as_uint(tb) << 32) | __float_as_uint(ta), __ATOMIC_RELAXED, __HIP_MEMORY_SCOPE_AGENT); }
        }
        asm volatile("s_waitcnt vmcnt(0)" ::: "memory"); __builtin_amdgcn_s_barrier(); asm volatile("" ::: "memory");
        if (tid == 0) __hip_atomic_store(flags + (d * 264 + u.pm) * 8 + hh, 1u, __ATOMIC_RELAXED, __HIP_MEMORY_SCOPE_AGENT);
        if (tid < 128) {
            const int pm = u.pm; const int b = pm < 256 ? (pm >> 5) : pm - 256; const int q = u.t;
            const unsigned* fp = flags + (d * 264 + chain_tile(b, d, lane < q ? lane : 0)) * 8 + hh;
            bool done = lane >= q; unsigned spins = 0;
            while (!__all(done)) {
                if (!done) done = __hip_atomic_load(fp, __ATOMIC_RELAXED, __HIP_MEMORY_SCOPE_AGENT) != 0u;
                if (++spins > (1u << 20)) { if (lane == 0) __hip_atomic_store(err, 1u, __ATOMIC_RELAXED, __HIP_MEMORY_SCOPE_AGENT); break; }
                if ((spins & 255u) == 0u && __hip_atomic_load(err, __ATOMIC_RELAXED, __HIP_MEMORY_SCOPE_AGENT) != 0u) break;
                __builtin_amdgcn_s_sleep(1);
            }
            __builtin_amdgcn_fence(__ATOMIC_ACQUIRE, "agent");
            float h = 0.f;
            for (int p0 = 0; p0 < q; p0 += 4) {
                unsigned long long w[4];
#pragma unroll
                for (int k = 0; k < 4; ++k) { const int p = p0 + k < q ? p0 + k : 0;
                    w[k] = __hip_atomic_load((const unsigned long long*)(agg + (((size_t)chain_tile(b, d, p) * 2 + d) * 1024 + chb + tid) * 2), __ATOMIC_RELAXED, __HIP_MEMORY_SCOPE_AGENT); }
#pragma unroll
                for (int k = 0; k < 4; ++k) if (p0 + k < q) h = __uint_as_float((unsigned)w[k]) * h + __uint_as_float((unsigned)(w[k] >> 32));
            }
            carry[tid] = h;
        }
        LDS_WAIT(); __builtin_amdgcn_s_barrier(); asm volatile("" ::: "memory");
        if (u.pm < 256 || apply_ctx) {
            float h[8];
#pragma unroll
            for (int c = 0; c < 8; ++c) { const float ae = row_shr<1>(Ar[c], 1.f), be = row_shr<1>(Br[c], 0.f);
                float hin = carry[hl0 + c]; if (wr == 1) { const f32x2 h0 = hagg[hl0 + c]; hin = h0.x * hin + h0.y; }
                h[c] = ae * hin + be; }
#pragma unroll
            for (int ai = 0; ai < 2; ++ai) {
                u32x4 hw[4], gw4[4];
                if (d != 0) {
#pragma unroll
                    for (int m = 0; m < 4; ++m) { const size_t ro = (size_t)(rowb + (ai * 4 + m) * rstep) * D + ch0; hw[m] = *(const u32x4*)(hs + ro); gw4[m] = *(const u32x4*)(gate + ro); } }
#pragma unroll
                for (int m = 0; m < 4; ++m) { const int trow = rowb + (ai * 4 + m) * rstep;
#pragma unroll
                    for (int bj = 0; bj < 2; ++bj)
#pragma unroll
                        for (int j = 0; j < 4; ++j) { const int c = bj * 4 + j; h[c] = acc[ai][bj][m][0][j] * h[c] + acc[ai][bj][m][1][j]; }
                    bf16* hp = hs + (size_t)trow * D + ch0;
                    if (d == 0) { *(u32x4*)hp = pack8(h); }
                    else { float hf[8], gf[8], o[8]; unpack8(hw[m], hf); unpack8(gw4[m], gf);
#pragma unroll
                        for (int c = 0; c < 8; ++c) o[c] = (hf[c] + h[c]) * gf[c];
                        *(u32x4*)hp = pack8(o); } }
                asm volatile("" ::: "memory"); }
        }
    }
};

namespace att {
constexpr int KVBLK = 64, KSTR = 400;
constexpr int SHM_V = KVBLK * 128 * 2, SHM_K = KVBLK * KSTR;
constexpr int LDS_ATT = 2 * SHM_V + 2 * SHM_K + NWAVES * 64 * 4;
static_assert(LDS_ATT <= RING_BYTES, "attention LDS");
constexpr float SCALE = 0.07216878364870322f;
constexpr float THR = 8.f;
#define SBAR() __builtin_amdgcn_sched_barrier(0)
__device__ __forceinline__ int crow(int r, int hi) { return (r & 3) + 8 * (r >> 2) + 4 * hi; }
__device__ __forceinline__ void partialSM(f32x16& p0, f32x16& p1, float& m_reg, float& mn, float& alpha) {
  constexpr float C = SCALE * 1.4426950408889634f;
  float pmax = p0[0];
#pragma unroll
  for (int r = 1; r < 16; ++r) pmax = fmaxf(pmax, p0[r]);
#pragma unroll
  for (int r = 0; r < 16; ++r) pmax = fmaxf(pmax, p1[r]);
  { auto rr = __builtin_amdgcn_permlane32_swap(__float_as_uint(pmax), __float_as_uint(pmax), false, false);
    pmax = fmaxf(__uint_as_float(rr[0]), __uint_as_float(rr[1])); }
  if (__builtin_expect(__all(pmax - m_reg <= THR / SCALE), 1)) { mn = m_reg; alpha = 1.f; }
  else { mn = fmaxf(m_reg, pmax); alpha = __builtin_amdgcn_exp2f((m_reg - mn) * C); m_reg = mn; }
  float mnC = -mn * C;
#pragma unroll
  for (int r = 0; r < 16; ++r) p0[r] = fmaf(p0[r], C, mnC);
#pragma unroll
  for (int r = 0; r < 16; ++r) p1[r] = fmaf(p1[r], C, mnC);
#pragma unroll
  for (int r = 0; r < 16; ++r) p0[r] = __builtin_amdgcn_exp2f(p0[r]);
}
__device__ __forceinline__ void finishSM(f32x16& p0, f32x16& p1, float alpha, float& l_reg, bf16x8& pa0, bf16x8& pa1, bf16x8& pa2, bf16x8& pa3) {
#pragma unroll
  for (int r = 0; r < 16; ++r) p1[r] = __builtin_amdgcn_exp2f(p1[r]);
  float ps = 0;
#pragma unroll
  for (int r = 0; r < 16; ++r) ps += p0[r];
#pragma unroll
  for (int r = 0; r < 16; ++r) ps += p1[r];
  { auto rr = __builtin_amdgcn_permlane32_swap(__float_as_uint(ps), __float_as_uint(ps), false, false);
    ps = __uint_as_float(rr[0]) + __uint_as_float(rr[1]); }
  l_reg = l_reg * alpha + ps;
#define PK4(P, BASE, OUT) do { unsigned a0 = cvtpk(P[BASE + 0], P[BASE + 1]), a1 = cvtpk(P[BASE + 2], P[BASE + 3]);   \
    unsigned b0 = cvtpk(P[BASE + 4], P[BASE + 5]), b1 = cvtpk(P[BASE + 6], P[BASE + 7]);                              \
    auto r0 = __builtin_amdgcn_permlane32_swap(a0, b0, false, false); auto r1 = __builtin_amdgcn_permlane32_swap(a1, b1, false, false); \
    u32x4 w = {r0[0], r1[0], r0[1], r1[1]}; OUT = *reinterpret_cast<bf16x8*>(&w); } while (0)
  PK4(p0, 0, pa0); PK4(p0, 8, pa1); PK4(p1, 0, pa2); PK4(p1, 8, pa3);
#undef PK4
}
__device__ __forceinline__ void qkt(f32x16& p0, f32x16& p1, const char* Ks, const bf16x8* qr, int r32, int hi) {
  p0 = f32x16{}; p1 = f32x16{};
#pragma unroll
  for (int d0 = 0; d0 < 12; ++d0) { const int cb = (d0 * 16 + hi * 8) * 2;
    bf16x8 b0 = *reinterpret_cast<const bf16x8*>(Ks + r32 * KSTR + cb);
    bf16x8 b1 = *reinterpret_cast<const bf16x8*>(Ks + (32 + r32) * KSTR + cb);
    p0 = __builtin_amdgcn_mfma_f32_32x32x16_bf16(b0, qr[d0], p0, 0, 0, 0);
    p1 = __builtin_amdgcn_mfma_f32_32x32x16_bf16(b1, qr[d0], p1, 0, 0, 0); }
}
__device__ __forceinline__ int v_st(int k, int c) { const int kk = (k & ~0xC) | ((k & 4) << 1) | ((k & 8) >> 1); return ((kk >> 3) * 4 + (c >> 5)) * 512 + ((kk & 7) * 32 + (c & 31)) * 2; }
__device__ __forceinline__ int v_rd_base(int lane) { return ((lane & 3) << 3) | (((lane >> 2) & 3) << 6) | (((lane >> 4) & 1) << 5) | (((lane >> 5) & 1) << 8); }
constexpr int v_rd_off(int d0, int ks, int half) { return d0 * 512 + ks * 4096 + half * 2048; }
template <int OFF> __device__ __forceinline__ s16x4 tr_read(int vb) {
  s16x4 r; asm volatile("ds_read_b64_tr_b16 %0, %1 offset:%2" : "=&v"(r) : "v"(vb), "i"(OFF) : "memory"); return r;
}
template <int D0> __device__ __forceinline__ void pv_one(f32x16& od, int vb, bf16x8 pa0, bf16x8 pa1, bf16x8 pa2, bf16x8 pa3) {
  const s16x4 l0 = tr_read<v_rd_off(D0, 0, 0)>(vb), h0 = tr_read<v_rd_off(D0, 0, 1)>(vb), l1 = tr_read<v_rd_off(D0, 1, 0)>(vb), h1 = tr_read<v_rd_off(D0, 1, 1)>(vb);
  const s16x4 l2 = tr_read<v_rd_off(D0, 2, 0)>(vb), h2 = tr_read<v_rd_off(D0, 2, 1)>(vb), l3 = tr_read<v_rd_off(D0, 3, 0)>(vb), h3 = tr_read<v_rd_off(D0, 3, 1)>(vb);
  asm volatile("s_waitcnt lgkmcnt(0)" ::: "memory"); SBAR();
#define PK(L, H) (bf16x8){L[0], L[1], L[2], L[3], H[0], H[1], H[2], H[3]}
  od = __builtin_amdgcn_mfma_f32_32x32x16_bf16(pa0, PK(l0, h0), od, 0, 0, 0);
  od = __builtin_amdgcn_mfma_f32_32x32x16_bf16(pa1, PK(l1, h1), od, 0, 0, 0);
  od = __builtin_amdgcn_mfma_f32_32x32x16_bf16(pa2, PK(l2, h2), od, 0, 0, 0);
  od = __builtin_amdgcn_mfma_f32_32x32x16_bf16(pa3, PK(l3, h3), od, 0, 0, 0);
#undef PK
}
__device__ __forceinline__ void pv_d0(f32x16* o, int vb, bf16x8 pa0, bf16x8 pa1, bf16x8 pa2, bf16x8 pa3) {
  pv_one<0>(o[0], vb, pa0, pa1, pa2, pa3); pv_one<1>(o[1], vb, pa0, pa1, pa2, pa3); pv_one<2>(o[2], vb, pa0, pa1, pa2, pa3); pv_one<3>(o[3], vb, pa0, pa1, pa2, pa3);
}
__device__ __forceinline__ void attn_body(const bf16* __restrict__ Qb, const bf16* __restrict__ KA, const bf16* __restrict__ VA, const bf16* __restrict__ KB2, const bf16* __restrict__ VB2,
                                          int nA, int seq, bf16* __restrict__ Ob, char* lds, const float* __restrict__ gqn, const float* __restrict__ rope) {
  constexpr int LDQ = 1536, LDK = 1536, LDV = 1024, LDO = 1024;
  const int tid = opaque_tid(), wid = tid >> 6, lane = tid & 63, r32 = lane & 31, hi = lane >> 5;
  char* V_lds = lds; char* K_lds = lds + 2 * SHM_V;
  float* ws = (float*)(lds + 2 * SHM_V + 2 * SHM_K) + wid * 64; float* li_l = ws; float* al_l = ws + 32;
  float m_reg = -1e30f, l_reg = 0; f32x16 o[4] = {}; bf16x8 qr[12];
  const bf16* Qw = Qb + (long)(wid * 32 + r32) * LDQ + hi * 8;
#pragma unroll
  for (int d0 = 0; d0 < 12; ++d0) qr[d0] = *reinterpret_cast<const bf16x8*>(Qw + d0 * 16);
  {
      float ss = 0.f;
#pragma unroll
      for (int d0 = 0; d0 < 12; ++d0) { float f[8]; unpack8(*reinterpret_cast<u32x4*>(&qr[d0]), f);
#pragma unroll
          for (int e = 0; e < 8; ++e) ss += f[e] * f[e]; }
      { auto rr = __builtin_amdgcn_permlane32_swap(__float_as_uint(ss), __float_as_uint(ss), false, false); ss = __uint_as_float(rr[0]) + __uint_as_float(rr[1]); }
      const float rstd = rsqrtf(ss * (1.f / 192) + EPS);
#pragma unroll
      for (int d0 = 0; d0 < 8; ++d0) { float f[8]; unpack8(*reinterpret_cast<u32x4*>(&qr[d0]), f); const f32x4 g0 = *(const f32x4*)(gqn + d0 * 16 + hi * 8), g1 = *(const f32x4*)(gqn + d0 * 16 + hi * 8 + 4);
#pragma unroll
          for (int e = 0; e < 4; ++e) { f[e] = f[e] * rstd * g0[e]; f[4 + e] = f[4 + e] * rstd * g1[e]; }
          u32x4 w = pack8(f); qr[d0] = *reinterpret_cast<bf16x8*>(&w); }
#pragma unroll
      for (int d0 = 8; d0 < 10; ++d0) {
          float x1[8], x2[8]; unpack8(*reinterpret_cast<u32x4*>(&qr[d0]), x1); unpack8(*reinterpret_cast<u32x4*>(&qr[d0 + 2]), x2);
          const float* ga = gqn + d0 * 16 + hi * 8; const float* gb2 = gqn + (d0 + 2) * 16 + hi * 8;
#pragma unroll
          for (int e = 0; e < 8; ++e) { x1[e] = x1[e] * rstd * ga[e]; x2[e] = x2[e] * rstd * gb2[e]; }
          if (rope) { const float* rt = rope + (size_t)(wid * 32 + r32) * 64 + ((d0 - 8) * 16 + hi * 8) * 2;
#pragma unroll
              for (int e = 0; e < 8; ++e) { const f32x2 cs = *(const f32x2*)(rt + 2 * e); const float a = x1[e], b = x2[e]; x1[e] = a * cs.x - b * cs.y; x2[e] = b * cs.x + a * cs.y; } }
          u32x4 w1 = pack8(x1), w2 = pack8(x2); qr[d0] = *reinterpret_cast<bf16x8*>(&w1); qr[d0 + 2] = *reinterpret_cast<bf16x8*>(&w2); }
  }
  const int sr = tid >> 4, sc = (tid & 15) * 8, vst0 = v_st(sr, sc), vst1 = v_st(32 + sr, sc);
  const int kgo = (tid >> 3) * LDK + (tid & 7) * 8, klo = (tid >> 3) * KSTR + (tid & 7) * 16;
  const int vb0 = (int)(uintptr_t)V_lds + v_rd_base(lane);
  bf16x8 vs0, vs1, ks0, ks1, ks2;
#define SLOAD(k0) do { const bool inA = (k0) < nA; const bf16* Kp = inA ? KA + (long)(k0) * LDK : KB2 + (long)((k0) - nA) * LDK; const bf16* Vp = inA ? VA + (long)(k0) * LDV : VB2 + (long)((k0) - nA) * LDV; \
    vs0 = *reinterpret_cast<const bf16x8*>(Vp + (long)sr * LDV + sc); vs1 = *reinterpret_cast<const bf16x8*>(Vp + (long)(32 + sr) * LDV + sc); \
    ks0 = *reinterpret_cast<const bf16x8*>(Kp + kgo); ks1 = *reinterpret_cast<const bf16x8*>(Kp + kgo + 64); ks2 = *reinterpret_cast<const bf16x8*>(Kp + kgo + 128); } while (0)
#define SWRITE(b) do { *(bf16x8*)(V_lds + (b) * SHM_V + vst0) = vs0; *(bf16x8*)(V_lds + (b) * SHM_V + vst1) = vs1; \
    *(bf16x8*)(K_lds + (b) * SHM_K + klo) = ks0; *(bf16x8*)(K_lds + (b) * SHM_K + klo + 128) = ks1; *(bf16x8*)(K_lds + (b) * SHM_K + klo + 256) = ks2; } while (0)
#define SWAIT() asm volatile("s_waitcnt vmcnt(0)" ::: "memory")
#define RESC(a) do { if (__any((a) < 1.f)) { if (hi == 0) al_l[r32] = (a); asm volatile("s_waitcnt lgkmcnt(0)" ::: "memory"); \
    _Pragma("unroll") for (int d = 0; d < 4; ++d) _Pragma("unroll") for (int r = 0; r < 16; ++r) o[d][r] *= al_l[crow(r, hi)]; } } while (0)
  f32x16 pA0, pA1, pB0, pB1; float mnA, mnB, alA, alB; bf16x8 pa0, pa1, pa2, pa3; const int NT = seq / KVBLK;
  SLOAD(0); SWAIT(); SWRITE(0); __syncthreads();
  qkt(pA0, pA1, K_lds, qr, r32, hi); partialSM(pA0, pA1, m_reg, mnA, alA);
  SLOAD(KVBLK);
  SWAIT(); SWRITE(1); __syncthreads();
  for (int j = 1; j + 1 < NT; j += 2) {
    SBAR(); qkt(pB0, pB1, K_lds + SHM_K, qr, r32, hi);
    finishSM(pA0, pA1, alA, l_reg, pa0, pa1, pa2, pa3); SBAR();
    SLOAD((j + 1) * KVBLK); SBAR();
    pv_d0(o, vb0, pa0, pa1, pa2, pa3); partialSM(pB0, pB1, m_reg, mnB, alB);
    __syncthreads(); SWAIT(); SWRITE(0);
    RESC(alB); __syncthreads();
    SBAR(); qkt(pA0, pA1, K_lds, qr, r32, hi);
    finishSM(pB0, pB1, alB, l_reg, pa0, pa1, pa2, pa3); SBAR();
    SLOAD((j + 2) * KVBLK); SBAR();
    pv_d0(o, vb0 + SHM_V, pa0, pa1, pa2, pa3); partialSM(pA0, pA1, m_reg, mnA, alA);
    __syncthreads(); SWAIT(); SWRITE(1);
    RESC(alA); __syncthreads();
  }
  SBAR(); qkt(pB0, pB1, K_lds + SHM_K, qr, r32, hi);
  finishSM(pA0, pA1, alA, l_reg, pa0, pa1, pa2, pa3); SBAR();
  pv_d0(o, vb0, pa0, pa1, pa2, pa3); partialSM(pB0, pB1, m_reg, mnB, alB);
  __syncthreads(); RESC(alB);
  finishSM(pB0, pB1, alB, l_reg, pa0, pa1, pa2, pa3); SBAR();
  pv_d0(o, vb0 + SHM_V, pa0, pa1, pa2, pa3);
  if (hi == 0) li_l[r32] = l_reg; asm volatile("s_waitcnt lgkmcnt(0)" ::: "memory");
  float rli[16];
#pragma unroll
  for (int r = 0; r < 16; ++r) rli[r] = __builtin_amdgcn_rcpf(li_l[crow(r, hi)]);
  bf16* Ow = Ob + (long)(wid * 32) * LDO;
#pragma unroll
  for (int r = 0; r < 16; ++r) { const int orow = crow(r, hi);
#pragma unroll
    for (int d0 = 0; d0 < 4; ++d0) Ow[(long)orow * LDO + d0 * 32 + r32] = (bf16)(cvtpk(o[d0][r] * rli[r], 0.f) & 0xffffu); }
#undef SLOAD
#undef SWRITE
#undef SWAIT
#undef RESC
}
}


namespace att8 {
constexpr int KVBLK = 64, KP = 208, VP = 80;
constexpr int SHM_K = KVBLK * KP, SHM_V = 128 * VP;
constexpr int SHM_Q = 256 * KP;
constexpr int NBUF = 3;
constexpr int LDS_ATT = NBUF * SHM_V + NBUF * SHM_K + NWAVES * 64 * 4 + SHM_Q;
static_assert(LDS_ATT <= RING_BYTES, "fp8 attention LDS"); static_assert(NWAVES * 32 * 144 <= SHM_Q, "output transpose scratch");
constexpr float SCALE = 0.07216878364870322f;
constexpr float THR = 3.f;
__device__ __forceinline__ int crow(int r, int hi) { return (r & 3) + 8 * (r >> 2) + 4 * hi; }
#define MFMA8(acc, a, b) asm volatile("s_nop 1\n\tv_mfma_f32_32x32x64_f8f6f4 %0, %1, %2, %0" : "+v"(acc) : "v"(a), "v"(b))
#define MFMA8Z(acc, a, b) asm volatile("s_nop 1\n\tv_mfma_f32_32x32x64_f8f6f4 %0, %1, %2, 0" : "=&v"(acc) : "v"(a), "v"(b))
#define MFMA8_DONE() asm volatile("s_nop 15\n\ts_nop 3" ::: "memory")
__device__ __forceinline__ i32x8 ld32(const LAS char* p) { i32x8 r; r.lo = *(const LAS i32x4*)p; r.hi = *(const LAS i32x4*)(p + 16); return r; }
__device__ __forceinline__ void qkt(f32x16& p0, f32x16& p1, const LAS char* Ks, const i32x8& q0, const i32x8& q1, const i32x8& q2, int r32, int hi) {
  const LAS char* k0 = Ks + r32 * KP + hi * 32; const LAS char* k1 = k0 + 32 * KP;
  { const i32x8 a0 = ld32(k0), a1 = ld32(k1); MFMA8Z(p0, a0, q0); MFMA8Z(p1, a1, q0); }
  { const i32x8 a0 = ld32(k0 + 64), a1 = ld32(k1 + 64); MFMA8(p0, a0, q1); MFMA8(p1, a1, q1); }
  { const i32x8 a0 = ld32(k0 + 128), a1 = ld32(k1 + 128); MFMA8(p0, a0, q2); MFMA8(p1, a1, q2); }
  MFMA8_DONE();
}
constexpr float THR2 = THR * 1.4426950408889634f;
__device__ __forceinline__ void partialSM(f32x16& p0, f32x16& p1, float& m_reg, float& mn, float& alpha) {
  float pmax = p0[0];
#pragma unroll
  for (int r = 1; r < 16; ++r) pmax = fmaxf(pmax, p0[r]);
#pragma unroll
  for (int r = 0; r < 16; ++r) pmax = fmaxf(pmax, p1[r]);
  { auto rr = __builtin_amdgcn_permlane32_swap(__float_as_uint(pmax), __float_as_uint(pmax), false, false);
    pmax = fmaxf(__uint_as_float(rr[0]), __uint_as_float(rr[1])); }
  if (__builtin_expect(__all(pmax - m_reg <= THR2), 1)) { mn = m_reg; alpha = 1.f; }
  else { mn = ceilf(fmaxf(m_reg, pmax)); alpha = __builtin_amdgcn_exp2f(m_reg - mn); m_reg = mn; }
#pragma unroll
  for (int r = 0; r < 16; ++r) p0[r] = __builtin_amdgcn_exp2f(p0[r]);
}
__device__ __forceinline__ void finishSM(f32x16& p0, f32x16& p1, float mn, float alpha, float& l_reg, i32x8& pf) {
#pragma unroll
  for (int r = 0; r < 16; ++r) p1[r] = __builtin_amdgcn_exp2f(p1[r]);
  float ps = 0;
#pragma unroll
  for (int r = 0; r < 16; ++r) ps += p0[r];
#pragma unroll
  for (int r = 0; r < 16; ++r) ps += p1[r];
  { auto rr = __builtin_amdgcn_permlane32_swap(__float_as_uint(ps), __float_as_uint(ps), false, false);
    ps = __uint_as_float(rr[0]) + __uint_as_float(rr[1]); }
  const float sc = __builtin_amdgcn_exp2f(mn - 4.f), isc = __builtin_amdgcn_exp2f(4.f - mn);
  l_reg = l_reg * alpha + ps * isc;
  int w[8];
#pragma unroll
  for (int i = 0; i < 4; ++i) {
      asm("v_cvt_scalef32_pk_fp8_f32 %0, %1, %2, %3" : "=v"(w[i]) : "v"(p0[4 * i]), "v"(p0[4 * i + 1]), "v"(sc));
      asm("v_cvt_scalef32_pk_fp8_f32 %0, %1, %2, %3" : "=v"(w[4 + i]) : "v"(p1[4 * i]), "v"(p1[4 * i + 1]), "v"(sc)); }
#pragma unroll
  for (int i = 0; i < 4; ++i) {
      asm("v_cvt_scalef32_pk_fp8_f32 %0, %1, %2, %3 op_sel:[0,0,0,1]" : "+v"(w[i]) : "v"(p0[4 * i + 2]), "v"(p0[4 * i + 3]), "v"(sc));
      asm("v_cvt_scalef32_pk_fp8_f32 %0, %1, %2, %3 op_sel:[0,0,0,1]" : "+v"(w[4 + i]) : "v"(p1[4 * i + 2]), "v"(p1[4 * i + 3]), "v"(sc)); }
#pragma unroll
  for (int i = 0; i < 8; ++i) pf[i] = w[i];
}
__device__ __forceinline__ void pv(f32x16* o, const LAS char* Vs, const i32x8 pf, int r32, int hi) {
  const LAS char* v0 = Vs + r32 * VP + hi * 32;
#pragma unroll
  for (int d0 = 0; d0 < 4; ++d0) { const i32x8 vf = ld32(v0 + d0 * 32 * VP);
    MFMA8(o[d0], pf, vf); }
  MFMA8_DONE();
}
__device__ __forceinline__ void attn_body(const bf16* __restrict__ Qb, const unsigned char* __restrict__ K8a, const unsigned char* __restrict__ V8a, const unsigned char* __restrict__ K8b,
                                          const unsigned char* __restrict__ V8b, int nA, int seq, bf16* __restrict__ Ob, LAS char* lds, const float* __restrict__ gqn, const float* __restrict__ rope) {
  constexpr int LDQ = 1536, LDO = 1024;
  const int tid = opaque_tid(), wid = tid >> 6, lane = tid & 63, r32 = lane & 31, hi = lane >> 5;
  LAS char* V_lds = lds; LAS char* K_lds = lds + NBUF * SHM_V;
  LAS float* ws = (LAS float*)(lds + NBUF * SHM_V + NBUF * SHM_K) + wid * 64; LAS float* li_l = ws; LAS float* al_l = ws + 32;
  LAS char* qs = lds + NBUF * SHM_V + NBUF * SHM_K + NWAVES * 64 * 4 + (wid * 32 + r32) * KP + hi * 32;
  const bool k1ok = (tid & 7) < 4;
  const int kg0 = (tid >> 3) * 1536 + (tid & 7) * 16, kl0 = (tid >> 3) * KP + (tid & 7) * 16;
  const int vg = tid * 16, vl = (tid >> 2) * VP + (tid & 3) * 16;
  u32x4 eK0, eK1, eV, oK0, oK1, oV;
#define SLOAD(S, k0) do { const bool inA = (k0) < nA; const unsigned char* Kp = inA ? K8a + (long)(k0) * 1536 : K8b + (long)((k0) - nA) * 1536; const unsigned char* Vp = inA ? V8a + (long)((k0) >> 6) * 65536 : V8b + (long)(((k0) - nA) >> 6) * 65536; \
    S##V = *reinterpret_cast<const u32x4*>(Vp + vg); S##K0 = *reinterpret_cast<const u32x4*>(Kp + kg0); S##K1 = *reinterpret_cast<const u32x4*>(Kp + kg0 + (k1ok ? 128 : 0)); } while (0)
#define SWRITE(b, S) do { *(LAS u32x4*)(V_lds + (b) * SHM_V + vl) = S##V; *(LAS u32x4*)(K_lds + (b) * SHM_K + kl0) = S##K0; if (k1ok) *(LAS u32x4*)(K_lds + (b) * SHM_K + kl0 + 128) = S##K1; } while (0)
#define SWAIT() asm volatile("s_waitcnt vmcnt(3)" ::: "memory")
#define RESC(a) do { if (__any((a) < 1.f)) { if (hi == 0) al_l[r32] = (a); asm volatile("s_waitcnt lgkmcnt(0)" ::: "memory"); \
    _Pragma("unroll") for (int d = 0; d < 4; ++d) _Pragma("unroll") for (int r = 0; r < 16; ++r) o[d][r] *= al_l[crow(r, hi)]; } } while (0)
#define SBAR8() __builtin_amdgcn_sched_barrier(0)
  f32x16 pA0, pA1, pB0, pB1; float mnA, mnB, alA, alB; i32x8 pf; const int NT = seq / KVBLK;
  SLOAD(e, 0); SLOAD(o, KVBLK);
  float m_reg = -1e30f, l_reg = 0;
  i32x8 qf[3];
  {
      const bf16* Qw = Qb + (long)(wid * 32 + r32) * LDQ + hi * 8;
      u32x4 qw[12];
#pragma unroll
      for (int d0 = 0; d0 < 12; ++d0) qw[d0] = *reinterpret_cast<const u32x4*>(Qw + d0 * 16);
      float ss = 0.f;
#pragma unroll
      for (int d0 = 0; d0 < 12; ++d0) { float f[8]; unpack8(qw[d0], f);
#pragma unroll
          for (int e = 0; e < 8; ++e) ss += f[e] * f[e]; }
      { auto rr = __builtin_amdgcn_permlane32_swap(__float_as_uint(ss), __float_as_uint(ss), false, false); ss = __uint_as_float(rr[0]) + __uint_as_float(rr[1]); }
      const float rstd = rsqrtf(ss * (1.f / 192) + EPS) * ATT_QS;
#pragma unroll
      for (int d0 = 0; d0 < 8; ++d0) { float f[8]; unpack8(qw[d0], f); const f32x4 g0 = *(const f32x4*)(gqn + d0 * 16 + hi * 8), g1 = *(const f32x4*)(gqn + d0 * 16 + hi * 8 + 4);
          qf[d0 >> 2][2 * (d0 & 3)] = (int)pk4_fp8(f[0] * rstd * g0[0], f[1] * rstd * g0[1], f[2] * rstd * g0[2], f[3] * rstd * g0[3]);
          qf[d0 >> 2][2 * (d0 & 3) + 1] = (int)pk4_fp8(f[4] * rstd * g1[0], f[5] * rstd * g1[1], f[6] * rstd * g1[2], f[7] * rstd * g1[3]); }
#pragma unroll
      for (int d0 = 8; d0 < 10; ++d0) {
          float x1[8], x2[8]; unpack8(qw[d0], x1); unpack8(qw[d0 + 2], x2);
          const float* ga = gqn + d0 * 16 + hi * 8; const float* gb2 = gqn + (d0 + 2) * 16 + hi * 8;
#pragma unroll
          for (int e = 0; e < 8; ++e) { x1[e] = x1[e] * rstd * ga[e]; x2[e] = x2[e] * rstd * gb2[e]; }
          if (rope) { const float* rt = rope + (size_t)(wid * 32 + r32) * 64 + ((d0 - 8) * 16 + hi * 8) * 2;
#pragma unroll
              for (int e = 0; e < 8; ++e) { const f32x2 cs = *(const f32x2*)(rt + 2 * e); const float a = x1[e], b = x2[e]; x1[e] = a * cs.x - b * cs.y; x2[e] = b * cs.x + a * cs.y; } }
          qf[2][2 * (d0 & 3)] = (int)pk4_fp8(x1[0], x1[1], x1[2], x1[3]); qf[2][2 * (d0 & 3) + 1] = (int)pk4_fp8(x1[4], x1[5], x1[6], x1[7]);
          qf[2][2 * ((d0 + 2) & 3)] = (int)pk4_fp8(x2[0], x2[1], x2[2], x2[3]); qf[2][2 * ((d0 + 2) & 3) + 1] = (int)pk4_fp8(x2[4], x2[5], x2[6], x2[7]); }
  }
  asm volatile("" : "+v"(qf[0]), "+v"(qf[1]), "+v"(qf[2]));
  f32x16 o[4] = {};
  asm volatile("s_waitcnt vmcnt(3)" ::: "memory"); SWRITE(0, e); __syncthreads();
  qkt(pA0, pA1, K_lds, qf[0], qf[1], qf[2], r32, hi); partialSM(pA0, pA1, m_reg, mnA, alA);
  if (2 < NT) SLOAD(e, 2 * KVBLK);
  SWAIT(); SWRITE(1, o); __syncthreads();
  int rb = 1;
#define NXT(i) ((i) == 2 ? 0 : (i) + 1)
#define PRV(i) ((i) == 0 ? 2 : (i) - 1)
  for (int j = 1; j + 1 < NT; j += 2) {
    SBAR8(); qkt(pB0, pB1, K_lds + rb * SHM_K, qf[0], qf[1], qf[2], r32, hi);
    finishSM(pA0, pA1, mnA, alA, l_reg, pf); SBAR8();
    if (j + 2 < NT) SLOAD(o, (j + 2) * KVBLK); SBAR8();
    pv(o, V_lds + PRV(rb) * SHM_V, pf, r32, hi); partialSM(pB0, pB1, m_reg, mnB, alB);
    SWAIT(); SWRITE(NXT(rb), e);
    RESC(alB); __syncthreads(); rb = NXT(rb);
    SBAR8(); qkt(pA0, pA1, K_lds + rb * SHM_K, qf[0], qf[1], qf[2], r32, hi);
    finishSM(pB0, pB1, mnB, alB, l_reg, pf); SBAR8();
    if (j + 3 < NT) SLOAD(e, (j + 3) * KVBLK); SBAR8();
    pv(o, V_lds + PRV(rb) * SHM_V, pf, r32, hi); partialSM(pA0, pA1, m_reg, mnA, alA);
    SWAIT(); SWRITE(NXT(rb), o);
    RESC(alA); __syncthreads(); rb = NXT(rb);
  }
  SBAR8(); qkt(pB0, pB1, K_lds + rb * SHM_K, qf[0], qf[1], qf[2], r32, hi);
  finishSM(pA0, pA1, mnA, alA, l_reg, pf); SBAR8();
  pv(o, V_lds + PRV(rb) * SHM_V, pf, r32, hi); partialSM(pB0, pB1, m_reg, mnB, alB);
  RESC(alB);
  finishSM(pB0, pB1, mnB, alB, l_reg, pf); SBAR8();
  pv(o, V_lds + rb * SHM_V, pf, r32, hi);
#undef NXT
#undef PRV
  if (hi == 0) li_l[r32] = l_reg; asm volatile("s_waitcnt lgkmcnt(0)" ::: "memory");
  float rli[16];
#pragma unroll
  for (int r = 0; r < 16; ++r) rli[r] = __builtin_amdgcn_rcpf(li_l[crow(r, hi)]) * (1.f / ATT_VS);
  bf16* Ow = Ob + (long)(wid * 32) * LDO;
  { LAS char* ot = lds + NBUF * SHM_V + NBUF * SHM_K + NWAVES * 64 * 4 + wid * (32 * 144);
#pragma unroll
    for (int p = 0; p < 2; ++p) {
#pragma unroll
      for (int dd = 0; dd < 2; ++dd)
#pragma unroll
        for (int r = 0; r < 16; ++r) *(LAS unsigned short*)(ot + crow(r, hi) * 144 + (dd * 32 + r32) * 2) = (unsigned short)(cvtpk(o[2 * p + dd][r] * rli[r], 0.f) & 0xffffu);
      asm volatile("s_waitcnt lgkmcnt(0)" ::: "memory");
#pragma unroll
      for (int i = 0; i < 4; ++i) { const int c = lane + 64 * i, row = c >> 3, col = c & 7;
        *(u32x4*)(Ow + (long)row * LDO + p * 64 + col * 8) = *(const LAS u32x4*)(ot + row * 144 + col * 16); }
      asm volatile("s_waitcnt lgkmcnt(0)" ::: "memory"); } }
#undef SLOAD
#undef SWRITE
#undef SWAIT
#undef RESC
#undef SBAR8
}
}

template <class Map, bool F8 = false>
__device__ __forceinline__ void conv_item(const float* W, int Ksrc, int N, bf16* WT, int Kd, LAS float* scr, int item, int lane, const Map& map) {
    const int nblk = N / 32, kb = item / nblk, nb = item % nblk, k0 = 64 * kb, n0 = 32 * nb;
    const bool live = k0 < Ksrc;
#pragma unroll 8
    for (int i = 0; i < 32; ++i) { const int kk = 2 * i + (lane >> 5); scr[kk * 33 + (lane & 31)] = live ? W[(size_t)(k0 + kk) * N + n0 + (lane & 31)] : 0.f; }
    LDS_WAIT(); asm volatile("" ::: "memory");
    const int c = lane & 7;
#pragma unroll
    for (int j = 0; j < 4; ++j) { const int n = (lane >> 3) + 8 * j; const LAS float* s = scr + (8 * c) * 33 + n;
        if constexpr (F8) { *(u32x2*)((unsigned char*)WT + (size_t)map(n0 + n) * Kd + k0 + 8 * c) =
                (u32x2){pk4_fp8(s[0 * 33] * F8_WGT, s[1 * 33] * F8_WGT, s[2 * 33] * F8_WGT, s[3 * 33] * F8_WGT), pk4_fp8(s[4 * 33] * F8_WGT, s[5 * 33] * F8_WGT, s[6 * 33] * F8_WGT, s[7 * 33] * F8_WGT)}; }
        else { u32x4 o; o.x = cvtpk(s[0 * 33], s[1 * 33]); o.y = cvtpk(s[2 * 33], s[3 * 33]); o.z = cvtpk(s[4 * 33], s[5 * 33]); o.w = cvtpk(s[6 * 33], s[7 * 33]);
            *(u32x4*)(WT + (size_t)map(n0 + n) * Kd + k0 + 8 * c) = o; } }
    LDS_WAIT(); asm volatile("" ::: "memory");
}
struct MapNat { int off; __device__ __forceinline__ int operator()(int n) const { return off + n; } };
struct MapLog { int off; __device__ __forceinline__ int operator()(int n) const { return off + (n & ~255) + phys_of_logical(n & 255); } };
struct MapPair { int off, nsel; __device__ __forceinline__ int operator()(int n) const { return off + (n >> 7) * 256 + phys_of_pair(n & 127, nsel); } };
struct MapUkv { __device__ __forceinline__ int operator()(int n) const { const int h = n >> 8, w = n & 255; const int l = h * 128 + (w & 127); return (w < 128 ? 1536 : 2560) + (l & ~255) + phys_of_logical(l & 255); } };

template <bool F8 = false, class Map>
__device__ __forceinline__ void conv_job(Frame& F, int& cursor, const float* W, int Ksrc, int N, bf16* WT, int Kd, const Map& map) {
    LAS float* scr = (LAS float*)(F.lds + F.wave * 16384);
    const int gw = F.vcu * NWAVES + F.wave, NGW = F.G * NWAVES;
    const int nitems = (Kd / 64) * (N / 32);
    int first = (gw - cursor) % NGW; if (first < 0) first += NGW;
    for (int it = first; it < nitems; it += NGW) conv_item<Map, F8>(W, Ksrc, N, WT, Kd, scr, it, F.lane, map);
    cursor = (cursor + nitems) % NGW;
}
__device__ __forceinline__ void conv_moe_layer(Frame& F, int& cur, int j) {
    KArgs ap = ARGS(); const float* w1 = ap->in[31]; const float* w3 = ap->in[32]; const float* w2 = ap->in[33];
    unsigned char* wm = ap->ws + WS_WMOE;
    LAS float* scr = (LAS float*)(F.lds + F.wave * 16384);
    const int gw = F.vcu * NWAVES + F.wave, NGW = F.G * NWAVES, lane = F.lane;
    constexpr int PER_M = (1024 / 64) * (EH / 32), PER_E = 3 * PER_M, TOTAL = NE * PER_E;
    static_assert(PER_M == (EH / 64) * (1024 / 32), "MoE conversion items");
    f32x4 nx[8];
#define MOE_DECODE(t) const int e_ = (t) / PER_E, r_ = (t) - e_ * PER_E, m_ = r_ / PER_M, it_ = r_ - m_ * PER_M; \
        const int N_ = m_ < 2 ? EH : 1024, nblk_ = N_ / 32, kb_ = it_ / nblk_, nb_ = it_ - kb_ * nblk_, k0_ = 64 * kb_, n0_ = 32 * nb_; \
        const float* src_ = (m_ == 0 ? w1 : m_ == 1 ? w3 : w2) + ((size_t)j * NE + e_) * 1024 * EH
#define MOE_ISSUE(t) do { MOE_DECODE(t); const float* p_ = src_ + (size_t)(k0_ + (lane >> 3)) * N_ + n0_ + 4 * (lane & 7); \
        _Pragma("unroll") for (int i = 0; i < 8; ++i) nx[i] = __builtin_nontemporal_load((const f32x4*)(p_ + (size_t)(8 * i) * N_)); } while (0)
    int t = gw;
    if (t < TOTAL) MOE_ISSUE(t);
    for (; t < TOTAL; t += NGW) {
        f32x4 x[8];
#pragma unroll
        for (int i = 0; i < 8; ++i) x[i] = nx[i];
        if (t + NGW < TOTAL) MOE_ISSUE(t + NGW);
#pragma unroll
        for (int i = 0; i < 8; ++i) { LAS float* d = scr + (8 * i + (lane >> 3)) * 33 + 4 * (lane & 7); d[0] = x[i][0]; d[1] = x[i][1]; d[2] = x[i][2]; d[3] = x[i][3]; }
        LDS_WAIT(); asm volatile("" ::: "memory");
        { MOE_DECODE(t); const int c = lane & 7;
          unsigned char* dst = m_ < 2 ? wm + WM_13 + (size_t)e_ * 7168 * 1024 : wm + WM_2 + (size_t)e_ * 1024 * 3584; const int Kd = m_ < 2 ? 1024 : 3584;
#pragma unroll
          for (int q = 0; q < 4; ++q) { const int n = (lane >> 3) + 8 * q; const LAS float* sp = scr + (8 * c) * 33 + n; const int nn = n0_ + n;
              const int row = m_ < 2 ? (nn >> 7) * 256 + phys_of_pair(nn & 127, m_) : nn;
              *(u32x2*)(dst + (size_t)row * Kd + k0_ + 8 * c) =
                  (u32x2){pk4_fp8(sp[0 * 33] * F8_WGT, sp[1 * 33] * F8_WGT, sp[2 * 33] * F8_WGT, sp[3 * 33] * F8_WGT), pk4_fp8(sp[4 * 33] * F8_WGT, sp[5 * 33] * F8_WGT, sp[6 * 33] * F8_WGT, sp[7 * 33] * F8_WGT)}; } }
        LDS_WAIT(); asm volatile("" ::: "memory");
    }
#undef MOE_DECODE
#undef MOE_ISSUE
}
__device__ __forceinline__ void rope_sincos(int pos, int f, float& c, float& s) {
    const double inv = exp2(-(double)f * (13.287712379549449 / 16.0));
    const double a = (double)pos * inv;
    const double k = rint(a * 0.6366197723675814);
    const double x = fma(-k, 1.5707963267948966, a) - k * 6.123233995736766e-17;
    const double x2 = x * x;
    const double sn = x * (1.0 + x2 * (-1.0 / 6 + x2 * (1.0 / 120 + x2 * (-1.0 / 5040 + x2 * (1.0 / 362880 + x2 * (-1.0 / 39916800 + x2 * (1.0 / 6227020800.0)))))));
    const double cs = 1.0 + x2 * (-0.5 + x2 * (1.0 / 24 + x2 * (-1.0 / 720 + x2 * (1.0 / 40320 + x2 * (-1.0 / 3628800 + x2 * (1.0 / 479001600.0 + x2 * (-1.0 / 87178291200.0)))))));
    const int q = ((int)k) & 3;
    const double sv = (q == 0) ? sn : (q == 1) ? cs : (q == 2) ? -sn : -cs;
    const double cv = (q == 0) ? cs : (q == 1) ? -sn : (q == 2) ? -cs : sn;
    c = (float)cv; s = (float)sv;
}
__device__ __forceinline__ void prologue(Frame& F) {
    int cur = 0;
    __syncthreads();
    {
        LAS float* sl = (LAS float*)F.lds;
        LAS float* red = (LAS float*)(F.lds + 40960);
        KArgs a = ARGS();
        const float* c = a->in[1]; const float* cc = a->in[3]; const float* aw = a->in[4]; const float* ab = a->in[5];
        float* mod = (float*)(a->ws + WS_MOD);
        bool have = false;
        for (int uidx = F.bx; uidx < 4 * 48; uidx += F.G) {
            if (!have) { for (int i = F.tid; i < 9 * 1024; i += NTHR) { const float x = i < 8192 ? c[i] : cc[i - 8192]; sl[i] = x / (1.f + expf(-x)); } __syncthreads(); have = true; }
            const int li = uidx / 48, cb = (uidx % 48) * 128, cg = F.tid & 31, ks = F.tid >> 5;
            float accv[9][4];
#pragma unroll
            for (int v = 0; v < 9; ++v)
#pragma unroll
                for (int q = 0; q < 4; ++q) accv[v][q] = 0.f;
            const float* wp = aw + ((size_t)li * 1024 + ks * 64) * 6144 + cb + cg * 4;
#pragma unroll 4
            for (int k = 0; k < 64; ++k) { const f32x4 w = *(const f32x4*)(wp + (size_t)k * 6144);
#pragma unroll
                for (int v = 0; v < 9; ++v) { const float sv = sl[v * 1024 + ks * 64 + k]; accv[v][0] += sv * w[0]; accv[v][1] += sv * w[1]; accv[v][2] += sv * w[2]; accv[v][3] += sv * w[3]; } }
#pragma unroll
            for (int v = 0; v < 9; ++v) *(LAS f32x4*)(red + (ks * 9 + v) * 128 + cg * 4) = (f32x4){accv[v][0], accv[v][1], accv[v][2], accv[v][3]};
            __syncthreads();
            for (int o = F.tid; o < 9 * 128; o += NTHR) { const int v = o >> 7, n = o & 127; float s = ab[(size_t)li * 6144 + cb + n];
#pragma unroll
                for (int k2 = 0; k2 < 16; ++k2) s += red[(k2 * 9 + v) * 128 + n];
                mod[((size_t)li * 9 + v) * 6144 + cb + n] = s; }
            __syncthreads();
        }
        __syncthreads();
    }
    {
        KArgs a = ARGS(); float* rt = (float*)(a->ws + WS_ROPE);
        for (int i = F.bx * NTHR + F.tid; i < SEQ * 32; i += F.G * NTHR) { const int pos = i >> 5, jj = i & 31; float cs, sn; rope_sincos(jj < 16 ? (pos >> 6) : (pos & 63), jj & 15, cs, sn); rt[2 * i] = cs; rt[2 * i + 1] = sn; }
    }
    {
        KArgs a = ARGS(); float* spt = (float*)(a->ws + WS_SPT); const float* lam = a->in[25];
        for (int i = F.bx * NTHR + F.tid; i < 2 * 2 * 1024; i += F.G * NTHR) spt[i] = -8.0f * 1.4426950408889634f * log1pf(expf(-lam[i]));
    }
#pragma unroll 1
    for (int j = 0; j < 2; ++j) {
        KArgs ap = ARGS(); bf16* wsm = (bf16*)(ap->ws + WS_WSM);
        bf16* wm = wsm + W_MLA + j * W_MLA_SZ;
        conv_job(F, cur, ap->in[8] + (size_t)j * 1024 * 256, 1024, 256, wm + W_MLA_1, 1024, MapLog{0});
        conv_job(F, cur, ap->in[11] + (size_t)j * 1024 * 192, 1024, 192, wm + W_MLA_1, 1024, MapLog{256});
        conv_job(F, cur, ap->in[10] + (size_t)j * 256 * 1536, 256, 1536, wm + W_MLA_CAT, 256, MapLog{0});
        conv_job(F, cur, ap->in[13] + (size_t)j * 128 * 2048, 128, 2048, wm + W_MLA_CAT, 256, MapUkv{});
        conv_job(F, cur, ap->in[16] + (size_t)j * 1024 * 1024, 1024, 1024, wm + W_MLA_O, 1024, MapNat{0});
        bf16* wr = wsm + W_RG + j * W_RG_SZ;
        conv_job(F, cur, ap->in[17] + (size_t)j * 1024 * 1024, 1024, 1024, wr + W_RG_IG, 1024, MapLog{0});
        conv_job(F, cur, ap->in[18] + (size_t)j * 1024 * 1024, 1024, 1024, wr + W_RG_IG, 1024, MapLog{1024});
        for (int dh = 0; dh < 8; ++dh) {
            conv_job(F, cur, ap->in[21] + ((size_t)j * 8 + dh) * 65536, 256, 256, wr + W_RG_AX + (size_t)dh * 2 * 65536, 256, MapPair{0, 0});
            conv_job(F, cur, ap->in[23] + ((size_t)j * 8 + dh) * 65536, 256, 256, wr + W_RG_AX + (size_t)dh * 2 * 65536, 256, MapPair{0, 1});
        }
        conv_job(F, cur, ap->in[26] + (size_t)j * 1024 * 1024, 1024, 1024, wr + W_RG_OUT, 1024, MapNat{0});
        bf16* wf = wsm + W_FFN + j * W_FFN_SZ;
        if ((FFN_F8_MASK >> j) & 1) {
            conv_job<true>(F, cur, ap->in[27] + (size_t)j * 1024 * FF, 1024, FF, wf + W_FFN_13, 1024, MapPair{0, 0});
            conv_job<true>(F, cur, ap->in[28] + (size_t)j * 1024 * FF, 1024, FF, wf + W_FFN_13, 1024, MapPair{0, 1});
            conv_job<true>(F, cur, ap->in[29] + (size_t)j * FF * 1024, FF, 1024, wf + W_FFN_2, FF, MapNat{0});
        } else {
            conv_job(F, cur, ap->in[27] + (size_t)j * 1024 * FF, 1024, FF, wf + W_FFN_13, 1024, MapPair{0, 0});
            conv_job(F, cur, ap->in[28] + (size_t)j * 1024 * FF, 1024, FF, wf + W_FFN_13, 1024, MapPair{0, 1});
            conv_job(F, cur, ap->in[29] + (size_t)j * FF * 1024, FF, 1024, wf + W_FFN_2, FF, MapNat{0});
        }
        { const int gw = F.vcu * NWAVES + F.wave, NGW = F.G * NWAVES;
          for (int r = gw; r < 64; r += NGW) { const int row = 256 + phys_of_logical(192 + r); bf16* p = wm + W_MLA_1 + (size_t)row * 1024;
              for (int k = F.lane * 8; k < 1024; k += 512) *(u32x4*)(p + k) = (u32x4){0u, 0u, 0u, 0u}; } }
    }
    conv_moe_layer(F, cur, 0);
}

template <bool ROUTE, int R, bool F8OUT = ROUTE, bool XF32 = false>
__device__ __forceinline__ void norm_pass(Frame& F, const float* xL, const float* xC, const bf16* xb, int nrows, const float* g, const float* mod  , int chunk_sh, bf16* H,
                                          const float* wrt, unsigned* cnt, int* rE, int* rRank, float* rG) {
    const int lane = F.lane;
    const int rpb = (nrows + F.G - 1) / F.G;
    const int gw = F.vcu * NWAVES + F.wave, NGW = F.G * NWAVES;
    const int rpw = (nrows + NGW - 1) / NGW;
    const int rbeg = ROUTE ? F.vcu * rpb : 0, rfirst = ROUTE ? rbeg + F.wave : gw * rpw, rstride = ROUTE ? NWAVES : 1;
    const int rend = ROUTE ? (rbeg + rpb < nrows ? rbeg + rpb : nrows) : (rfirst + rpw < nrows ? rfirst + rpw : nrows);
    LAS int* sel = (LAS int*)F.lds;
    LAS float* wl = (LAS float*)(F.lds + 4096);
    if (ROUTE) {
        for (int x = F.tid; x < 2048; x += NTHR) { const int slot = x >> 6, L = x & 63, jj = slot >> 4, q = (slot >> 1) & 7, hf = slot & 1;
            *(LAS f32x4*)(wl + (size_t)x * 4) = *(const f32x4*)(wrt + (size_t)(8 * L + 512 * jj + q) * 8 + hf * 4); }
        LDS_WAIT(); __syncthreads();
    }
    float gg[2][8];
#pragma unroll
    for (int jj = 0; jj < 2; ++jj) { const f32x4 a = *(const f32x4*)(g + 8 * lane + 512 * jj), b = *(const f32x4*)(g + 8 * lane + 512 * jj + 4);
        gg[jj][0] = a[0]; gg[jj][1] = a[1]; gg[jj][2] = a[2]; gg[jj][3] = a[3]; gg[jj][4] = b[0]; gg[jj][5] = b[1]; gg[jj][6] = b[2]; gg[jj][7] = b[3]; }
    u32x4 nx[XF32 ? 1 : R][2]; f32x4 nf[XF32 ? R : 1][2][2]; int curvec = -1; float mA[2][8], mB[2][8];
#define NP_LOADX(base) do { _Pragma("unroll") for (int r = 0; r < R; ++r) { const int rr = (base) + r * rstride; const int rw = rr < rend ? rr : (base); \
        _Pragma("unroll") for (int jj = 0; jj < 2; ++jj) nx[r][jj] = __builtin_nontemporal_load((const u32x4*)(xb + (size_t)rw * D + 8 * lane + 512 * jj)); } } while (0)
#define NP_LOADF(base) do { _Pragma("unroll") for (int r = 0; r < R; ++r) { const int rr = (base) + r * rstride; const int rw = rr < rend ? rr : (base); \
        const float* xr = rw < TL ? xL + (size_t)rw * D : xC + (size_t)(rw - TL) * D; \
        _Pragma("unroll") for (int jj = 0; jj < 2; ++jj) { nf[XF32 ? r : 0][jj][0] = __builtin_nontemporal_load((const f32x4*)(xr + 8 * lane + 512 * jj)); nf[XF32 ? r : 0][jj][1] = __builtin_nontemporal_load((const f32x4*)(xr + 8 * lane + 512 * jj + 4)); } } } while (0)
    constexpr bool PF = !ROUTE;
    if (PF && rfirst < rend) { if constexpr (!XF32) NP_LOADX(rfirst); else NP_LOADF(rfirst); }
    for (int row0 = rfirst; row0 < rend; row0 += R * rstride) {
        float v[XF32 ? R : 1][2][8]; u32x4 cu[XF32 ? 1 : R][2]; float ss[R]; int rows[R];
#define NP_GETV(r, jj, f) do { if constexpr (XF32) { _Pragma("unroll") for (int e_ = 0; e_ < 8; ++e_) f[e_] = v[XF32 ? (r) : 0][jj][e_]; } else unpack8(cu[XF32 ? 0 : (r)][jj], f); } while (0)
        const int nrow0 = row0 + R * rstride;
#pragma unroll
        for (int r = 0; r < R; ++r) { const int rr = row0 + r * rstride; rows[r] = rr < rend ? rr : row0; }
        if constexpr (XF32) {
#pragma unroll
            for (int r = 0; r < R; ++r)
#pragma unroll
                for (int jj = 0; jj < 2; ++jj) { const f32x4 a = nf[r][jj][0], b = nf[r][jj][1];
                    v[r][jj][0] = a[0]; v[r][jj][1] = a[1]; v[r][jj][2] = a[2]; v[r][jj][3] = a[3]; v[r][jj][4] = b[0]; v[r][jj][5] = b[1]; v[r][jj][6] = b[2]; v[r][jj][7] = b[3]; }
            if (nrow0 < rend) NP_LOADF(nrow0);
        } else {
            if constexpr (!PF) NP_LOADX(row0);
#pragma unroll
            for (int r = 0; r < R; ++r)
#pragma unroll
                for (int jj = 0; jj < 2; ++jj) cu[r][jj] = nx[r][jj];
            if (PF && nrow0 < rend) NP_LOADX(nrow0);
        }
        const int vec0 = row_vec(row0);
        if (vec0 != curvec) { curvec = vec0; const float* mv0 = mod + (size_t)vec0 * 6144 + chunk_sh * 1024;
#pragma unroll
            for (int jj = 0; jj < 2; ++jj) { const int c = 8 * lane + 512 * jj;
                const f32x4 sh0 = *(const f32x4*)(mv0 + c), sh1 = *(const f32x4*)(mv0 + c + 4), sc0 = *(const f32x4*)(mv0 + 1024 + c), sc1 = *(const f32x4*)(mv0 + 1024 + c + 4);
#pragma unroll
                for (int e = 0; e < 8; ++e) { mA[jj][e] = gg[jj][e] * ((e < 4 ? sc0[e & 3] : sc1[e & 3]) + 1.f); mB[jj][e] = e < 4 ? sh0[e & 3] : sh1[e & 3]; } } }
#pragma unroll
        for (int r = 0; r < R; ++r) { float s = 0.f;
#pragma unroll
            for (int jj = 0; jj < 2; ++jj) { float f[8]; NP_GETV(r, jj, f);
#pragma unroll
                for (int e = 0; e < 8; ++e) s += f[e] * f[e]; }
            ss[r] = s; }
#pragma unroll
        for (int r = 0; r < R; ++r) ss[r] = wave_sum(ss[r]);
#pragma unroll
        for (int r = 0; r < R; ++r) { const int row = rows[r]; const bool live = (row0 + r * rstride) < rend;
            const float rstd = rsqrtf(ss[r] * (1.f / D) + EPS);
            const bool same = row_vec(row) == vec0;
            const float* mv = mod + (size_t)row_vec(row) * 6144 + chunk_sh * 1024;
            float lg[8];
            if (ROUTE) {
#pragma unroll
                for (int e = 0; e < 8; ++e) lg[e] = 0.f; }
#pragma unroll
            for (int jj = 0; jj < 2; ++jj) { const int c = 8 * lane + 512 * jj;
                float h[8], f[8]; NP_GETV(r, jj, f);
                if (same) {
#pragma unroll
                    for (int e = 0; e < 8; ++e) h[e] = (f[e] * rstd) * mA[jj][e] + mB[jj][e];
                } else {
                    const f32x4 sh0 = *(const f32x4*)(mv + c), sh1 = *(const f32x4*)(mv + c + 4), sc0 = *(const f32x4*)(mv + 1024 + c), sc1 = *(const f32x4*)(mv + 1024 + c + 4);
#pragma unroll
                    for (int e = 0; e < 8; ++e) h[e] = (f[e] * rstd) * gg[jj][e] * ((e < 4 ? sc0[e & 3] : sc1[e & 3]) + 1.f) + (e < 4 ? sh0[e & 3] : sh1[e & 3]);
                }
                if (ROUTE) {
#pragma unroll
                    for (int q = 0; q < 8; ++q) { const f32x4 w0 = *(const LAS f32x4*)(wl + (((jj * 8 + q) * 2 + 0) * 64 + lane) * 4), w1 = *(const LAS f32x4*)(wl + (((jj * 8 + q) * 2 + 1) * 64 + lane) * 4);
                        lg[0] += h[q] * w0[0]; lg[1] += h[q] * w0[1]; lg[2] += h[q] * w0[2]; lg[3] += h[q] * w0[3]; lg[4] += h[q] * w1[0]; lg[5] += h[q] * w1[1]; lg[6] += h[q] * w1[2]; lg[7] += h[q] * w1[3]; } }
                if (live) { if (F8OUT) *(u32x2*)((unsigned char*)H + (size_t)row * D + c) = (u32x2){pk4_fp8(h[0] * F8_ACT, h[1] * F8_ACT, h[2] * F8_ACT, h[3] * F8_ACT), pk4_fp8(h[4] * F8_ACT, h[5] * F8_ACT, h[6] * F8_ACT, h[7] * F8_ACT)};
                            else *(u32x4*)(H + (size_t)row * D + c) = pack8(h); } }
            if (ROUTE) {
#pragma unroll
                for (int e = 0; e < 8; ++e) lg[e] = wave_sum(lg[e]);
                int e1 = 0; float l1 = lg[0];
#pragma unroll
                for (int e = 1; e < 8; ++e) if (lg[e] > l1) { l1 = lg[e]; e1 = e; }
                int e2 = -1; float l2 = -3.0e38f;
#pragma unroll
                for (int e = 0; e < 8; ++e) if (e != e1 && lg[e] > l2) { l2 = lg[e]; e2 = e; }
                const float ga = 1.f / (1.f + expf(l2 - l1)), gb = 1.f - ga;
                const int ea = e1 < e2 ? e1 : e2, eb = e1 < e2 ? e2 : e1; const float g0 = e1 < e2 ? ga : gb, g1 = e1 < e2 ? gb : ga;
                if (lane == 0 && live) { sel[row - rbeg] = ea | (eb << 4); rE[2 * row] = ea; rE[2 * row + 1] = eb; rG[2 * row] = g0; rG[2 * row + 1] = g1; }
            }
        }
    }
#undef NP_LOADX
#undef NP_LOADF
#undef NP_GETV
#undef NP_LOADM
    if (ROUTE) {
        LDS_WAIT(); __syncthreads();
        if (F.tid < 16) {
            const int sh = (F.tid >> 3) * 4, e = F.tid & 7; const int n = rend - rbeg;
            int c = 0;
            for (int i = 0; i < n; ++i) if (((sel[i] >> sh) & 15) == e) { rRank[2 * (rbeg + i) + (F.tid >> 3)] = c; ++c; }
            ((int*)cnt)[F.vcu * 16 + F.tid] = c;
        }
        __syncthreads();
    }
}
__device__ __forceinline__ void moe_lists(Frame& F, int nrows, unsigned* cnt, const int* blkcnt, const int* rE, const int* rRank, const float* rG, int* tok, float* gvv) {
    const int gt = F.bx * NTHR + F.tid, NGT = F.G * NTHR;
    const int rpb = (nrows + F.G - 1) / F.G;
    LAS int* pre = (LAS int*)F.lds;
    LAS int* tot = pre + 256 * 16;
    LAS int* tb = tot + 16;
    for (int i = F.tid; i < F.G * 16; i += NTHR) pre[i] = blkcnt[i];
    LDS_WAIT(); __syncthreads();
    if (F.tid < 16) { int run = 0; for (int b = 0; b < F.G; ++b) { const int v = pre[b * 16 + F.tid]; pre[b * 16 + F.tid] = run; run += v; } tot[F.tid] = run;
        if (F.bx == 0) cnt[64 * F.tid] = (unsigned)run; }
    LDS_WAIT(); __syncthreads();
    if (F.tid == 0) {
#pragma unroll 1
        for (int s = 0; s < 2; ++s) { int a = 0;
#pragma unroll 1
            for (int e = 0; e < NE; ++e) { tb[s * 8 + e] = a * 256; a += (tot[s * 8 + e] + 255) >> 8; } }
    }
    LDS_WAIT(); __syncthreads();
    for (int i = gt; i < nrows * 2; i += NGT) { const int s = i & 1, row = i >> 1, se = s * 8 + rE[i]; const int pos = tb[se] + pre[(row / rpb) * 16 + se] + rRank[i];
        tok[s * MOE_ROWS + pos] = row; gvv[s * MOE_ROWS + pos] = rG[i]; }
#pragma unroll 1
    for (int se = 0; se < 16; ++se) { const int c = tot[se], base = tb[se], end = (c + 255) & ~255, so = (se >> 3) * MOE_ROWS;
        for (int p = c + gt; p < end; p += NGT) { tok[so + base + p] = -1; gvv[so + base + p] = 0.f; } }
    __syncthreads();
}
__device__ __forceinline__ void qkva_norm_pass(Frame& F, int nrows, bf16* QKVA, const float* gq, const float* gkv) {
    constexpr int R = 4;
    const int gw = F.vcu * NWAVES + F.wave, NGW = F.G * NWAVES, lane = F.lane;
    float gl[8];
    { const float* gp = lane < 32 ? gq + lane * 8 : gkv + ((lane < 48 ? lane : 32) - 32) * 8;
#pragma unroll
      for (int i = 0; i < 8; ++i) gl[i] = gp[i]; }
    for (int row0 = gw; row0 < nrows; row0 += R * NGW) {
        u32x4 w[R]; float sq[R], sc[R];
#pragma unroll
        for (int r = 0; r < R; ++r) { const int rr = row0 + r * NGW; w[r] = *(const u32x4*)(QKVA + (size_t)(rr < nrows ? rr : row0) * 512 + lane * 8); }
#pragma unroll
        for (int r = 0; r < R; ++r) { float f[8]; unpack8(w[r], f); float s = 0.f;
#pragma unroll
            for (int i = 0; i < 8; ++i) s += f[i] * f[i];
            sq[r] = lane < 32 ? s : 0.f; sc[r] = (lane >= 32 && lane < 48) ? s : 0.f; }
#pragma unroll
        for (int o = 1; o < 64; o <<= 1) {
#pragma unroll
            for (int r = 0; r < R; ++r) { sq[r] += __shfl_xor(sq[r], o); sc[r] += __shfl_xor(sc[r], o); } }
#pragma unroll
        for (int r = 0; r < R; ++r) { const int rr = row0 + r * NGW;
            if (lane < 48 && rr < nrows) { float f[8]; unpack8(w[r], f); const float rstd = lane < 32 ? rsqrtf(sq[r] * (1.f / 256) + EPS) : rsqrtf(sc[r] * (1.f / 128) + EPS);
#pragma unroll
                for (int i = 0; i < 8; ++i) f[i] = f[i] * rstd * gl[i];
                *(u32x4*)(QKVA + (size_t)rr * 512 + lane * 8) = pack8(f); } }
    }
}
__device__ __forceinline__ void k_final_pass(Frame& F, int nrows, bf16* Kb, const bf16* QKVA, const float* gkn, const float* rope) {
    constexpr int R = 4;
    const int gw = F.vcu * NWAVES + F.wave, NGW = F.G * NWAVES, lane = F.lane, h = lane >> 3, l = lane & 7;
    float gn[16], gr[8];
#pragma unroll
    for (int i = 0; i < 16; ++i) gn[i] = gkn[l * 16 + i];
#pragma unroll
    for (int i = 0; i < 8; ++i) gr[i] = gkn[128 + l * 8 + i];
    for (int row0 = gw; row0 < nrows; row0 += R * NGW) {
        u32x4 wa[R], wb[R], wr[R]; float ss[R];
#pragma unroll
        for (int r = 0; r < R; ++r) { const int rr = row0 + r * NGW; const int row = rr < nrows ? rr : row0; const bf16* kp = Kb + (size_t)row * 1536 + h * 192;
            wa[r] = *(const u32x4*)(kp + l * 16); wb[r] = *(const u32x4*)(kp + l * 16 + 8); wr[r] = *(const u32x4*)(QKVA + (size_t)row * 512 + 384 + l * 8); }
#pragma unroll
        for (int r = 0; r < R; ++r) { float a[8], b[8], q[8]; unpack8(wa[r], a); unpack8(wb[r], b); unpack8(wr[r], q); float s = 0.f;
#pragma unroll
            for (int i = 0; i < 8; ++i) s += a[i] * a[i] + b[i] * b[i] + q[i] * q[i];
            ss[r] = s; }
#pragma unroll
        for (int o = 1; o < 8; o <<= 1) {
#pragma unroll
            for (int r = 0; r < R; ++r) ss[r] += __shfl_xor(ss[r], o); }
#pragma unroll
        for (int r = 0; r < R; ++r) { const int rr = row0 + r * NGW; const int row = rr < nrows ? rr : row0;
            float a[8], b[8], q[8]; unpack8(wa[r], a); unpack8(wb[r], b); unpack8(wr[r], q);
            const float rstd = rsqrtf(ss[r] * (1.f / 192) + EPS);
#pragma unroll
            for (int i = 0; i < 8; ++i) { a[i] = a[i] * rstd * gn[i]; b[i] = b[i] * rstd * gn[8 + i]; q[i] = q[i] * rstd * gr[i]; }
            if (row < TL) { const int pos = row & (SEQ - 1); const float* rt = rope + ((size_t)pos * 32 + (l & 3) * 8) * 2;
#pragma unroll
                for (int i = 0; i < 8; ++i) { const float other = __shfl_xor(q[i], 4); const f32x2 cs = *(const f32x2*)(rt + 2 * i);
                    q[i] = l < 4 ? q[i] * cs.x - other * cs.y : q[i] * cs.x + other * cs.y; } }
            if (rr < nrows) { bf16* kp = Kb + (size_t)row * 1536 + h * 192; *(u32x4*)(kp + l * 16) = pack8(a); *(u32x4*)(kp + l * 16 + 8) = pack8(b); *(u32x4*)(kp + 128 + l * 8) = pack8(q); } }
    }
}
__device__ __forceinline__ void conv_pass(Frame& F, int nrows, const bf16* UP, bf16* U, const float* cw, const float* cb) {
    constexpr int R = 2;
    const int gw = F.vcu * NWAVES + F.wave, NGW = F.G * NWAVES, lane = F.lane;
#pragma unroll 1
    for (int half = 0; half < 2; ++half) { const int c = lane * 8 + half * 512;
        float cwv[4][8], cbv[8];
#pragma unroll
        for (int k = 0; k < 4; ++k) { const f32x4 a = *(const f32x4*)(cw + k * 1024 + c), b2 = *(const f32x4*)(cw + k * 1024 + c + 4);
            cwv[k][0] = a[0]; cwv[k][1] = a[1]; cwv[k][2] = a[2]; cwv[k][3] = a[3]; cwv[k][4] = b2[0]; cwv[k][5] = b2[1]; cwv[k][6] = b2[2]; cwv[k][7] = b2[3]; }
        { const f32x4 a = *(const f32x4*)(cb + c), b2 = *(const f32x4*)(cb + c + 4); cbv[0] = a[0]; cbv[1] = a[1]; cbv[2] = a[2]; cbv[3] = a[3]; cbv[4] = b2[0]; cbv[5] = b2[1]; cbv[6] = b2[2]; cbv[7] = b2[3]; }
        u32x4 nw[R][4];
#define CV_LOAD(base) do { _Pragma("unroll") for (int r = 0; r < R; ++r) { const int rr = (base) + r * NGW; const int row = rr < nrows ? rr : (base); \
            const int len = row < TL ? SEQ : CTXL; const int n = row < TL ? (row & (SEQ - 1)) : ((row - TL) & (CTXL - 1)); \
            _Pragma("unroll") for (int k = 0; k < 4; ++k) { const int nn = n + k - 2; nw[r][k] = (nn >= 0 && nn < len) ? *(const u32x4*)(UP + (size_t)(row + k - 2) * D + c) : (u32x4){0u, 0u, 0u, 0u}; } } } while (0)
        if (gw < nrows) CV_LOAD(gw);
        for (int row0 = gw; row0 < nrows; row0 += R * NGW) {
            u32x4 w[R][4];
#pragma unroll
            for (int r = 0; r < R; ++r)
#pragma unroll
                for (int k = 0; k < 4; ++k) w[r][k] = nw[r][k];
            if (row0 + R * NGW < nrows) CV_LOAD(row0 + R * NGW);
#pragma unroll
            for (int r = 0; r < R; ++r) { const int rr = row0 + r * NGW;
                float o[8];
#pragma unroll
                for (int i = 0; i < 8; ++i) o[i] = cbv[i];
#pragma unroll
                for (int k = 0; k < 4; ++k) { float f[8]; unpack8(w[r][k], f);
#pragma unroll
                    for (int i = 0; i < 8; ++i) o[i] += f[i] * cwv[k][i]; }
                if (rr < nrows) *(u32x4*)(U + (size_t)rr * D + c) = pack8(o); }
        }
#undef CV_LOAD
    }
}

__device__ __forceinline__ f32x4 ld_bf16x4(const bf16* p) { const u32x2 w = *(const u32x2*)p; return (f32x4){bf2f(w.x & 0xffffu), __uint_as_float(w.x & 0xffff0000u), bf2f(w.y & 0xffffu), __uint_as_float(w.y & 0xffff0000u)}; }
__device__ __forceinline__ void reduce_resid(Frame& F, const Split sp, int nM, int nN, const float* part, const float* inL, const float* inC, bf16* xb, const float* gate, float scale) {
    const int gt = F.bx * NTHR + F.tid, NGT = F.G * NTHR;
    for (int idx = gt; idx < sp.Lf * 16384; idx += NGT) { const int l = idx >> 14, e = idx & 16383, r = e >> 6, c4 = (e & 63) * 4;
        int pm, pn; pg8::tile_of(sp.F + l, nM, nN, pm, pn);
        const float* pp = part + (size_t)(l * sp.S) * 65536 + r * 256 + c4; f32x4 a = *(const f32x4*)pp;
        for (int k = 1; k < sp.S; ++k) a += *(const f32x4*)(pp + (size_t)k * 65536);
        const int row = pm * 256 + r, col = pn * 256 + c4; const bool lat = row < TL;
        const f32x4 x = inL ? *(const f32x4*)((lat ? inL + (size_t)row * D : inC + (size_t)(row - TL) * D) + col) : ld_bf16x4(xb + (size_t)row * D + col);
        const f32x4 g = *(const f32x4*)(gate + (size_t)row_vec(row) * 6144 + col);
        const f32x4 y = x + (g * scale) * a;
        *(u32x2*)(xb + (size_t)row * D + col) = (u32x2){cvtpk(y[0], y[1]), cvtpk(y[2], y[3])}; }
}
__device__ __forceinline__ void reduce_moe(Frame& F, const Split sp, int nM, const float* part, bf16* xb, float* fin, const float* g2, const int* tok, const float* gv) {
    const int gt = F.bx * NTHR + F.tid, NGT = F.G * NTHR;
    for (int idx = gt; idx < sp.Lf * 16384; idx += NGT) { const int l = idx >> 14, e = idx & 16383, r = e >> 6, c4 = (e & 63) * 4;
        int pm, pn; pg8::tile_of(sp.F + l, nM, 4, pm, pn);
        const int pos = pm * 256 + r; const int tk = tok[pos]; if (tk < 0) continue;
        const float* pp = part + (size_t)(l * sp.S) * 65536 + r * 256 + c4; f32x4 a = *(const f32x4*)pp;
        for (int k = 1; k < sp.S; ++k) a += *(const f32x4*)(pp + (size_t)k * 65536);
        const int col = pn * 256 + c4; bf16* xr = xb + (size_t)tk * D + col;
        const f32x4 g = *(const f32x4*)(g2 + (size_t)row_vec(tk) * 6144 + col);
        const f32x4 y = ld_bf16x4(xr) + (g * (gv[pos] * F8_INV)) * a;
        if (fin) *(f32x4*)(fin + (size_t)tk * D + col) = y; else *(u32x2*)xr = (u32x2){cvtpk(y[0], y[1]), cvtpk(y[2], y[3])}; }
}
#ifdef PROBE
constexpr int CW_PROBE = 20480;
__device__ __forceinline__ void probe_buf(int id, const void* p, size_t nelem, bool f32v, unsigned* word) {
    int bxx = blockIdx.x; asm volatile("" : "+s"(bxx));
    const unsigned gt = (unsigned)bxx * NTHR + (unsigned)opaque_tid(), NGT = gridDim.x * NTHR;
    const unsigned nw = (unsigned)(f32v ? nelem : nelem / 2);
    const unsigned* q = (const unsigned*)p;
    bool bad = false;
    if (f32v) { for (unsigned i = gt; i < nw; i += NGT) bad |= ((q[i] & 0x7f800000u) == 0x7f800000u); }
    else { for (unsigned i = gt; i < nw; i += NGT) { const unsigned w = q[i]; bad |= ((w & 0x7f80u) == 0x7f80u) | ((w & 0x7f800000u) == 0x7f800000u); } }
    if (bad) atomicMax(word, (unsigned)(1000 - id));
}
#define PROBE_CHECK(id, ptr, nelem, f32v) do { KArgs ap = ARGS(); probe_buf(id, ptr, nelem, f32v, (unsigned*)WSP(WS_CTL) + CW_PROBE); } while (0)
#else
#define PROBE_CHECK(id, ptr, nelem, f32v) do { } while (0)
#endif
#ifndef PH_MASK
#define PH_MASK 0xffffffffu
#endif
#define PH(k) ((((unsigned)(PH_MASK)) >> (k)) & 1u)
#ifndef REP_MASK
#define REP_MASK 0u
#endif
#define REPS(k) (((((unsigned)(REP_MASK)) >> (k)) & 1u) ? 2 : 1)
__global__ void __launch_bounds__(NTHR, 2) fwd_kernel(Args args) {
    extern __shared__ __attribute__((aligned(16))) unsigned char lds_raw[];
#define MKFRAME() Frame F; F.lds = (LAS unsigned char*)lds_raw; F.tid = opaque_tid(); F.lane = F.tid & 63; F.wave = __builtin_amdgcn_readfirstlane(F.tid >> 6); \
    F.G = gridDim.x; F.bx = blockIdx.x; asm volatile("" : "+s"(F.G), "+s"(F.bx)); F.vcu = (F.bx & 7) * (F.G >> 3) + (F.bx >> 3)
    volatile LAS unsigned* MISC = (volatile LAS unsigned*)((LAS unsigned char*)lds_raw + MISC_OFF);
    if (threadIdx.x < 64) MISC[threadIdx.x] = 0u;
    __syncthreads();
    (void)xcd_barrier_post((unsigned*)(args.ws + WS_CTL) + CW_BAR, MISC + 8);
#define GRID_BAR() do { KArgs _ap = ARGS(); XcdBarrier _b; _b.bar = (unsigned*)(_ap->ws + WS_CTL) + CW_BAR; _b.x = xb_xcc_id(); _b.st = (volatile LAS unsigned*)((LAS unsigned char*)lds_raw + MISC_OFF) + 8; xcd_barrier(_b); } while (0)
#ifdef TSEL
#define PHASE_END(k) do { GRID_BAR(); if (blockIdx.x == 0 && threadIdx.x == 0) { const unsigned now = (unsigned)wall_clock64(); if ((((unsigned)(TSEL)) >> (k)) & 1u) MISC[16] += (now - MISC[17]) * (unsigned)(TMUL); MISC[17] = now; } } while (0)
#else
#define PHASE_END(k) GRID_BAR()
#endif
#define RING ((LAS unsigned char*)lds_raw)
#define EPISCR ((LAS unsigned char*)lds_raw + EPI_OFF)
#define WSP(off) (ap->ws + (off))
#define MODP(li) ((const float*)WSP(WS_MOD) + (size_t)(li) * 9 * 6144)
#define XBP ((bf16*)WSP(WS_XB))
#define HP ((bf16*)WSP(WS_H))
#define ARP(off) ((bf16*)(WSP(WS_ARENA) + (off)))
#define WSMP ((bf16*)WSP(WS_WSM))

#ifdef TSEL
    GRID_BAR(); if (blockIdx.x == 0 && threadIdx.x == 0) { MISC[16] = 0u; MISC[17] = (unsigned)wall_clock64(); }
#endif
    if constexpr (PH(0)) _Pragma("unroll 1") for (int rep_ = 0; rep_ < REPS(0); ++rep_) { MKFRAME(); prologue(F); }
    PHASE_END(0);
            PROBE_CHECK(1, WSP(WS_MOD), (size_t)4 * 9 * 6144, true); PROBE_CHECK(2, WSP(WS_ROPE), (size_t)SEQ * 64, true); PROBE_CHECK(3, WSP(WS_WSM), (W_FFN + 2 * W_FFN_SZ), false); PROBE_CHECK(4, WSP(WS_WMOE), WM_SZ, false);

#pragma unroll 1
    for (int j = 0; j < 2; ++j) {
        {
            const int li = 2 * j;
            if constexpr (PH(1)) _Pragma("unroll 1") for (int rep_ = 0; rep_ < REPS(1); ++rep_) { KArgs ap = ARGS(); MKFRAME();
                if (j == 0) norm_pass<false, 3, false, true>(F, ap->in[0], ap->in[2], XBP, T, ap->in[6] + li * 1024, MODP(li), 0, HP, nullptr, nullptr, nullptr, nullptr, nullptr);
                else norm_pass<false, 3>(F, nullptr, nullptr, XBP, T, ap->in[6] + li * 1024, MODP(li), 0, HP, nullptr, nullptr, nullptr, nullptr, nullptr);
                if (j == 1) { int cur = 0; conv_moe_layer(F, cur, 1); } }
            PHASE_END(1);
            PROBE_CHECK(10 + 20 * j, HP, (size_t)T * 1024, false);
            if constexpr (PH(2)) _Pragma("unroll 1") for (int rep_ = 0; rep_ < REPS(2); ++rep_) { KArgs ap = ARGS(); MKFRAME();
              SchedPlain S{(const char*)HP, (const char*)(WSMP + W_MLA + j * W_MLA_SZ + W_MLA_1), 2048, 2048, T / 256, 2, F.G, F.bx, 1 << 30, 16, make_split(T / 256 * 2, F.G, 8, false)};
              EpiStore1 E{{}, ARP(AR_QKVA), ap->in[9] + j * 256, ap->in[12] + j * 128, EPISCR};
              pg8::gemm_phase(RING, 1024, 1024, S, E); }
            PHASE_END(2);
            PROBE_CHECK(11 + 20 * j, ARP(AR_QKVA), (size_t)T * 512, false);
            if constexpr (PH(4)) _Pragma("unroll 1") for (int rep_ = 0; rep_ < REPS(4); ++rep_) { KArgs ap = ARGS(); MKFRAME();
              SchedA3 S{(const char*)ARP(AR_QKVA), (const char*)(WSMP + W_MLA + j * W_MLA_SZ + W_MLA_CAT), T / 256, F.G, F.bx};
              EpiStoreQKV E{{}, ARP(AR_Q), (unsigned char*)ARP(AR_K), (unsigned char*)ARP(AR_V), ARP(AR_QKVA), ap->in[15] + j * 192, (const float*)WSP(WS_ROPE), EPISCR};
              pg8::gemm_phase(RING, 256, 256, S, E); }
            PHASE_END(4);
            PROBE_CHECK(13 + 20 * j, ARP(AR_Q), (size_t)T * 1536, false); PROBE_CHECK(14 + 20 * j, ARP(AR_V), (size_t)T * 1024, false);
            if constexpr (PH(6)) _Pragma("unroll 1") for (int rep_ = 0; rep_ < REPS(6); ++rep_) { KArgs ap = ARGS(); MKFRAME(); bf16* AO = HP; const bf16* Qb = ARP(AR_Q); const unsigned char* K8 = (const unsigned char*)ARP(AR_K); const unsigned char* V8 = (const unsigned char*)ARP(AR_V); const float* gqn = ap->in[14] + j * 192; const float* ropeT = (const float*)WSP(WS_ROPE);
              const int nlat = NB * NH * 32, ntot = nlat + NB * NH;
              for (int u = F.vcu; u < ntot; u += F.G) {
                  __syncthreads();
                  if (u < nlat) { const int bh = u >> 5, qb = u & 31, b = bh >> 3, h = bh & 7; const size_t r0 = (size_t)b * SEQ, rc = (size_t)TL + (size_t)b * CTXL, rq = r0 + qb * 256;
                      const unsigned char* vbase = V8 + ((size_t)b * 132 * 8 + h) * 8192;
                      att8::attn_body(Qb + rq * 1536 + h * 192, K8 + r0 * 1536 + h * 192, vbase, K8 + rc * 1536 + h * 192, vbase + (size_t)128 * 65536, SEQ, SEQ + CTXL, AO + rq * 1024 + h * 128, (LAS char*)lds_raw, gqn, ropeT + (size_t)(qb * 256) * 64);
                  } else { const int bh = u - nlat, b = bh >> 3, h = bh & 7; const size_t rc = (size_t)TL + (size_t)b * CTXL;
                      const unsigned char* vbase = V8 + ((size_t)b * 132 * 8 + h) * 8192 + (size_t)128 * 65536;
                      att8::attn_body(Qb + rc * 1536 + h * 192, K8 + rc * 1536 + h * 192, vbase, K8 + rc * 1536 + h * 192, vbase, CTXL, CTXL, AO + rc * 1024 + h * 128, (LAS char*)lds_raw, gqn, nullptr);
                  }
              }
              __syncthreads(); }
            PHASE_END(6);
            PROBE_CHECK(17 + 20 * j, HP, (size_t)T * 1024, false);
            if constexpr (PH(7)) _Pragma("unroll 1") for (int rep_ = 0; rep_ < REPS(7); ++rep_) { KArgs ap = ARGS(); MKFRAME();
              const Split sp = make_split(T / 256 * 4, F.G, 8, false);
              SchedPlain S{(const char*)HP, (const char*)(WSMP + W_MLA + j * W_MLA_SZ + W_MLA_O), 2048, 2048, T / 256, 4, F.G, F.bx, 1 << 30, 16, sp};
              EpiResid E{{}, j == 0 ? ap->in[0] : nullptr, j == 0 ? ap->in[2] : nullptr, XBP, MODP(li) + 2 * 1024, (float*)ARP(AR_PART), 1.f};
              pg8::gemm_phase(RING, 1024, 1024, S, E);
              if (sp.Lf) { GRID_BAR(); reduce_resid(F, sp, T / 256, 4, (const float*)ARP(AR_PART), j == 0 ? ap->in[0] : nullptr, j == 0 ? ap->in[2] : nullptr, XBP, MODP(li) + 2 * 1024, 1.f); } }
            PHASE_END(7);
            PROBE_CHECK(18 + 20 * j, XLP, (size_t)TL * 1024, true); PROBE_CHECK(19 + 20 * j, XCP, (size_t)TC * 1024, true);
            if constexpr (PH(8)) _Pragma("unroll 1") for (int rep_ = 0; rep_ < REPS(8); ++rep_) { KArgs ap = ARGS(); MKFRAME();
              if ((FFN_F8_MASK >> j) & 1) norm_pass<false, 3, true>(F, nullptr, nullptr, XBP, T, ap->in[7] + li * 1024, MODP(li), 3, HP, nullptr, nullptr, nullptr, nullptr, nullptr);
              else norm_pass<false, 3, false>(F, nullptr, nullptr, XBP, T, ap->in[7] + li * 1024, MODP(li), 3, HP, nullptr, nullptr, nullptr, nullptr, nullptr); }
            PHASE_END(8);
            PROBE_CHECK(20 + 20 * j, HP, (size_t)T * 1024, false);
            if constexpr (PH(9)) _Pragma("unroll 1") for (int rep_ = 0; rep_ < REPS(9); ++rep_) { KArgs ap = ARGS(); MKFRAME();
              if ((FFN_F8_MASK >> j) & 1) {
                SchedPlain S{(const char*)HP, (const char*)(WSMP + W_FFN + j * W_FFN_SZ + W_FFN_13), 1024, 1024, T / 256, 22, F.G, F.bx, 1 << 30, 8, make_split(T / 256 * 22, F.G, 4, false)};
                EpiSwiglu8 E{{}, (unsigned char*)ARP(AR_HID), FF};
                pg8::gemm_phase_f8(RING, 1024, S, E);
              } else {
                SchedPlain S{(const char*)HP, (const char*)(WSMP + W_FFN + j * W_FFN_SZ + W_FFN_13), 2048, 2048, T / 256, 22, F.G, F.bx, 1 << 30, 16, make_split(T / 256 * 22, F.G, 8, false)};
                EpiSwiglu E{{}, ARP(AR_HID), FF};
                pg8::gemm_phase(RING, 1024, 1024, S, E);
              } }
            PHASE_END(9);
            PROBE_CHECK(21 + 20 * j, ARP(AR_HID), (size_t)T * FF, false);
            if constexpr (PH(10)) _Pragma("unroll 1") for (int rep_ = 0; rep_ < REPS(10); ++rep_) { KArgs ap = ARGS(); MKFRAME();
              if ((FFN_F8_MASK >> j) & 1) {
                const Split sp = make_split(T / 256 * 4, F.G, FF / 256, true);
                SchedPlain S{(const char*)ARP(AR_HID), (const char*)(WSMP + W_FFN + j * W_FFN_SZ + W_FFN_2), FF, FF, T / 256, 4, F.G, F.bx, 1 << 30, FF / 128, sp};
                EpiResid E{{}, nullptr, nullptr, XBP, MODP(li) + 5 * 1024, (float*)ARP(AR_PART), F8_INV};
                pg8::gemm_phase_f8(RING, FF, S, E);
                if (sp.Lf) { GRID_BAR(); reduce_resid(F, sp, T / 256, 4, (const float*)ARP(AR_PART), nullptr, nullptr, XBP, MODP(li) + 5 * 1024, F8_INV); }
              } else {
                const Split sp = make_split(T / 256 * 4, F.G, FF / 128, true);
                SchedPlain S{(const char*)ARP(AR_HID), (const char*)(WSMP + W_FFN + j * W_FFN_SZ + W_FFN_2), FF * 2, FF * 2, T / 256, 4, F.G, F.bx, 1 << 30, FF / 64, sp};
                EpiResid E{{}, nullptr, nullptr, XBP, MODP(li) + 5 * 1024, (float*)ARP(AR_PART), 1.f};
                pg8::gemm_phase(RING, FF, FF, S, E);
                if (sp.Lf) { GRID_BAR(); reduce_resid(F, sp, T / 256, 4, (const float*)ARP(AR_PART), nullptr, nullptr, XBP, MODP(li) + 5 * 1024, 1.f); }
              } }
            PHASE_END(10);
            PROBE_CHECK(22 + 20 * j, XLP, (size_t)TL * 1024, true);
        }
        {
            const int li = 2 * j + 1;
            const int nrows_out = li < 3 ? T : TL;
            if constexpr (PH(11)) _Pragma("unroll 1") for (int rep_ = 0; rep_ < REPS(11); ++rep_) { KArgs ap = ARGS(); MKFRAME(); norm_pass<false, 3>(F, nullptr, nullptr, XBP, T, ap->in[6] + li * 1024, MODP(li), 0, HP, nullptr, nullptr, nullptr, nullptr, nullptr); }
            PHASE_END(11);
            PROBE_CHECK(50 + 20 * j, HP, (size_t)T * 1024, false);
            if constexpr (PH(12)) _Pragma("unroll 1") for (int rep_ = 0; rep_ < REPS(12); ++rep_) { KArgs ap = ARGS(); MKFRAME();
              SchedPlain S{(const char*)HP, (const char*)(WSMP + W_RG + j * W_RG_SZ + W_RG_IG), 2048, 2048, T / 256, 8, F.G, F.bx, 4, 16, make_split(T / 256 * 8, F.G, 8, false)};
              EpiStoreUG E{{}, ARP(AR_UPRE), ARP(AR_GATE)};
              pg8::gemm_phase(RING, 1024, 1024, S, E); }
            PHASE_END(12);
            PROBE_CHECK(51 + 20 * j, ARP(AR_UPRE), (size_t)T * 1024, false); PROBE_CHECK(52 + 20 * j, ARP(AR_GATE), (size_t)T * 1024, false);
            if constexpr (PH(13)) _Pragma("unroll 1") for (int rep_ = 0; rep_ < REPS(13); ++rep_) { KArgs ap = ARGS(); MKFRAME(); conv_pass(F, T, ARP(AR_UPRE), ARP(AR_U), ap->in[19] + j * 4096, ap->in[20] + j * 1024); }
            PHASE_END(13);
            PROBE_CHECK(53 + 20 * j, ARP(AR_U), (size_t)T * 1024, false);
#define SCANFLAGS ((unsigned*)WSP(WS_CTL) + CW_SCANF + j * 2 * 264 * 8)
            if constexpr (PH(15)) _Pragma("unroll 1") for (int rep_ = 0; rep_ < REPS(15); ++rep_) { KArgs ap = ARGS(); MKFRAME();
              SchedScan S{(const char*)ARP(AR_U), (const char*)(WSMP + W_RG + j * W_RG_SZ + W_RG_AX), 0, F.G, F.bx};
              EpiScan<0> E{ARP(AR_U), ap->in[22] + j * 2048, ap->in[24] + j * 2048, (const float*)WSP(WS_SPT) + j * 2048, (float*)WSP(WS_AGG), SCANFLAGS, (unsigned*)WSP(WS_CTL) + CW_ERR, HP, ARP(AR_GATE), li < 3 ? 1 : 0, EPISCR};
              { LAS float* tab_ = (LAS float*)(EPISCR + 4096); const float* b0_ = ap->in[22] + j * 2048 + 0 * 1024; const float* b1_ = ap->in[24] + j * 2048 + 0 * 1024; const float* b2_ = (const float*)WSP(WS_SPT) + j * 2048 + 0 * 1024;
                for (int i_ = F.tid; i_ < 1024; i_ += NTHR) { tab_[i_] = b0_[i_]; tab_[1024 + i_] = b1_[i_]; tab_[2048 + i_] = b2_[i_]; }
                LDS_WAIT(); __syncthreads(); }
              pg8::gemm_phase(RING, 256, 256, S, E); }
            PHASE_END(15);
            if constexpr (PH(16)) _Pragma("unroll 1") for (int rep_ = 0; rep_ < REPS(16); ++rep_) { KArgs ap = ARGS(); MKFRAME();
              SchedScan S{(const char*)ARP(AR_U), (const char*)(WSMP + W_RG + j * W_RG_SZ + W_RG_AX), 1, F.G, F.bx};
              EpiScan<1> E{ARP(AR_U), ap->in[22] + j * 2048, ap->in[24] + j * 2048, (const float*)WSP(WS_SPT) + j * 2048, (float*)WSP(WS_AGG), SCANFLAGS, (unsigned*)WSP(WS_CTL) + CW_ERR, HP, ARP(AR_GATE), li < 3 ? 1 : 0, EPISCR};
              { LAS float* tab_ = (LAS float*)(EPISCR + 4096); const float* b0_ = ap->in[22] + j * 2048 + 1 * 1024; const float* b1_ = ap->in[24] + j * 2048 + 1 * 1024; const float* b2_ = (const float*)WSP(WS_SPT) + j * 2048 + 1 * 1024;
                for (int i_ = F.tid; i_ < 1024; i_ += NTHR) { tab_[i_] = b0_[i_]; tab_[1024 + i_] = b1_[i_]; tab_[2048 + i_] = b2_[i_]; }
                LDS_WAIT(); __syncthreads(); }
              pg8::gemm_phase(RING, 256, 256, S, E); }
            PHASE_END(16);
            if constexpr (PH(17)) _Pragma("unroll 1") for (int rep_ = 0; rep_ < REPS(17); ++rep_) { KArgs ap = ARGS(); MKFRAME();
              const Split sp = make_split(nrows_out / 256 * 4, F.G, 8, false);
              SchedPlain S{(const char*)HP, (const char*)(WSMP + W_RG + j * W_RG_SZ + W_RG_OUT), 2048, 2048, nrows_out / 256, 4, F.G, F.bx, 1 << 30, 16, sp};
              EpiResid E{{}, nullptr, nullptr, XBP, MODP(li) + 2 * 1024, (float*)ARP(AR_PART), 1.f};
              pg8::gemm_phase(RING, 1024, 1024, S, E);
              if (sp.Lf) { GRID_BAR(); reduce_resid(F, sp, nrows_out / 256, 4, (const float*)ARP(AR_PART), nullptr, nullptr, XBP, MODP(li) + 2 * 1024, 1.f); } }
            PHASE_END(17);
            PROBE_CHECK(57 + 20 * j, XLP, (size_t)TL * 1024, true);
#define CNTP ((unsigned*)WSP(WS_CTL) + CW_CNT + j * 16 * 64)
#define RTP(off) (WSP(WS_ROUTE) + (off))
            if constexpr (PH(18)) _Pragma("unroll 1") for (int rep_ = 0; rep_ < REPS(18); ++rep_) { KArgs ap = ARGS(); MKFRAME();
              norm_pass<true, 3>(F, nullptr, nullptr, XBP, nrows_out, ap->in[7] + li * 1024, MODP(li), 3, HP, ap->in[30] + (size_t)j * 1024 * 8, (unsigned*)RTP(RT_BLK), (int*)RTP(RT_E), (int*)RTP(RT_RANK), (float*)RTP(RT_G)); }
            PHASE_END(18);
            PROBE_CHECK(58 + 20 * j, HP, (size_t)nrows_out * 1024, false);
            if constexpr (PH(19)) _Pragma("unroll 1") for (int rep_ = 0; rep_ < REPS(19); ++rep_) { KArgs ap = ARGS(); MKFRAME(); moe_lists(F, nrows_out, CNTP, (const int*)RTP(RT_BLK), (const int*)RTP(RT_E), (const int*)RTP(RT_RANK), (const float*)RTP(RT_G), (int*)RTP(RT_TOK), (float*)RTP(RT_GV)); }
            PHASE_END(19);
#pragma unroll 1
            for (int s = 0; s < 2; ++s) {
                if constexpr (PH(20)) _Pragma("unroll 1") for (int rep_ = 0; rep_ < REPS(20); ++rep_) { KArgs ap = ARGS(); MKFRAME(); MoeTiles mt; moe_tiles(CNTP + 64 * 8 * s, mt);
                  SchedMoeUp S{(const char*)HP, (const char*)(WSP(WS_WMOE) + WM_13), (const int*)RTP(RT_TOK) + s * MOE_ROWS, mt, F.G, F.bx};
                  EpiSwiglu8 E{{}, (unsigned char*)ARP(AR_HID), EH};
                  pg8::gemm_phase_f8(RING, 1024, S, E); }
                PHASE_END(20);
                if constexpr (PH(21)) _Pragma("unroll 1") for (int rep_ = 0; rep_ < REPS(21); ++rep_) { KArgs ap = ARGS(); MKFRAME(); MoeTiles mt; moe_tiles(CNTP + 64 * 8 * s, mt);
                  const Split sp = make_split(mt.ts[NE] * 4, F.G, 14, true);
                  SchedMoeDown S{(const char*)ARP(AR_HID), (const char*)(WSP(WS_WMOE) + WM_2), mt, F.G, F.bx, sp};
                  EpiMoeDown E{{}, XBP, (li == 3 && s == 1) ? ap->out : nullptr, MODP(li) + 5 * 1024, (const int*)RTP(RT_TOK) + s * MOE_ROWS, (const float*)RTP(RT_GV) + s * MOE_ROWS, (float*)ARP(AR_PART)};
                  pg8::gemm_phase_f8(RING, EH, S, E);
                  if (sp.Lf) { GRID_BAR(); reduce_moe(F, sp, mt.ts[NE], (const float*)ARP(AR_PART), XBP, (li == 3 && s == 1) ? ap->out : nullptr, MODP(li) + 5 * 1024, (const int*)RTP(RT_TOK) + s * MOE_ROWS, (const float*)RTP(RT_GV) + s * MOE_ROWS); } }
                PHASE_END(21);
            PROBE_CHECK(60 + 20 * j + s, XLP, (size_t)TL * 1024, true);
            }
        }
    }
#ifdef TSEL
    {   KArgs ap = ARGS(); unsigned* w = (unsigned*)WSP(WS_CTL) + 24576;
        if (blockIdx.x == 0 && threadIdx.x == 0) __hip_atomic_store(w, MISC[16], __ATOMIC_RELAXED, __HIP_MEMORY_SCOPE_AGENT);
        GRID_BAR();
        const unsigned dur = __hip_atomic_load(w, __ATOMIC_RELAXED, __HIP_MEMORY_SCOPE_AGENT); const unsigned t0 = (unsigned)wall_clock64();
        while ((unsigned)wall_clock64() - t0 < dur) __builtin_amdgcn_s_sleep(8);
    }
#endif
#ifdef PROBE
    {
        KArgs ap = ARGS(); const unsigned w = *((volatile unsigned*)WSP(WS_CTL) + CW_PROBE); const int id = w ? 1000 - (int)w : 89;
        float* o = ap->out; const unsigned gt = blockIdx.x * NTHR + (unsigned)opaque_tid(), NGT = gridDim.x * NTHR;
        for (unsigned i = gt; i < (unsigned)TL * D; i += NGT) o[i] = (i == 0) ? (float)(10 + id) * 1.0e4f : 0.f;
    }
#endif
}

extern "C" void kernel_launch(void* const* d_in, const int* in_sizes, int n_in, void* d_out, int out_size, void* d_ws, size_t ws_size, hipStream_t stream) {
    static int grid = 0;
    if (grid == 0) {
        if (n_in != 34 || out_size != TL * D || ws_size < WS_END) { fprintf(stderr, "kernel_launch: unexpected shapes: n_in %d out %d ws %zu (need %zu)\n", n_in, out_size, ws_size, (size_t)WS_END); grid = -1; return; }
        int dev = 0, cus = 0, per_cu = 0;
        if (hipGetDevice(&dev) != hipSuccess || hipDeviceGetAttribute(&cus, hipDeviceAttributeMultiprocessorCount, dev) != hipSuccess) { grid = -1; return; }
        if (hipFuncSetAttribute((const void*)fwd_kernel, hipFuncAttributeMaxDynamicSharedMemorySize, LDS_BYTES) != hipSuccess) { fprintf(stderr, "kernel_launch: hipFuncSetAttribute failed\n"); grid = -1; return; }
        if (hipOccupancyMaxActiveBlocksPerMultiprocessor(&per_cu, (const void*)fwd_kernel, NTHR, LDS_BYTES) != hipSuccess || per_cu < 1) { fprintf(stderr, "kernel_launch: occupancy query says %d\n", per_cu); (void)hipGetLastError(); }
        grid = cus & ~7;
    }
    if (grid < 0) return;
    (void)hipMemsetAsync((char*)d_ws + WS_CTL, 0, CTL_BYTES, stream);
    Args a{};
    for (int i = 0; i < 34; ++i) a.in[i] = (const float*)d_in[i];
    a.out = (float*)d_out; a.ws = (unsigned char*)d_ws;
    hipLaunchKernelGGL(fwd_kernel, dim3(grid), dim3(NTHR), LDS_BYTES, stream, a);
    const hipError_t le = hipPeekAtLastError();
    if (le != hipSuccess) fprintf(stderr, "kernel_launch: launch failed: %s\n", hipGetErrorName(le));
}
```

```cpp
#include <hip/hip_runtime.h>
#include <cstdio>
#include <cstdint>

#define GAS __attribute__((address_space(1)))
#define LAS __attribute__((address_space(3)))
typedef unsigned short bf16;
typedef short bf16x8 __attribute__((ext_vector_type(8)));
typedef short s16x4 __attribute__((ext_vector_type(4)));
typedef float f32x2 __attribute__((ext_vector_type(2)));
typedef float f32x4 __attribute__((ext_vector_type(4)));
typedef float f32x16 __attribute__((ext_vector_type(16)));
typedef unsigned u32x2 __attribute__((ext_vector_type(2)));
typedef unsigned u32x4 __attribute__((ext_vector_type(4)));
typedef int i32x4 __attribute__((ext_vector_type(4)));
typedef int i32x8 __attribute__((ext_vector_type(8)));

constexpr int D = 1024, NB = 8, SEQ = 8192, CTXL = 256;
constexpr int TL = NB * SEQ, TC = NB * CTXL, T = TL + TC;
constexpr int NH = 8, QLORA = 256, KVLORA = 128, ROPE = 64, NOPE = 128, VD = 128, QK = 192;
constexpr int FF = 2816, NE = 8, EH = 3584;
constexpr float EPS = 1e-6f;
constexpr int NWAVES = 8, NTHR = 512;

constexpr size_t MiB = 1u << 20;
constexpr size_t WS_CTL = 0, CTL_BYTES = 1 * MiB;
constexpr size_t WS_MOD = 1 * MiB;
constexpr size_t WS_XC = 2 * MiB;
constexpr size_t WS_AGG = 10 * MiB;
constexpr size_t WS_ROUTE = 15 * MiB;
constexpr size_t WS_ROPE = 18 * MiB;
static_assert(WS_AGG + (size_t)264 * 2 * 1024 * 2 * 4 <= 14 * MiB + 512 * 1024 && WS_ROPE + (size_t)8192 * 64 * 4 <= 20 * MiB, "ws map");
constexpr size_t WS_SPT = 14 * MiB + 512 * 1024;
constexpr size_t WS_WSM = 20 * MiB;
constexpr size_t WS_WMOE = 84 * MiB;
constexpr size_t WS_XB = 172 * MiB;
constexpr size_t WS_H = 304 * MiB;
constexpr size_t WS_ARENA = 436 * MiB;
constexpr size_t WS_END = 436 * MiB + 600 * MiB;
constexpr size_t W_MLA = 0;
constexpr size_t W_MLA_1 = 0, W_MLA_CAT = 512 * 1024, W_MLA_O = W_MLA_CAT + 3584 * 256, W_MLA_SZ = W_MLA_O + 1024 * 1024;
constexpr size_t W_RG = 2 * W_MLA_SZ;
constexpr size_t W_RG_IG = 0, W_RG_AX = 2048 * 1024, W_RG_OUT = W_RG_AX + 16 * 256 * 256, W_RG_SZ = W_RG_OUT + 1024 * 1024;
constexpr size_t W_FFN = W_RG + 2 * W_RG_SZ;
constexpr size_t W_FFN_13 = 0, W_FFN_2 = (size_t)5632 * 1024, W_FFN_SZ = W_FFN_2 + (size_t)1024 * 2816;
static_assert((W_FFN + 2 * W_FFN_SZ) * 2 <= 64 * MiB, "small weights fit");
constexpr size_t WM_13 = 0, WM_2 = (size_t)NE * 7168 * 1024, WM_SZ = WM_2 + (size_t)NE * 1024 * 3584;
static_assert(WM_SZ <= 88 * MiB && WS_WMOE + 88 * MiB <= WS_XB && WS_XB + (size_t)T * 1024 * 2 <= WS_H, "moe weights (fp8) and the residual stream fit");
static_assert(WS_H + (size_t)T * 1024 * 2 <= WS_ARENA, "H fits");
constexpr size_t AR_QKVA = 0;
constexpr size_t AR_Q = 66 * MiB;
constexpr size_t AR_K = AR_Q + 198 * MiB;
constexpr size_t AR_V = AR_K + 198 * MiB;
static_assert(AR_V + 132 * MiB <= 600 * MiB, "mla arena");
constexpr size_t AR_HID = 0;
static_assert((size_t)(T + 2048) * 3584 * 2 <= 600 * MiB, "moe hid fits");
constexpr size_t AR_UPRE = 0, AR_GATE = 132 * MiB, AR_U = 264 * MiB;
constexpr size_t AR_PART = 480 * MiB;
static_assert(AR_PART + 64 * MiB <= 600 * MiB && (size_t)(T + 2048) * 3584 * 2 <= AR_PART, "partials");
constexpr int MOE_ROWS = T + 2048;
constexpr size_t RT_E = 0, RT_RANK = RT_E + (size_t)T * 2 * 4, RT_G = RT_RANK + (size_t)T * 2 * 4, RT_TOK = RT_G + (size_t)T * 2 * 4, RT_GV = RT_TOK + (size_t)MOE_ROWS * 2 * 4;
constexpr size_t RT_BLK = RT_GV + (size_t)MOE_ROWS * 2 * 4;
static_assert(RT_BLK + 256 * 16 * 4 <= 3 * MiB, "routing fits");
constexpr int CW_BAR = 4096;
constexpr int CW_SCANF = 32768;
constexpr int CW_ERR = 24000;
constexpr int CW_CNT = 16384;

constexpr int RING_BYTES = 131072;
constexpr int EPI_OFF = RING_BYTES;
constexpr int MISC_OFF = EPI_OFF + 16384;
constexpr int LDS_BYTES = MISC_OFF + 256;

__device__ __forceinline__ int opaque_tid() { int t = threadIdx.x; asm volatile("" : "+v"(t)); return t; }
#define LDS_WAIT() asm volatile("s_waitcnt lgkmcnt(0)" ::: "memory")
#define VM_WAIT() asm volatile("s_waitcnt vmcnt(0)" ::: "memory")
__device__ __forceinline__ float bf2f(unsigned v) { return __uint_as_float(v << 16); }
__device__ __forceinline__ unsigned cvtpk(float lo, float hi) { unsigned r; asm volatile("v_cvt_pk_bf16_f32 %0, %1, %2" : "=v"(r) : "v"(lo), "v"(hi)); return r; }
__device__ __forceinline__ unsigned pk4_fp8(float a, float b, float c, float d) {
    a = __builtin_amdgcn_fmed3f(a, -448.f, 448.f); b = __builtin_amdgcn_fmed3f(b, -448.f, 448.f); c = __builtin_amdgcn_fmed3f(c, -448.f, 448.f); d = __builtin_amdgcn_fmed3f(d, -448.f, 448.f);
    int w = 0; w = __builtin_amdgcn_cvt_pk_fp8_f32(a, b, w, false); w = __builtin_amdgcn_cvt_pk_fp8_f32(c, d, w, true); return (unsigned)w;
}
constexpr float ATT_QS = 0.322672506f, ATT_KS = ATT_QS, ATT_VS = 4.f, ATT_PS = 16.f;
__host__ __device__ __forceinline__ int k8_pos(int d) { const int d0 = d >> 4, hi = (d >> 3) & 1, e = d & 7; return 64 * (d0 >> 2) + 32 * hi + 8 * (d0 & 3) + e; }
__host__ __device__ __forceinline__ int v8_pos(int k) { const int g = k >> 5, kk = k & 31, hi = (kk >> 2) & 1, r = (kk & 3) + 4 * (kk >> 3); return 32 * hi + 16 * g + r; }
constexpr int FFN_F8_MASK = 2;
constexpr float F8_ACT = 8.f, F8_WGT = 64.f, F8_INV = 1.f / (F8_ACT * F8_WGT);
__device__ __forceinline__ float ex2(float x) { return __builtin_amdgcn_exp2f(x); }
__device__ __forceinline__ float fexp(float x) { return __builtin_amdgcn_exp2f(x * 1.4426950408889634f); }
__device__ __forceinline__ float sigm(float x) { return __builtin_amdgcn_rcpf(1.f + fexp(-x)); }
__device__ __forceinline__ float silu_f(float x) { return x * sigm(x); }
__device__ __forceinline__ float gelu_tanh_f(float x) { const float t = x * x; const float w = fmaf(t, -1.029432396e-01f, -2.302208198e+00f);
    return x * __builtin_amdgcn_rcpf(1.f + __builtin_amdgcn_exp2f(x * w)); }
template <int K> __device__ __forceinline__ float lane_xor(float v) {
    return __int_as_float(__builtin_amdgcn_ds_swizzle(__float_as_int(v), 0x1f | (K << 10)));
}
__device__ __forceinline__ float half_sum(float v) {
    auto rr = __builtin_amdgcn_permlane32_swap(__float_as_uint(v), __float_as_uint(v), false, false); return __uint_as_float(rr[0]) + __uint_as_float(rr[1]);
}
__device__ __forceinline__ float wave_sum(float v) {
    v += lane_xor<1>(v); v += lane_xor<2>(v); v += lane_xor<4>(v); v += lane_xor<8>(v); v += lane_xor<16>(v); return half_sum(v);
}
template <int N> __device__ __forceinline__ float row_shr(float v, float fill) {
    return __int_as_float(__builtin_amdgcn_update_dpp(__float_as_int(fill), __float_as_int(v), 0x110 + N, 0xf, 0xf, false));
}
__device__ __forceinline__ void unpack8(u32x4 w, float (&f)[8]) {
    f[0] = bf2f(w.x & 0xffffu); f[1] = __uint_as_float(w.x & 0xffff0000u); f[2] = bf2f(w.y & 0xffffu); f[3] = __uint_as_float(w.y & 0xffff0000u);
    f[4] = bf2f(w.z & 0xffffu); f[5] = __uint_as_float(w.z & 0xffff0000u); f[6] = bf2f(w.w & 0xffffu); f[7] = __uint_as_float(w.w & 0xffff0000u);
}
__device__ __forceinline__ u32x4 pack8(const float (&f)[8]) { u32x4 w; w.x = cvtpk(f[0], f[1]); w.y = cvtpk(f[2], f[3]); w.z = cvtpk(f[4], f[5]); w.w = cvtpk(f[6], f[7]); return w; }

#define XB_TMO      128
#define XB_XCNT(j)  (256  + 64 * (j))
#define XB_XSUB(j)  (1280 + 64 * (j))
#define XB_XGEN(j)  (2304 + 64 * (j))
#define XB_TOP      3328
#define XB_TOPGEN   3392
#define XCD_BAR_WORDS 3456
#define XB_SPIN_CAP (1u << 21)
__device__ __forceinline__ unsigned xb_ld(unsigned* p)              { return __hip_atomic_load(p, __ATOMIC_RELAXED, __HIP_MEMORY_SCOPE_AGENT); }
__device__ __forceinline__ unsigned xb_add(unsigned* p, unsigned v) { return __hip_atomic_fetch_add(p, v, __ATOMIC_RELAXED, __HIP_MEMORY_SCOPE_AGENT); }
__device__ __forceinline__ unsigned xb_xcc_id() { return (unsigned)__builtin_amdgcn_s_getreg((3 << 11) | 20) & 0xFu; }
#define XB_SPIN(cond, bar) do { unsigned _sp = 0; while (cond) { __builtin_amdgcn_s_sleep(1); \
    if ((++_sp & 255u) == 0u) { if (xb_ld(&(bar)[XB_TMO])) break; if (_sp > XB_SPIN_CAP) { atomicAdd(&(bar)[XB_TMO], 1u); break; } } } } while (0)
struct XcdBarrier { unsigned* bar; unsigned x; volatile LAS unsigned* st; };
__device__ __forceinline__ XcdBarrier xcd_barrier_post(unsigned* bar, volatile LAS unsigned* st) {
    XcdBarrier b; b.bar = bar; b.x = xb_xcc_id(); b.st = st;
    if (threadIdx.x == 0) (void)xb_add(&bar[XB_XCNT(b.x)], 1u);
    return b;
}
__device__ __forceinline__ void xcd_barrier_complete(unsigned* bar, unsigned x, unsigned& nloc, unsigned& nx) {
    const unsigned G = gridDim.x * gridDim.y * gridDim.z;
    unsigned sum, cnt, mine, sp = 0u;
    for (;;) {
        sum = 0u; cnt = 0u; mine = 0u;
#pragma unroll
        for (unsigned j = 0; j < 16; ++j) { const unsigned c = xb_ld(&bar[XB_XCNT(j)]); sum += c; cnt += (c > 0u) ? 1u : 0u; mine = (j == x) ? c : mine; }
        if (sum == G) break;
        __builtin_amdgcn_s_sleep(1);
        if ((++sp & 255u) == 0u) { if (xb_ld(&bar[XB_TMO])) break; if (sp > XB_SPIN_CAP) { atomicAdd(&bar[XB_TMO], 1u); break; } }
    }
    nloc = mine > 0u ? mine : 1u; nx = cnt > 0u ? cnt : 1u;
}
__device__ __forceinline__ void xcd_barrier(const XcdBarrier& b) {
    asm volatile("s_waitcnt vmcnt(0)" ::: "memory");
    __syncthreads();
    if (threadIdx.x == 0) {
        unsigned* bar = b.bar;
        __builtin_amdgcn_s_waitcnt(0);
        unsigned nloc = b.st[0], nx = b.st[1];
        if (nloc == 0u) { xcd_barrier_complete(bar, b.x, nloc, nx); b.st[0] = nloc; b.st[1] = nx; }
        const unsigned old = xb_add(&bar[XB_XSUB(b.x)], 1u);
        const unsigned gen = old / nloc;
        if (old + 1u == (gen + 1u) * nloc) {
            __builtin_amdgcn_fence(__ATOMIC_RELEASE, "agent");
            asm volatile("s_waitcnt vmcnt(0)" ::: "memory");
            const unsigned og = xb_add(&bar[XB_TOP], 1u);
            const unsigned tg = og / nx;
            if (og + 1u == (tg + 1u) * nx) xb_add(&bar[XB_TOPGEN], 1u);
            else XB_SPIN(xb_ld(&bar[XB_TOPGEN]) == tg, bar);
            __builtin_amdgcn_fence(__ATOMIC_ACQUIRE, "agent");
            xb_add(&bar[XB_XGEN(b.x)], 1u);
            asm volatile("s_waitcnt vmcnt(0)" ::: "memory");
        } else {
            XB_SPIN(xb_ld(&bar[XB_XGEN(b.x)]) == gen, bar);
            __builtin_amdgcn_fence(__ATOMIC_ACQUIRE, "agent");
            asm volatile("s_waitcnt vmcnt(0)" ::: "memory");
        }
    }
    __syncthreads();
}

namespace pg8 {
constexpr int BM = 256, BK = 64, HALF = 128, HTB = HALF * BK * 2, STAGE_BYTES = 8 * HTB, NXCD = 8, WGM = 4;
__host__ __device__ __forceinline__ int lds_byte(int r, int c) { const int st = (r >> 4) * 2 + (c >> 5), rr = r & 15, cc = c & 31, ob = rr * 64 + cc * 2; return st * 1024 + (ob ^ (((ob >> 9) & 1) << 5)); }
__host__ __device__ __forceinline__ void stage_rc(int b, int& R, int& C) { const int st = b / 1024, sb = b % 1024, swz = sb ^ (((sb >> 9) & 1) << 5); R = (st >> 1) * 16 + swz / 64; C = (st & 1) * 32 + (swz % 64) / 2; }
__device__ __forceinline__ void tile_of(int L, int nM, int nN, int& pm, int& pn) {
    const int nwg = nM * nN; int wgid = L;
    { const int q = nwg / NXCD, r = nwg % NXCD, xcd = wgid % NXCD, off = wgid / NXCD; wgid = (xcd < r ? xcd * (q + 1) : r * (q + 1) + (xcd - r) * q) + off; }
    const int nig = WGM * nN, gid = wgid / nig, fm = gid * WGM, gsz = (nM - fm) < WGM ? (nM - fm) : WGM;
    pm = fm + ((wgid % nig) % gsz); pn = (wgid % nig) / gsz;
}
struct Unit { const char* A; const char* B; int pm, pn, t, nt, sub; };

template <class Epi, class Sched, bool FP8>
__device__ __forceinline__ void gemm_phase_impl(LAS unsigned char* lds, const int ldbB, const Sched& S, const Epi& E) {
    const int tid = opaque_tid(), wid = __builtin_amdgcn_readfirstlane(tid >> 6), lane = tid & 63, wr = wid >> 2, wc = wid & 3, fr = lane & 15, fq = lane >> 4;
    unsigned voffB[2];
#pragma unroll
    for (int i = 0; i < 2; ++i) { int R, C; stage_rc(tid * 16 + i * 8192, R, C); voffB[i] = (unsigned)(R * ldbB + C * 2); }
#define PG8_AOFFS(u, o0, o1) do { int _t = tid; asm volatile("" : "+v"(_t)); _Pragma("unroll") for (int _i = 0; _i < 2; ++_i) { int _R, _C; stage_rc(_t * 16 + _i * 8192, _R, _C); \
        o0[_i] = S.aoff(u, _R) + (unsigned)_C * 2u; o1[_i] = S.aoff(u, HALF + _R) + (unsigned)_C * 2u; } } while (0)
    const size_t kstep = (size_t)(BK * 2);
    const size_t hstepB = (size_t)HALF * ldbB;
    const unsigned ldsw = (unsigned)wid * 1024u;
    const int aoff = lds_byte(wr * 64 + fr, fq * 8), boff = lds_byte(wc * 32 + fr, fq * 8);
#define PG8_SA(b, h) (((b) * 2 + (h)) * HTB)
#define PG8_SB(b, h) ((4 + (b) * 2 + (h)) * HTB)
#define PG8_STAGE(bufoff, gbase, voff) do { _Pragma("unroll") for (int _i = 0; _i < 2; ++_i) { unsigned _o = (voff)[_i]; asm volatile("" : "+v"(_o));     \
        __builtin_amdgcn_global_load_lds((const unsigned*)((const char*)(gbase) + _o), (LAS unsigned*)(lds + (bufoff) + ldsw + _i * 8192), 16, 0, 0); } } while (0)
#define PG8_LDA(dst, b, h) do { if constexpr (FP8) { _Pragma("unroll") for (int m = 0; m < 4; ++m) { dst##8[m].lo = *(const LAS i32x4*)(lds + PG8_SA(b, h) + aoff + m * 2048); dst##8[m].hi = *(const LAS i32x4*)(lds + PG8_SA(b, h) + aoff + m * 2048 + 1024); } } \
        else { _Pragma("unroll") for (int m = 0; m < 4; ++m) _Pragma("unroll") for (int k = 0; k < 2; ++k) dst[m][k] = *(const LAS bf16x8*)(lds + PG8_SA(b, h) + aoff + m * 2048 + k * 1024); } } while (0)
#define PG8_LDB(dst, b, h) do { if constexpr (FP8) { _Pragma("unroll") for (int n = 0; n < 2; ++n) { dst##8[n].lo = *(const LAS i32x4*)(lds + PG8_SB(b, h) + boff + n * 2048); dst##8[n].hi = *(const LAS i32x4*)(lds + PG8_SB(b, h) + boff + n * 2048 + 1024); } } \
        else { _Pragma("unroll") for (int n = 0; n < 2; ++n) _Pragma("unroll") for (int k = 0; k < 2; ++k) dst[n][k] = *(const LAS bf16x8*)(lds + PG8_SB(b, h) + boff + n * 2048 + k * 1024); } } while (0)
#define PG8_CAT(x0, x1) __builtin_shufflevector(__builtin_bit_cast(i32x4, x0), __builtin_bit_cast(i32x4, x1), 0, 1, 2, 3, 4, 5, 6, 7)
#define PG8_MMA(ai, bj, At, Bt) do { __builtin_amdgcn_s_setprio(1); \
        if constexpr (FP8) { _Pragma("unroll") for (int m = 0; m < 4; ++m) _Pragma("unroll") for (int n = 0; n < 2; ++n) \
            asm volatile("v_mfma_f32_16x16x128_f8f6f4 %0, %1, %2, %0" : "+v"(acc[ai][bj][m][n]) : "v"(Bt##8[n]), "v"(At##8[m])); } \
        else { _Pragma("unroll") for (int m = 0; m < 4; ++m) _Pragma("unroll") for (int n = 0; n < 2; ++n) _Pragma("unroll") for (int k = 0; k < 2; ++k) \
            acc[ai][bj][m][n] = __builtin_amdgcn_mfma_f32_16x16x32_bf16(Bt[n][k], At[m][k], acc[ai][bj][m][n], 0, 0, 0); } \
        __builtin_amdgcn_s_setprio(0); } while (0)
#define PG8_WAIT_V(n) asm volatile("s_waitcnt vmcnt(" #n ")" ::: "memory")
#define PG8_WAIT_L(n) asm volatile("s_waitcnt lgkmcnt(" #n ")" ::: "memory")
#define PG8_BAR __builtin_amdgcn_s_barrier()
#define PG8_SCHED __builtin_amdgcn_sched_barrier(0)
    Unit cur, nxt; int ui = 0;
    if (!S.next(0, cur)) return;
    f32x4 acc[2][2][4][2];
    E.init(acc, cur, wr, wc, fr, fq);
    bf16x8 At[4][2], B0[2][2], B1[2][2];
    i32x8 At8[4], B08[2], B18[2];
    unsigned vA0[2], vA1[2], nA0[2], nA1[2];
    PG8_AOFFS(cur, vA0, vA1);
    const char* cA = cur.A; const char* cB = cur.B;
    PG8_STAGE(PG8_SB(0, 0), cB, voffB); PG8_STAGE(PG8_SB(0, 1), cB + hstepB, voffB); PG8_STAGE(PG8_SA(0, 0), cA, vA0); PG8_STAGE(PG8_SA(0, 1), cA, vA1);
    if (wr == 1) PG8_BAR;
    PG8_WAIT_V(2); PG8_BAR;
    PG8_STAGE(PG8_SB(1, 0), cB + kstep, voffB); PG8_STAGE(PG8_SA(1, 0), cA + kstep, vA0); PG8_STAGE(PG8_SB(1, 1), cB + hstepB + kstep, voffB);
    PG8_WAIT_V(6); PG8_BAR;
    for (;;) {
        const bool has_next = S.next(ui + 1, nxt);
        if (Sched::UNIT_A && has_next) { PG8_AOFFS(nxt, nA0, nA1); }
        else {
#pragma unroll
            for (int i = 0; i < 2; ++i) { nA0[i] = vA0[i]; nA1[i] = vA1[i]; }
        }
        const char* nA = has_next ? nxt.A : cA; const char* nB = has_next ? nxt.B : cB;
        const int nt = cur.nt;
        for (int t = 0; t < nt; t += 2) {
            const bool last = (t == nt - 2);
            const char* a1 = cA + (size_t)(t + 1) * kstep;
            const char* a2 = last ? nA : cA + (size_t)(t + 2) * kstep; const char* b2 = last ? nB : cB + (size_t)(t + 2) * kstep;
            const char* a3 = a2 + kstep; const char* b3 = b2 + kstep;
            unsigned w0[2], w1[2];
#pragma unroll
            for (int i = 0; i < 2; ++i) { w0[i] = last ? nA0[i] : vA0[i]; w1[i] = last ? nA1[i] : vA1[i]; }
            PG8_LDB(B0, 0, 0); PG8_LDB(B1, 0, 1); PG8_SCHED; PG8_LDA(At, 0, 0); PG8_STAGE(PG8_SA(1, 1), a1, vA1);
            PG8_WAIT_V(8); PG8_WAIT_L(0); PG8_BAR; PG8_MMA(0, 0, At, B0); PG8_MMA(0, 1, At, B1); PG8_BAR; PG8_SCHED;
            PG8_LDA(At, 0, 1); PG8_STAGE(PG8_SB(0, 0), b2, voffB); PG8_STAGE(PG8_SB(0, 1), b2 + hstepB, voffB); PG8_STAGE(PG8_SA(0, 0), a2, w0);
            PG8_WAIT_V(8); PG8_WAIT_L(0); PG8_BAR; PG8_MMA(1, 0, At, B0); PG8_MMA(1, 1, At, B1); PG8_BAR; PG8_SCHED;
            PG8_LDB(B0, 1, 0); PG8_LDB(B1, 1, 1); PG8_SCHED; PG8_LDA(At, 1, 0); PG8_STAGE(PG8_SA(0, 1), a2, w1);
            PG8_WAIT_V(8); PG8_WAIT_L(0); PG8_BAR; PG8_MMA(0, 0, At, B0); PG8_MMA(0, 1, At, B1); PG8_BAR; PG8_SCHED;
            PG8_LDA(At, 1, 1); PG8_STAGE(PG8_SB(1, 0), b3, voffB); PG8_STAGE(PG8_SB(1, 1), b3 + hstepB, voffB); PG8_STAGE(PG8_SA(1, 0), a3, w0);
            PG8_WAIT_V(8); PG8_WAIT_L(0); PG8_BAR; PG8_MMA(1, 0, At, B0); PG8_MMA(1, 1, At, B1); PG8_BAR; PG8_SCHED;
        }
        if (wr == 0) PG8_BAR;
        if constexpr (FP8) asm volatile("s_nop 15\n\ts_nop 15" ::: "memory");
        { int l2 = lane; asm volatile("" : "+v"(l2));
          E(acc, cur, wr, wc, l2 & 15, l2 >> 4, l2, wid);
          if (!has_next) break;
          E.init(acc, nxt, wr, wc, l2 & 15, l2 >> 4); }
        cur = nxt; cA = nA; cB = nB; ++ui;
#pragma unroll
        for (int i = 0; i < 2; ++i) { vA0[i] = nA0[i]; vA1[i] = nA1[i]; }
        if (wr == 1) PG8_BAR;
    }
    PG8_WAIT_V(0);
    PG8_BAR;
#undef PG8_AOFFS
#undef PG8_CAT
#undef PG8_SA
#undef PG8_SB
#undef PG8_STAGE
#undef PG8_LDA
#undef PG8_LDB
#undef PG8_MMA
#undef PG8_WAIT_V
#undef PG8_WAIT_L
#undef PG8_BAR
#undef PG8_SCHED
}
template <class Epi, class Sched> __device__ __forceinline__ void gemm_phase(LAS unsigned char* lds, const int, const int ldb, const Sched& S, const Epi& E) { gemm_phase_impl<Epi, Sched, false>(lds, ldb * 2, S, E); }
template <class Epi, class Sched> __device__ __forceinline__ void gemm_phase_f8(LAS unsigned char* lds, const int ldbB, const Sched& S, const Epi& E) { gemm_phase_impl<Epi, Sched, true>(lds, ldbB, S, E); }
}
using pg8::Unit;

__host__ __device__ __forceinline__ int phys_of_logical(int ll) { return (ll & ~31) | (((ll >> 2) & 1) << 4) | (((ll >> 3) & 3) << 2) | (ll & 3); }
__host__ __device__ __forceinline__ int phys_of_pair(int hl, int n) { return 128 * ((hl >> 2) & 1) + 32 * (hl >> 5) + 16 * n + 4 * ((hl >> 3) & 3) + (hl & 3); }

struct Args { const float* in[34]; float* out; unsigned char* ws; };
struct Frame {
    LAS unsigned char* lds;
    int tid, lane, wave, vcu, G, bx;
};
typedef const Args __attribute__((address_space(4)))* KArgs;
#define ARGS() ({ KArgs _p = (KArgs)__builtin_amdgcn_kernarg_segment_ptr(); asm volatile("" : "+s"(_p)); _p; })
__device__ __forceinline__ int row_vec(int row) { return row < TL ? (row >> 13) : NB; }

struct Split { int F, Lf, S; };
__device__ __forceinline__ Split make_split(int U, int G, int pairs, bool enable) {
    Split sp; sp.F = enable ? (U / G) * G : U; sp.Lf = U - sp.F; int S = sp.Lf ? G / sp.Lf : 1; S = S > 8 ? 8 : S; S = S > pairs ? pairs : S; sp.S = S < 1 ? 1 : S;
    if (sp.S == 1) { sp.F = U; sp.Lf = 0; }
    return sp;
}
struct SchedPlain {
    static constexpr bool UNIT_A = false;
    const char* A; const char* B; int lda2, ldb2, nM, nN, G, c, tsplit, ntf; Split sp;
    __device__ __forceinline__ bool next(int i, Unit& u) const {
        const int L = i * G + c; int ui, p0 = 0, p1 = ntf >> 1; u.sub = -1;
        if (L < sp.F) ui = L;
        else { const int q = L - sp.F; if (q >= sp.Lf * sp.S) return false; const int l = q % sp.Lf, si = q / sp.Lf; ui = sp.F + l; u.sub = l * sp.S + si; p0 = si * p1 / sp.S; p1 = (si + 1) * p1 / sp.S; }
        pg8::tile_of(ui, nM, nN, u.pm, u.pn); u.t = u.pn >= tsplit ? 1 : 0; u.nt = 2 * (p1 - p0);
        u.A = A + (size_t)u.pm * 256 * lda2 + p0 * 256; u.B = B + (size_t)u.pn * 256 * ldb2 + p0 * 256; return true;
    }
    __device__ __forceinline__ unsigned aoff(const Unit&, int r) const { return (unsigned)(r * lda2); }
};
struct SchedA3 {
    static constexpr bool UNIT_A = false;
    const char* A; const char* B; int nM, G, c;
    __device__ __forceinline__ bool next(int i, Unit& u) const {
        const int L = i * G + c; if (L >= nM * 14) return false;
        pg8::tile_of(L, nM, 14, u.pm, u.pn); u.t = u.pn < 6 ? 0 : (u.pn < 10 ? 1 : 2); u.nt = 4; u.sub = -1;
        u.A = A + (size_t)u.pm * 256 * 1024 + (u.pn < 6 ? 0 : 512); u.B = B + (size_t)u.pn * 256 * 512; return true;
    }
    __device__ __forceinline__ unsigned aoff(const Unit&, int r) const { return (unsigned)(r * 1024); }
};
__device__ __forceinline__ int scan_pos(int r) { return (((r >> 6) & 1) * 16 + (r & 15)) * 8 + ((r >> 7) * 4 + ((r >> 4) & 3)); }
__device__ __forceinline__ int chain_tile(int b, int d, int p) { return p == 0 ? 256 + b : (d ? b * 32 + 32 - p : b * 32 + p - 1); }
struct SchedScan {
    static constexpr bool UNIT_A = true;
    const char* A; const char* B; int d, G, c;
    __device__ __forceinline__ bool next(int i, Unit& u) const {
        const int L = i * G + c; if (L >= 33 * 64) return false;
        const int q = L >> 6, b = (L >> 3) & 7, hh = L & 7;
        u.pm = chain_tile(b, d, q); u.pn = d * 8 + hh; u.t = q; u.nt = 4; u.sub = -1;
        u.A = A + (size_t)u.pm * 256 * 2048 + (hh >> 1) * 512; u.B = B + (size_t)u.pn * 256 * 512; return true;
    }
    __device__ __forceinline__ unsigned aoff(const Unit&, int r) const { const int s = scan_pos(r); return (unsigned)((d ? 255 - s : s) * 2048); }
};
struct MoeTiles { int ts[NE + 1]; };
__device__ __forceinline__ void moe_tiles(const unsigned* cnt, MoeTiles& mt) {
    int a = 0;
#pragma unroll
    for (int e = 0; e < NE; ++e) { mt.ts[e] = a; a += (int)((cnt[64 * e] + 255u) >> 8); }
    mt.ts[NE] = a;
}
__device__ __forceinline__ int moe_ts_of(const MoeTiles& mt, int e) { int r = 0;
#pragma unroll
    for (int k = 0; k < NE; ++k) r = (e == k) ? mt.ts[k] : r;
    return r; }
__device__ __forceinline__ int moe_expert_of(const MoeTiles& mt, int pm) { int e = 0;
#pragma unroll
    for (int k = 1; k < NE; ++k) e += (pm >= mt.ts[k]) ? 1 : 0;
    return e; }
struct SchedMoeUp {
    static constexpr bool UNIT_A = true;
    const char* A; const char* B; const int* tok; MoeTiles mt; int G, c;
    __device__ __forceinline__ bool next(int i, Unit& u) const {
        const int nM = mt.ts[NE]; const int L = i * G + c; if (L >= nM * 28) return false;
        pg8::tile_of(L, nM, 28, u.pm, u.pn); u.t = moe_expert_of(mt, u.pm); u.nt = 8; u.sub = -1;
        u.A = A; u.B = B + ((size_t)u.t * 7168 + (size_t)u.pn * 256) * 1024; return true;
    }
    __device__ __forceinline__ unsigned aoff(const Unit& u, int r) const { int tk = tok[u.pm * 256 + r]; tk = tk < 0 ? 0 : tk; return (unsigned)tk * 1024u; }
};
struct SchedMoeDown {
    static constexpr bool UNIT_A = false;
    const char* A; const char* B; MoeTiles mt; int G, c; Split sp;
    __device__ __forceinline__ bool next(int i, Unit& u) const {
        const int nM = mt.ts[NE]; const int L = i * G + c; int ui, p0 = 0, p1 = 14; u.sub = -1;
        if (L < sp.F) ui = L;
        else { const int q = L - sp.F; if (q >= sp.Lf * sp.S) return false; const int l = q % sp.Lf, si = q / sp.Lf; ui = sp.F + l; u.sub = l * sp.S + si; p0 = si * 14 / sp.S; p1 = (si + 1) * 14 / sp.S; }
        pg8::tile_of(ui, nM, 4, u.pm, u.pn); u.t = moe_expert_of(mt, u.pm); u.nt = 2 * (p1 - p0);
        u.A = A + (size_t)u.pm * 256 * 3584 + p0 * 256; u.B = B + ((size_t)u.t * 1024 + (size_t)u.pn * 256) * 3584 + p0 * 256; return true;
    }
    __device__ __forceinline__ unsigned aoff(const Unit&, int r) const { return (unsigned)(r * 3584); }
};

typedef f32x4 Acc[2][2][4][2];
struct EpiZero {
    __device__ __forceinline__ void init(Acc& acc, const Unit&, int, int, int, int) const {
#pragma unroll
        for (int a = 0; a < 2; ++a)
#pragma unroll
            for (int b = 0; b < 2; ++b)
#pragma unroll
                for (int m = 0; m < 4; ++m)
#pragma unroll
                    for (int n = 0; n < 2; ++n) acc[a][b][m][n] = (f32x4){0.f, 0.f, 0.f, 0.f};
    }
};
template <int LDC, int BS, int ACT>
__device__ __forceinline__ void epi_store_tile(const Acc& acc, bf16* dst, int pm, int ct, int wr, int wc, int fr, int fq) {
    bf16* p0 = dst + (size_t)(pm * 256 + wr * 64 + fr) * LDC + ct * (2 * BS) + wc * 32 + fq * 8;
#pragma unroll
    for (int ai = 0; ai < 2; ++ai)
#pragma unroll
        for (int m = 0; m < 4; ++m) { bf16* rowp = p0 + (size_t)(ai * 128 + m * 16) * LDC;
#pragma unroll
            for (int bj = 0; bj < 2; ++bj) { f32x4 v0 = acc[ai][bj][m][0], v1 = acc[ai][bj][m][1];
                if (ACT) {
#pragma unroll
                    for (int j = 0; j < 4; ++j) { v0[j] = gelu_tanh_f(v0[j]); v1[j] = gelu_tanh_f(v1[j]); } }
                u32x4 w; w.x = cvtpk(v0[0], v0[1]); w.y = cvtpk(v0[2], v0[3]); w.z = cvtpk(v1[0], v1[1]); w.w = cvtpk(v1[2], v1[3]);
                *(u32x4*)(rowp + bj * BS) = w; } }
}
struct EpiStore1 : EpiZero {
    bf16* b0; const float* gq; const float* gkv; LAS unsigned char* scr;
    __device__ __forceinline__ void operator()(const Acc& acc, const Unit& u, int wr, int wc, int fr, int fq, int, int) const {
        LAS float* P = (LAS float*)scr;
        const bool qt = u.pn == 0;
#pragma unroll
        for (int ai = 0; ai < 2; ++ai)
#pragma unroll
            for (int m = 0; m < 4; ++m) { float s = 0.f;
#pragma unroll
                for (int bj = 0; bj < 2; ++bj)
#pragma unroll
                    for (int n = 0; n < 2; ++n) { const f32x4 x = acc[ai][bj][m][n]; const float t = (x[0] * x[0] + x[1] * x[1]) + (x[2] * x[2] + x[3] * x[3]); s += (qt || bj == 0) ? t : 0.f; }
                s += lane_xor<16>(s); s = half_sum(s);
                if (fq == 0) P[(ai * 128 + wr * 64 + m * 16 + fr) * 4 + wc] = s; }
        LDS_WAIT(); __builtin_amdgcn_s_barrier(); asm volatile("" ::: "memory");
        const int cl = wc * 32 + fq * 8;
        float g0[8], g1[8];
#pragma unroll
        for (int i = 0; i < 8; ++i) { g0[i] = qt ? gq[cl + i] : gkv[cl + i]; g1[i] = qt ? gq[128 + cl + i] : 1.f; }
        bf16* p0 = b0 + (size_t)(u.pm * 256 + wr * 64 + fr) * 512 + u.pn * 256 + cl;
#pragma unroll
        for (int ai = 0; ai < 2; ++ai)
#pragma unroll
            for (int m = 0; m < 4; ++m) { const int r = ai * 128 + wr * 64 + m * 16 + fr; const f32x4 pv = *(const LAS f32x4*)(P + r * 4);
                const float rstd = rsqrtf(((pv[0] + pv[1]) + (pv[2] + pv[3])) * (qt ? 1.f / 256 : 1.f / 128) + EPS); const float r1 = qt ? rstd : 1.f;
                bf16* rowp = p0 + (size_t)(ai * 128 + m * 16) * 512;
                { const f32x4 v0 = acc[ai][0][m][0], v1 = acc[ai][0][m][1];
                  u32x4 w; w.x = cvtpk(v0[0] * rstd * g0[0], v0[1] * rstd * g0[1]); w.y = cvtpk(v0[2] * rstd * g0[2], v0[3] * rstd * g0[3]); w.z = cvtpk(v1[0] * rstd * g0[4], v1[1] * rstd * g0[5]); w.w = cvtpk(v1[2] * rstd * g0[6], v1[3] * rstd * g0[7]);
                  *(u32x4*)rowp = w; }
                { const f32x4 v0 = acc[ai][1][m][0], v1 = acc[ai][1][m][1];
                  u32x4 w; w.x = cvtpk(v0[0] * r1 * g1[0], v0[1] * r1 * g1[1]); w.y = cvtpk(v0[2] * r1 * g1[2], v0[3] * r1 * g1[3]); w.z = cvtpk(v1[0] * r1 * g1[4], v1[1] * r1 * g1[5]); w.w = cvtpk(v1[2] * r1 * g1[6], v1[3] * r1 * g1[7]);
                  *(u32x4*)(rowp + 128) = w; } }
    }
};
struct EpiStoreQKV : EpiZero {
    bf16* q; unsigned char* k; unsigned char* v; const bf16* qkva; const float* gkn; const float* rope; LAS unsigned char* scr;
    __device__ __forceinline__ void operator()(const Acc& acc, const Unit& u, int wr, int wc, int fr, int fq, int lane, int wid) const {
        if (u.t == 0) { epi_store_tile<1536, 128, 0>(acc, q, u.pm, u.pn, wr, wc, fr, fq); return; }
        if (u.t == 2) {
            const int vt = u.pn - 10, pm = u.pm; const int kb0 = pm < 256 ? (pm >> 5) * 132 + (pm & 31) * 4 : (pm - 256) * 132 + 128;
            float vs4; asm volatile("v_mov_b32 %0, 4.0" : "=v"(vs4)); static_assert(ATT_VS == 4.f, "vs4");
#pragma unroll
            for (int ai = 0; ai < 2; ++ai)
#pragma unroll
                for (int bj = 0; bj < 2; ++bj) { unsigned char* vb = v + (((size_t)(kb0 + 2 * ai + wr) * 8 + (2 * vt + bj)) * 128 + wc * 32 + fq * 8) * 64;
#pragma unroll
                    for (int m = 0; m < 4; ++m) { const int kp = v8_pos(16 * m + fr);
#pragma unroll
                        for (int n = 0; n < 2; ++n) { const f32x4 x = acc[ai][bj][m][n] * vs4; const unsigned w = pk4_fp8(x[0], x[1], x[2], x[3]);
#pragma unroll
                            for (int jj = 0; jj < 4; ++jj) vb[(4 * n + jj) * 64 + kp] = (unsigned char)(w >> (8 * jj)); } } }
            return; }
        LAS float* P = (LAS float*)scr;
        float ks4; asm volatile("v_mov_b32 %0, 0x3ea53555" : "=v"(ks4)); static_assert(ATT_KS == 0.322672506f, "ks4");
        LAS float* PE = P + 2048;
        const int hp = u.pn - 6, rt = u.pm * 256, tid = wid * 64 + lane;
#pragma unroll
        for (int ai = 0; ai < 2; ++ai)
#pragma unroll
            for (int m = 0; m < 4; ++m)
#pragma unroll
                for (int bj = 0; bj < 2; ++bj) { const f32x4 x0 = acc[ai][bj][m][0], x1 = acc[ai][bj][m][1];
                    float s = ((x0[0] * x0[0] + x0[1] * x0[1]) + (x0[2] * x0[2] + x0[3] * x0[3])) + ((x1[0] * x1[0] + x1[1] * x1[1]) + (x1[2] * x1[2] + x1[3] * x1[3]));
                    s += lane_xor<16>(s); s = half_sum(s);
                    if (fq == 0) P[((ai * 128 + wr * 64 + m * 16 + fr) * 2 + bj) * 4 + wc] = s; }
        const int prow = tid >> 1, half = tid & 1; const int grow = rt + prow;
        u32x4 kw[4];
#pragma unroll
        for (int i = 0; i < 4; ++i) kw[i] = *(const u32x4*)(qkva + (size_t)grow * 512 + 384 + half * 32 + i * 8);
        { float s = 0.f;
#pragma unroll
          for (int i = 0; i < 4; ++i) { float f[8]; unpack8(kw[i], f);
#pragma unroll
              for (int e = 0; e < 8; ++e) s += f[e] * f[e]; }
          s += lane_xor<1>(s);
          if (half == 0) PE[prow] = s; }
        LDS_WAIT(); __builtin_amdgcn_s_barrier(); asm volatile("" ::: "memory");
        { const int cl = wc * 32 + fq * 8; float g[8];
#pragma unroll
          for (int i = 0; i < 8; ++i) g[i] = gkn[cl + i] * ks4;
          unsigned char* p0 = k + (size_t)(rt + wr * 64 + fr) * 1536 + (2 * hp) * 192 + k8_pos(cl);
#pragma unroll
          for (int ai = 0; ai < 2; ++ai)
#pragma unroll
            for (int m = 0; m < 4; ++m) { const int r = ai * 128 + wr * 64 + m * 16 + fr; const float pe = PE[r];
#pragma unroll
                for (int bj = 0; bj < 2; ++bj) { const f32x4 pv = *(const LAS f32x4*)(P + (r * 2 + bj) * 4);
                    const float rstd = rsqrtf((((pv[0] + pv[1]) + (pv[2] + pv[3])) + pe) * (1.f / 192) + EPS);
                    const f32x4 v0 = acc[ai][bj][m][0], v1 = acc[ai][bj][m][1];
                    *(u32x2*)(p0 + (size_t)(ai * 128 + m * 16) * 1536 + bj * 192) = (u32x2){pk4_fp8(v0[0] * rstd * g[0], v0[1] * rstd * g[1], v0[2] * rstd * g[2], v0[3] * rstd * g[3]),
                                                                                           pk4_fp8(v1[0] * rstd * g[4], v1[1] * rstd * g[5], v1[2] * rstd * g[6], v1[3] * rstd * g[7])}; } } }
        { const bool lat = grow < TL; const int pos = grow & (SEQ - 1); const float pe = PE[prow];
          float rs[2];
#pragma unroll
          for (int bj = 0; bj < 2; ++bj) { const f32x4 pv = *(const LAS f32x4*)(P + (prow * 2 + bj) * 4); rs[bj] = rsqrtf((((pv[0] + pv[1]) + (pv[2] + pv[3])) + pe) * (1.f / 192) + EPS) * ks4; }
#pragma unroll
          for (int i = 0; i < 4; ++i) { float f[8]; unpack8(kw[i], f);
              float y[8];
#pragma unroll
              for (int e = 0; e < 8; ++e) { const float gv = gkn[128 + half * 32 + i * 8 + e]; const float x = f[e] * gv; const float other = lane_xor<1>(x);
                  float c = 1.f, sn = 0.f; if (lat) { const f32x2 cs = *(const f32x2*)(rope + ((size_t)pos * 32 + i * 8 + e) * 2); c = cs.x; sn = cs.y; }
                  y[e] = half == 0 ? x * c - other * sn : x * c + other * sn; }
              unsigned char* kp = k + (size_t)grow * 1536 + (2 * hp) * 192 + k8_pos(128 + half * 32 + i * 8);
              *(u32x2*)kp = (u32x2){pk4_fp8(y[0] * rs[0], y[1] * rs[0], y[2] * rs[0], y[3] * rs[0]), pk4_fp8(y[4] * rs[0], y[5] * rs[0], y[6] * rs[0], y[7] * rs[0])};
              *(u32x2*)(kp + 192) = (u32x2){pk4_fp8(y[0] * rs[1], y[1] * rs[1], y[2] * rs[1], y[3] * rs[1]), pk4_fp8(y[4] * rs[1], y[5] * rs[1], y[6] * rs[1], y[7] * rs[1])}; } }
    }
};
struct EpiStoreUG : EpiZero {
    bf16* up; bf16* gate;
    __device__ __forceinline__ void operator()(const Acc& acc, const Unit& u, int wr, int wc, int fr, int fq, int, int) const {
        if (u.t == 0) epi_store_tile<1024, 128, 0>(acc, up, u.pm, u.pn, wr, wc, fr, fq);
        else epi_store_tile<1024, 128, 1>(acc, gate, u.pm, u.pn - 4, wr, wc, fr, fq);
    }
};
__device__ __forceinline__ void store_partial(const Acc& acc, float* part, int sub, int wr, int wc, int fr, int fq) {
    float* p0 = part + (size_t)sub * 65536 + (wr * 64 + fr) * 256 + wc * 32 + 4 * fq;
#pragma unroll
    for (int ai = 0; ai < 2; ++ai)
#pragma unroll
        for (int m = 0; m < 4; ++m)
#pragma unroll
            for (int bj = 0; bj < 2; ++bj)
#pragma unroll
                for (int n = 0; n < 2; ++n) *(f32x4*)(p0 + (ai * 128 + m * 16) * 256 + bj * 128 + n * 16) = acc[ai][bj][m][n];
}
struct EpiResid : EpiZero {
    const float* inL; const float* inC; bf16* xb; const float* gate; float* part; float scale;
    __device__ __forceinline__ void operator()(const Acc& acc, const Unit& u, int wr, int wc, int fr, int fq, int, int) const {
        if (u.sub >= 0) { store_partial(acc, part, u.sub, wr, wc, fr, fq); return; }
        const int rt = u.pm * 256; const bool lat = rt < TL; const bool f32in = inL != nullptr;
        const float* ib = f32in ? (lat ? inL + (size_t)rt * D : inC + (size_t)(rt - TL) * D) : nullptr;
        const float* g = gate + (size_t)row_vec(rt) * 6144;
        const int col0 = u.pn * 256 + wc * 32 + 4 * fq, r0 = wr * 64 + fr;
        f32x4 gv[2][2];
#pragma unroll
        for (int bj = 0; bj < 2; ++bj)
#pragma unroll
            for (int n = 0; n < 2; ++n) gv[bj][n] = *(const f32x4*)(g + col0 + bj * 128 + n * 16) * scale;
        bf16* op = xb + (size_t)(rt + r0) * D + col0;
#pragma unroll
        for (int ai = 0; ai < 2; ++ai)
#pragma unroll
            for (int m = 0; m < 4; ++m) { const int off = (ai * 128 + m * 16) * D;
                f32x4 x[2][2];
                if (f32in) {
#pragma unroll
                    for (int bj = 0; bj < 2; ++bj)
#pragma unroll
                        for (int n = 0; n < 2; ++n) x[bj][n] = *(const f32x4*)(ib + (size_t)r0 * D + col0 + off + bj * 128 + n * 16);
                } else {
#pragma unroll
                    for (int bj = 0; bj < 2; ++bj)
#pragma unroll
                        for (int n = 0; n < 2; ++n) { const u32x2 w = *(const u32x2*)(op + off + bj * 128 + n * 16); x[bj][n] = (f32x4){bf2f(w.x & 0xffffu), __uint_as_float(w.x & 0xffff0000u), bf2f(w.y & 0xffffu), __uint_as_float(w.y & 0xffff0000u)}; }
                }
#pragma unroll
                for (int bj = 0; bj < 2; ++bj)
#pragma unroll
                    for (int n = 0; n < 2; ++n) { const f32x4 y = x[bj][n] + gv[bj][n] * acc[ai][bj][m][n]; *(u32x2*)(op + off + bj * 128 + n * 16) = (u32x2){cvtpk(y[0], y[1]), cvtpk(y[2], y[3])}; }
                asm volatile("" ::: "memory"); }
    }
};
struct EpiSwiglu : EpiZero {
    bf16* hid; int ld;
    __device__ __forceinline__ void operator()(const Acc& acc, const Unit& u, int wr, int wc, int fr, int fq, int, int) const {
        const int row0 = u.pm * 256 + wr * 64 + fr, col0 = u.pn * 128 + wc * 32 + fq * 8;
#pragma unroll
        for (int ai = 0; ai < 2; ++ai)
#pragma unroll
            for (int m = 0; m < 4; ++m) { float v[8];
#pragma unroll
                for (int bj = 0; bj < 2; ++bj)
#pragma unroll
                    for (int j = 0; j < 4; ++j) v[bj * 4 + j] = silu_f(acc[ai][bj][m][0][j]) * acc[ai][bj][m][1][j];
                *(u32x4*)(hid + (size_t)(row0 + ai * 128 + m * 16) * ld + col0) = pack8(v); }
    }
};
struct EpiSwiglu8 : EpiZero {
    unsigned char* hid; int ld;
    __device__ __forceinline__ void operator()(const Acc& acc, const Unit& u, int wr, int wc, int fr, int fq, int, int) const {
        const int row0 = u.pm * 256 + wr * 64 + fr, col0 = u.pn * 128 + wc * 32 + fq * 8;
        static_assert(F8_INV * F8_INV * F8_ACT == 0x1p-15f, "swiglu scale");
        constexpr float C1 = -F8_INV * 1.4426950408889634f, LIM = 448.f * 0x1p15f;
        float s15 = 0x1p15f; asm volatile("" : "+v"(s15));
#pragma unroll
        for (int ai = 0; ai < 2; ++ai)
#pragma unroll
            for (int m = 0; m < 4; ++m) { float v[8];
#pragma unroll
                for (int bj = 0; bj < 2; ++bj)
#pragma unroll
                    for (int j = 0; j < 4; ++j) { const float av = acc[ai][bj][m][0][j], bv = acc[ai][bj][m][1][j];
                        const float r = __builtin_amdgcn_rcpf(1.f + __builtin_amdgcn_exp2f(av * C1));
                        v[bj * 4 + j] = __builtin_amdgcn_fmed3f((av * bv) * r, -LIM, LIM); }
                int w0, w1;
                asm("v_cvt_scalef32_pk_fp8_f32 %0, %1, %2, %3" : "=v"(w0) : "v"(v[0]), "v"(v[1]), "v"(s15)); asm("s_nop 0\n\tv_cvt_scalef32_pk_fp8_f32 %0, %1, %2, %3 op_sel:[0,0,0,1]" : "+v"(w0) : "v"(v[2]), "v"(v[3]), "v"(s15));
                asm("v_cvt_scalef32_pk_fp8_f32 %0, %1, %2, %3" : "=v"(w1) : "v"(v[4]), "v"(v[5]), "v"(s15)); asm("s_nop 0\n\tv_cvt_scalef32_pk_fp8_f32 %0, %1, %2, %3 op_sel:[0,0,0,1]" : "+v"(w1) : "v"(v[6]), "v"(v[7]), "v"(s15));
                *(u32x2*)(hid + (size_t)(row0 + ai * 128 + m * 16) * ld + col0) = (u32x2){(unsigned)w0, (unsigned)w1}; }
    }
};
struct EpiMoeDown : EpiZero {
    bf16* xb; float* fin; const float* g2; const int* tok; const float* gv; float* part;
    __device__ __forceinline__ void operator()(const Acc& acc, const Unit& u, int wr, int wc, int fr, int fq, int, int) const {
        if (u.sub >= 0) { store_partial(acc, part, u.sub, wr, wc, fr, fq); return; }
        const int p0 = u.pm * 256 + wr * 64 + fr, col0 = u.pn * 256 + wc * 32 + 4 * fq;
        int tk[2][4]; float gt[2][4];
#pragma unroll
        for (int ai = 0; ai < 2; ++ai)
#pragma unroll
            for (int m = 0; m < 4; ++m) { const int pos = p0 + ai * 128 + m * 16; tk[ai][m] = tok[pos]; gt[ai][m] = gv[pos] * F8_INV; }
#pragma unroll
        for (int ai = 0; ai < 2; ++ai) {
            u32x2 xw[4][2][2];
#pragma unroll
            for (int m = 0; m < 4; ++m) { const bf16* xr = xb + (size_t)(tk[ai][m] >= 0 ? tk[ai][m] : 0) * D + col0;
#pragma unroll
                for (int bj = 0; bj < 2; ++bj)
#pragma unroll
                    for (int n = 0; n < 2; ++n) xw[m][bj][n] = *(const u32x2*)(xr + bj * 128 + n * 16); }
#pragma unroll
            for (int m = 0; m < 4; ++m) { const int t = tk[ai][m];
                if (t >= 0) { bf16* xr = xb + (size_t)t * D + col0; const float* gr = g2 + (size_t)row_vec(t) * 6144 + col0; const float gtv = gt[ai][m];
#pragma unroll
                    for (int bj = 0; bj < 2; ++bj)
#pragma unroll
                        for (int n = 0; n < 2; ++n) { const u32x2 w = xw[m][bj][n]; const f32x4 x = (f32x4){bf2f(w.x & 0xffffu), __uint_as_float(w.x & 0xffff0000u), bf2f(w.y & 0xffffu), __uint_as_float(w.y & 0xffff0000u)};
                            const f32x4 g = *(const f32x4*)(gr + bj * 128 + n * 16);
                            const f32x4 y = x + (g * gtv) * acc[ai][bj][m][n];
                            if (fin) *(f32x4*)(fin + (size_t)t * D + col0 + bj * 128 + n * 16) = y; else *(u32x2*)(xr + bj * 128 + n * 16) = (u32x2){cvtpk(y[0], y[1]), cvtpk(y[2], y[3])}; } }
            }
            asm volatile("" ::: "memory"); }
    }
};
template <int DIR> struct EpiScan {
    const bf16* U; const float* ba; const float* bx; const float* lam;
    float* agg;
    unsigned* flags;
    unsigned* err;
    bf16* hs; const bf16* gate;
    int apply_ctx;
    LAS unsigned char* scr;
    __device__ __forceinline__ void init(Acc& acc, const Unit& u, int, int wc, int, int fq) const {
        const int d = DIR, ch0 = ((u.pn >> 1) & 3) * 256 + (u.pn & 1) * 128 + wc * 32 + fq * 8;
        const LAS float* tab = (const LAS float*)(scr + 4096);
#pragma unroll
        for (int bj = 0; bj < 2; ++bj) { const f32x4 a = *(const LAS f32x4*)(tab + ch0 + bj * 4), x = *(const LAS f32x4*)(tab + 1024 + ch0 + bj * 4);
#pragma unroll
            for (int ai = 0; ai < 2; ++ai)
#pragma unroll
                for (int m = 0; m < 4; ++m) { acc[ai][bj][m][0] = a; acc[ai][bj][m][1] = x; } }
    }
    __device__ __forceinline__ void operator()(Acc& acc, const Unit& u, int wr, int wc, int fr, int fq, int lane, int wid) const {
        const int d = DIR, hh = u.pn & 7, chb = (hh >> 1) * 256 + (hh & 1) * 128, hl0 = wc * 32 + fq * 8, ch0 = chb + hl0;
        LAS float* carry = (LAS float*)scr; LAS f32x2* hagg = (LAS f32x2*)(scr + 1024);
        const int tid = wid * 64 + lane;
        float sp[8];
        { const LAS float* tab = (const LAS float*)(scr + 4096); const f32x4 s0v = *(const LAS f32x4*)(tab + 2048 + ch0), s1v = *(const LAS f32x4*)(tab + 2048 + ch0 + 4);
          sp[0] = s0v[0]; sp[1] = s0v[1]; sp[2] = s0v[2]; sp[3] = s0v[3]; sp[4] = s1v[0]; sp[5] = s1v[1]; sp[6] = s1v[2]; sp[7] = s1v[3]; }
        const int s0 = (wr * 16 + fr) * 8;
        const int rowb = u.pm * 256 + (d ? 255 - s0 : s0), rstep = d ? -1 : 1;
        float Ar[8], Br[8];
#pragma unroll
        for (int c = 0; c < 8; ++c) { Ar[c] = 1.f; Br[c] = 0.f; }
#pragma unroll
        for (int ai = 0; ai < 2; ++ai)
#pragma unroll
            for (int m = 0; m < 4; ++m) { const int trow = rowb + (ai * 4 + m) * rstep;
                float uf[8]; unpack8(*(const u32x4*)(U + (size_t)trow * D + ch0), uf);
#pragma unroll
                for (int bj = 0; bj < 2; ++bj)
#pragma unroll
                    for (int j = 0; j < 4; ++j) { const int c = bj * 4 + j;
                        const float r = sigm(acc[ai][bj][m][0][j]), ig = sigm(acc[ai][bj][m][1][j]);
                        const float a = ex2(sp[c] * r); const float bb = __builtin_amdgcn_sqrtf(fabsf(1.f - a * a)) * (ig * uf[c]);
                        acc[ai][bj][m][0][j] = a; acc[ai][bj][m][1][j] = bb;
                        Br[c] = a * Br[c] + bb; Ar[c] = Ar[c] * a; }
                asm volatile("" ::: "memory"); }
#define SCAN_STEP(DL) do { _Pragma("unroll") for (int c = 0; c < 8; ++c) { const float ap = row_shr<DL>(Ar[c], 1.f), bp = row_shr<DL>(Br[c], 0.f);     \
            Br[c] = Ar[c] * bp + Br[c]; Ar[c] = Ar[c] * ap; } } while (0)
        SCAN_STEP(1); SCAN_STEP(2); SCAN_STEP(4); SCAN_STEP(8);
#undef SCAN_STEP
        if (wr == 0 && fr == 15) {
#pragma unroll
            for (int c = 0; c < 8; ++c) hagg[hl0 + c] = (f32x2){Ar[c], Br[c]};
        }
        LDS_WAIT(); __builtin_amdgcn_s_barrier(); asm volatile("" ::: "memory");
        if (wr == 1 && fr == 15) {
#pragma unroll
            for (int c = 0; c < 8; ++c) { const f32x2 h0 = hagg[hl0 + c]; const float ta = h0.x * Ar[c], tb = Ar[c] * h0.y + Br[c];
                __hip_atomic_store((unsigned long long*)(agg + (((size_t)u.pm * 2 + d) * 1024 + ch0 + c) * 2), ((unsigned long long)__float_as_uint(tb) << 32) | __float_as_uint(ta), __ATOMIC_RELAXED, __HIP_MEMORY_SCOPE_AGENT); }
        }
        asm volatile("s_waitcnt vmcnt(0)" ::: "memory"); __builtin_amdgcn_s_barrier(); asm volatile("" ::: "memory");
        if (tid == 0) __hip_atomic_store(flags + (d * 264 + u.pm) * 8 + hh, 1u, __ATOMIC_RELAXED, __HIP_MEMORY_SCOPE_AGENT);
        if (tid < 128) {
            const int pm = u.pm; const int b = pm < 256 ? (pm >> 5) : pm - 256; const int q = u.t;
            const unsigned* fp = flags + (d * 264 + chain_tile(b, d, lane < q ? lane : 0)) * 8 + hh;
            bool done = lane >= q; unsigned spins = 0;
            while (!__all(done)) {
                if (!done) done = __hip_atomic_load(fp, __ATOMIC_RELAXED, __HIP_MEMORY_SCOPE_AGENT) != 0u;
                if (++spins > (1u << 20)) { if (lane == 0) __hip_atomic_store(err, 1u, __ATOMIC_RELAXED, __HIP_MEMORY_SCOPE_AGENT); break; }
                if ((spins & 255u) == 0u && __hip_atomic_load(err, __ATOMIC_RELAXED, __HIP_MEMORY_SCOPE_AGENT) != 0u) break;
                __builtin_amdgcn_s_sleep(1);
            }
            __builtin_amdgcn_fence(__ATOMIC_ACQUIRE, "agent");
            float h = 0.f;
            for (int p0 = 0; p0 < q; p0 += 4) {
                unsigned long long w[4];
#pragma unroll
                for (int k = 0; k < 4; ++k) { const int p = p0 + k < q ? p0 + k : 0;
                    w[k] = __hip_atomic_load((const unsigned long long*)(agg + (((size_t)chain_tile(b, d, p) * 2 + d) * 1024 + chb + tid) * 2), __ATOMIC_RELAXED, __HIP_MEMORY_SCOPE_AGENT); }
#pragma unroll
                for (int k = 0; k < 4; ++k) if (p0 + k < q) h = __uint_as_float((unsigned)w[k]) * h + __uint_as_float((unsigned)(w[k] >> 32));
            }
            carry[tid] = h;
        }
        LDS_WAIT(); __builtin_amdgcn_s_barrier(); asm volatile("" ::: "memory");
        if (u.pm < 256 || apply_ctx) {
            float h[8];
#pragma unroll
            for (int c = 0; c < 8; ++c) { const float ae = row_shr<1>(Ar[c], 1.f), be = row_shr<1>(Br[c], 0.f);
                float hin = carry[hl0 + c]; if (wr == 1) { const f32x2 h0 = hagg[hl0 + c]; hin = h0.x * hin + h0.y; }
                h[c] = ae * hin + be; }
#pragma unroll
            for (int ai = 0; ai < 2; ++ai) {
                u32x4 hw[4], gw4[4];
                if (d != 0) {
#pragma unroll
                    for (int m = 0; m < 4; ++m) { const size_t ro = (size_t)(rowb + (ai * 4 + m) * rstep) * D + ch0; hw[m] = *(const u32x4*)(hs + ro); gw4[m] = *(const u32x4*)(gate + ro); } }
#pragma unroll
                for (int m = 0; m < 4; ++m) { const int trow = rowb + (ai * 4 + m) * rstep;
#pragma unroll
                    for (int bj = 0; bj < 2; ++bj)
#pragma unroll
                        for (int j = 0; j < 4; ++j) { const int c = bj * 4 + j; h[c] = acc[ai][bj][m][0][j] * h[c] + acc[ai][bj][m][1][j]; }
                    bf16* hp = hs + (size_t)trow * D + ch0;
                    if (d == 0) { *(u32x4*)hp = pack8(h); }
                    else { float hf[8], gf[8], o[8]; unpack8(hw[m], hf); unpack8(gw4[m], gf);
#pragma unroll
                        for (int c = 0; c < 8; ++c) o[c] = (hf[c] + h[c]) * gf[c];
                        *(u32x4*)hp = pack8(o); } }
                asm volatile("" ::: "memory"); }
        }
    }
};

namespace att {
constexpr int KVBLK = 64, KSTR = 400;
constexpr int SHM_V = KVBLK * 128 * 2, SHM_K = KVBLK * KSTR;
constexpr int LDS_ATT = 2 * SHM_V + 2 * SHM_K + NWAVES * 64 * 4;
static_assert(LDS_ATT <= RING_BYTES, "attention LDS");
constexpr float SCALE = 0.07216878364870322f;
constexpr float THR = 8.f;
#define SBAR() __builtin_amdgcn_sched_barrier(0)
__device__ __forceinline__ int crow(int r, int hi) { return (r & 3) + 8 * (r >> 2) + 4 * hi; }
__device__ __forceinline__ void partialSM(f32x16& p0, f32x16& p1, float& m_reg, float& mn, float& alpha) {
  constexpr float C = SCALE * 1.4426950408889634f;
  float pmax = p0[0];
#pragma unroll
  for (int r = 1; r < 16; ++r) pmax = fmaxf(pmax, p0[r]);
#pragma unroll
  for (int r = 0; r < 16; ++r) pmax = fmaxf(pmax, p1[r]);
  { auto rr = __builtin_amdgcn_permlane32_swap(__float_as_uint(pmax), __float_as_uint(pmax), false, false);
    pmax = fmaxf(__uint_as_float(rr[0]), __uint_as_float(rr[1])); }
  if (__builtin_expect(__all(pmax - m_reg <= THR / SCALE), 1)) { mn = m_reg; alpha = 1.f; }
  else { mn = fmaxf(m_reg, pmax); alpha = __builtin_amdgcn_exp2f((m_reg - mn) * C); m_reg = mn; }
  float mnC = -mn * C;
#pragma unroll
  for (int r = 0; r < 16; ++r) p0[r] = fmaf(p0[r], C, mnC);
#pragma unroll
  for (int r = 0; r < 16; ++r) p1[r] = fmaf(p1[r], C, mnC);
#pragma unroll
  for (int r = 0; r < 16; ++r) p0[r] = __builtin_amdgcn_exp2f(p0[r]);
}
__device__ __forceinline__ void finishSM(f32x16& p0, f32x16& p1, float alpha, float& l_reg, bf16x8& pa0, bf16x8& pa1, bf16x8& pa2, bf16x8& pa3) {
#pragma unroll
  for (int r = 0; r < 16; ++r) p1[r] = __builtin_amdgcn_exp2f(p1[r]);
  float ps = 0;
#pragma unroll
  for (int r = 0; r < 16; ++r) ps += p0[r];
#pragma unroll
  for (int r = 0; r < 16; ++r) ps += p1[r];
  { auto rr = __builtin_amdgcn_permlane32_swap(__float_as_uint(ps), __float_as_uint(ps), false, false);
    ps = __uint_as_float(rr[0]) + __uint_as_float(rr[1]); }
  l_reg = l_reg * alpha + ps;
#define PK4(P, BASE, OUT) do { unsigned a0 = cvtpk(P[BASE + 0], P[BASE + 1]), a1 = cvtpk(P[BASE + 2], P[BASE + 3]);   \
    unsigned b0 = cvtpk(P[BASE + 4], P[BASE + 5]), b1 = cvtpk(P[BASE + 6], P[BASE + 7]);                              \
    auto r0 = __builtin_amdgcn_permlane32_swap(a0, b0, false, false); auto r1 = __builtin_amdgcn_permlane32_swap(a1, b1, false, false); \
    u32x4 w = {r0[0], r1[0], r0[1], r1[1]}; OUT = *reinterpret_cast<bf16x8*>(&w); } while (0)
  PK4(p0, 0, pa0); PK4(p0, 8, pa1); PK4(p1, 0, pa2); PK4(p1, 8, pa3);
#undef PK4
}
__device__ __forceinline__ void qkt(f32x16& p0, f32x16& p1, const char* Ks, const bf16x8* qr, int r32, int hi) {
  p0 = f32x16{}; p1 = f32x16{};
#pragma unroll
  for (int d0 = 0; d0 < 12; ++d0) { const int cb = (d0 * 16 + hi * 8) * 2;
    bf16x8 b0 = *reinterpret_cast<const bf16x8*>(Ks + r32 * KSTR + cb);
    bf16x8 b1 = *reinterpret_cast<const bf16x8*>(Ks + (32 + r32) * KSTR + cb);
    p0 = __builtin_amdgcn_mfma_f32_32x32x16_bf16(b0, qr[d0], p0, 0, 0, 0);
    p1 = __builtin_amdgcn_mfma_f32_32x32x16_bf16(b1, qr[d0], p1, 0, 0, 0); }
}
__device__ __forceinline__ int v_st(int k, int c) { const int kk = (k & ~0xC) | ((k & 4) << 1) | ((k & 8) >> 1); return ((kk >> 3) * 4 + (c >> 5)) * 512 + ((kk & 7) * 32 + (c & 31)) * 2; }
__device__ __forceinline__ int v_rd_base(int lane) { return ((lane & 3) << 3) | (((lane >> 2) & 3) << 6) | (((lane >> 4) & 1) << 5) | (((lane >> 5) & 1) << 8); }
constexpr int v_rd_off(int d0, int ks, int half) { return d0 * 512 + ks * 4096 + half * 2048; }
template <int OFF> __device__ __forceinline__ s16x4 tr_read(int vb) {
  s16x4 r; asm volatile("ds_read_b64_tr_b16 %0, %1 offset:%2" : "=&v"(r) : "v"(vb), "i"(OFF) : "memory"); return r;
}
template <int D0> __device__ __forceinline__ void pv_one(f32x16& od, int vb, bf16x8 pa0, bf16x8 pa1, bf16x8 pa2, bf16x8 pa3) {
  const s16x4 l0 = tr_read<v_rd_off(D0, 0, 0)>(vb), h0 = tr_read<v_rd_off(D0, 0, 1)>(vb), l1 = tr_read<v_rd_off(D0, 1, 0)>(vb), h1 = tr_read<v_rd_off(D0, 1, 1)>(vb);
  const s16x4 l2 = tr_read<v_rd_off(D0, 2, 0)>(vb), h2 = tr_read<v_rd_off(D0, 2, 1)>(vb), l3 = tr_read<v_rd_off(D0, 3, 0)>(vb), h3 = tr_read<v_rd_off(D0, 3, 1)>(vb);
  asm volatile("s_waitcnt lgkmcnt(0)" ::: "memory"); SBAR();
#define PK(L, H) (bf16x8){L[0], L[1], L[2], L[3], H[0], H[1], H[2], H[3]}
  od = __builtin_amdgcn_mfma_f32_32x32x16_bf16(pa0, PK(l0, h0), od, 0, 0, 0);
  od = __builtin_amdgcn_mfma_f32_32x32x16_bf16(pa1, PK(l1, h1), od, 0, 0, 0);
  od = __builtin_amdgcn_mfma_f32_32x32x16_bf16(pa2, PK(l2, h2), od, 0, 0, 0);
  od = __builtin_amdgcn_mfma_f32_32x32x16_bf16(pa3, PK(l3, h3), od, 0, 0, 0);
#undef PK
}
__device__ __forceinline__ void pv_d0(f32x16* o, int vb, bf16x8 pa0, bf16x8 pa1, bf16x8 pa2, bf16x8 pa3) {
  pv_one<0>(o[0], vb, pa0, pa1, pa2, pa3); pv_one<1>(o[1], vb, pa0, pa1, pa2, pa3); pv_one<2>(o[2], vb, pa0, pa1, pa2, pa3); pv_one<3>(o[3], vb, pa0, pa1, pa2, pa3);
}
__device__ __forceinline__ void attn_body(const bf16* __restrict__ Qb, const bf16* __restrict__ KA, const bf16* __restrict__ VA, const bf16* __restrict__ KB2, const bf16* __restrict__ VB2,
                                          int nA, int seq, bf16* __restrict__ Ob, char* lds, const float* __restrict__ gqn, const float* __restrict__ rope) {
  constexpr int LDQ = 1536, LDK = 1536, LDV = 1024, LDO = 1024;
  const int tid = opaque_tid(), wid = tid >> 6, lane = tid & 63, r32 = lane & 31, hi = lane >> 5;
  char* V_lds = lds; char* K_lds = lds + 2 * SHM_V;
  float* ws = (float*)(lds + 2 * SHM_V + 2 * SHM_K) + wid * 64; float* li_l = ws; float* al_l = ws + 32;
  float m_reg = -1e30f, l_reg = 0; f32x16 o[4] = {}; bf16x8 qr[12];
  const bf16* Qw = Qb + (long)(wid * 32 + r32) * LDQ + hi * 8;
#pragma unroll
  for (int d0 = 0; d0 < 12; ++d0) qr[d0] = *reinterpret_cast<const bf16x8*>(Qw + d0 * 16);
  {
      float ss = 0.f;
#pragma unroll
      for (int d0 = 0; d0 < 12; ++d0) { float f[8]; unpack8(*reinterpret_cast<u32x4*>(&qr[d0]), f);
#pragma unroll
          for (int e = 0; e < 8; ++e) ss += f[e] * f[e]; }
      { auto rr = __builtin_amdgcn_permlane32_swap(__float_as_uint(ss), __float_as_uint(ss), false, false); ss = __uint_as_float(rr[0]) + __uint_as_float(rr[1]); }
      const float rstd = rsqrtf(ss * (1.f / 192) + EPS);
#pragma unroll
      for (int d0 = 0; d0 < 8; ++d0) { float f[8]; unpack8(*reinterpret_cast<u32x4*>(&qr[d0]), f); const f32x4 g0 = *(const f32x4*)(gqn + d0 * 16 + hi * 8), g1 = *(const f32x4*)(gqn + d0 * 16 + hi * 8 + 4);
#pragma unroll
          for (int e = 0; e < 4; ++e) { f[e] = f[e] * rstd * g0[e]; f[4 + e] = f[4 + e] * rstd * g1[e]; }
          u32x4 w = pack8(f); qr[d0] = *reinterpret_cast<bf16x8*>(&w); }
#pragma unroll
      for (int d0 = 8; d0 < 10; ++d0) {
          float x1[8], x2[8]; unpack8(*reinterpret_cast<u32x4*>(&qr[d0]), x1); unpack8(*reinterpret_cast<u32x4*>(&qr[d0 + 2]), x2);
          const float* ga = gqn + d0 * 16 + hi * 8; const float* gb2 = gqn + (d0 + 2) * 16 + hi * 8;
#pragma unroll
          for (int e = 0; e < 8; ++e) { x1[e] = x1[e] * rstd * ga[e]; x2[e] = x2[e] * rstd * gb2[e]; }
          if (rope) { const float* rt = rope + (size_t)(wid * 32 + r32) * 64 + ((d0 - 8) * 16 + hi * 8) * 2;
#pragma unroll
              for (int e = 0; e < 8; ++e) { const f32x2 cs = *(const f32x2*)(rt + 2 * e); const float a = x1[e], b = x2[e]; x1[e] = a * cs.x - b * cs.y; x2[e] = b * cs.x + a * cs.y; } }
          u32x4 w1 = pack8(x1), w2 = pack8(x2); qr[d0] = *reinterpret_cast<bf16x8*>(&w1); qr[d0 + 2] = *reinterpret_cast<bf16x8*>(&w2); }
  }
  const int sr = tid >> 4, sc = (tid & 15) * 8, vst0 = v_st(sr, sc), vst1 = v_st(32 + sr, sc);
  const int kgo = (tid >> 3) * LDK + (tid & 7) * 8, klo = (tid >> 3) * KSTR + (tid & 7) * 16;
  const int vb0 = (int)(uintptr_t)V_lds + v_rd_base(lane);
  bf16x8 vs0, vs1, ks0, ks1, ks2;
#define SLOAD(k0) do { const bool inA = (k0) < nA; const bf16* Kp = inA ? KA + (long)(k0) * LDK : KB2 + (long)((k0) - nA) * LDK; const bf16* Vp = inA ? VA + (long)(k0) * LDV : VB2 + (long)((k0) - nA) * LDV; \
    vs0 = *reinterpret_cast<const bf16x8*>(Vp + (long)sr * LDV + sc); vs1 = *reinterpret_cast<const bf16x8*>(Vp + (long)(32 + sr) * LDV + sc); \
    ks0 = *reinterpret_cast<const bf16x8*>(Kp + kgo); ks1 = *reinterpret_cast<const bf16x8*>(Kp + kgo + 64); ks2 = *reinterpret_cast<const bf16x8*>(Kp + kgo + 128); } while (0)
#define SWRITE(b) do { *(bf16x8*)(V_lds + (b) * SHM_V + vst0) = vs0; *(bf16x8*)(V_lds + (b) * SHM_V + vst1) = vs1; \
    *(bf16x8*)(K_lds + (b) * SHM_K + klo) = ks0; *(bf16x8*)(K_lds + (b) * SHM_K + klo + 128) = ks1; *(bf16x8*)(K_lds + (b) * SHM_K + klo + 256) = ks2; } while (0)
#define SWAIT() asm volatile("s_waitcnt vmcnt(0)" ::: "memory")
#define RESC(a) do { if (__any((a) < 1.f)) { if (hi == 0) al_l[r32] = (a); asm volatile("s_waitcnt lgkmcnt(0)" ::: "memory"); \
    _Pragma("unroll") for (int d = 0; d < 4; ++d) _Pragma("unroll") for (int r = 0; r < 16; ++r) o[d][r] *= al_l[crow(r, hi)]; } } while (0)
  f32x16 pA0, pA1, pB0, pB1; float mnA, mnB, alA, alB; bf16x8 pa0, pa1, pa2, pa3; const int NT = seq / KVBLK;
  SLOAD(0); SWAIT(); SWRITE(0); __syncthreads();
  qkt(pA0, pA1, K_lds, qr, r32, hi); partialSM(pA0, pA1, m_reg, mnA, alA);
  SLOAD(KVBLK);
  SWAIT(); SWRITE(1); __syncthreads();
  for (int j = 1; j + 1 < NT; j += 2) {
    SBAR(); qkt(pB0, pB1, K_lds + SHM_K, qr, r32, hi);
    finishSM(pA0, pA1, alA, l_reg, pa0, pa1, pa2, pa3); SBAR();
    SLOAD((j + 1) * KVBLK); SBAR();
    pv_d0(o, vb0, pa0, pa1, pa2, pa3); partialSM(pB0, pB1, m_reg, mnB, alB);
    __syncthreads(); SWAIT(); SWRITE(0);
    RESC(alB); __syncthreads();
    SBAR(); qkt(pA0, pA1, K_lds, qr, r32, hi);
    finishSM(pB0, pB1, alB, l_reg, pa0, pa1, pa2, pa3); SBAR();
    SLOAD((j + 2) * KVBLK); SBAR();
    pv_d0(o, vb0 + SHM_V, pa0, pa1, pa2, pa3); partialSM(pA0, pA1, m_reg, mnA, alA);
    __syncthreads(); SWAIT(); SWRITE(1);
    RESC(alA); __syncthreads();
  }
  SBAR(); qkt(pB0, pB1, K_lds + SHM_K, qr, r32, hi);
  finishSM(pA0, pA1, alA, l_reg, pa0, pa1, pa2, pa3); SBAR();
  pv_d0(o, vb0, pa0, pa1, pa2, pa3); partialSM(pB0, pB1, m_reg, mnB, alB);
  __syncthreads(); RESC(alB);
  finishSM(pB0, pB1, alB, l_reg, pa0, pa1, pa2, pa3); SBAR();
  pv_d0(o, vb0 + SHM_V, pa0, pa1, pa2, pa3);
  if (hi == 0) li_l[r32] = l_reg; asm volatile("s_waitcnt lgkmcnt(0)" ::: "memory");
  float rli[16];
#pragma unroll
  for (int r = 0; r < 16; ++r) rli[r] = __builtin_amdgcn_rcpf(li_l[crow(r, hi)]);
  bf16* Ow = Ob + (long)(wid * 32) * LDO;
#pragma unroll
  for (int r = 0; r < 16; ++r) { const int orow = crow(r, hi);
#pragma unroll
    for (int d0 = 0; d0 < 4; ++d0) Ow[(long)orow * LDO + d0 * 32 + r32] = (bf16)(cvtpk(o[d0][r] * rli[r], 0.f) & 0xffffu); }
#undef SLOAD
#undef SWRITE
#undef SWAIT
#undef RESC
}
}


namespace att8 {
constexpr int KVBLK = 64, KP = 208, VP = 80;
constexpr int SHM_K = KVBLK * KP, SHM_V = 128 * VP;
constexpr int SHM_Q = 256 * KP;
constexpr int NBUF = 3;
constexpr int LDS_ATT = NBUF * SHM_V + NBUF * SHM_K + NWAVES * 64 * 4 + SHM_Q;
static_assert(LDS_ATT <= RING_BYTES, "fp8 attention LDS");
constexpr float SCALE = 0.07216878364870322f;
constexpr float THR = 3.f;
__device__ __forceinline__ int crow(int r, int hi) { return (r & 3) + 8 * (r >> 2) + 4 * hi; }
#define MFMA8(acc, a, b) asm volatile("s_nop 1\n\tv_mfma_f32_32x32x64_f8f6f4 %0, %1, %2, %0" : "+v"(acc) : "v"(a), "v"(b))
#define MFMA8Z(acc, a, b) asm volatile("s_nop 1\n\tv_mfma_f32_32x32x64_f8f6f4 %0, %1, %2, 0" : "=&v"(acc) : "v"(a), "v"(b))
#define MFMA8_DONE() asm volatile("s_nop 15\n\ts_nop 3" ::: "memory")
__device__ __forceinline__ i32x8 ld32(const LAS char* p) { i32x8 r; r.lo = *(const LAS i32x4*)p; r.hi = *(const LAS i32x4*)(p + 16); return r; }
__device__ __forceinline__ void qkt(f32x16& p0, f32x16& p1, const LAS char* Ks, const i32x8& q0, const i32x8& q1, const i32x8& q2, int r32, int hi) {
  const LAS char* k0 = Ks + r32 * KP + hi * 32; const LAS char* k1 = k0 + 32 * KP;
  { const i32x8 a0 = ld32(k0), a1 = ld32(k1); MFMA8Z(p0, a0, q0); MFMA8Z(p1, a1, q0); }
  { const i32x8 a0 = ld32(k0 + 64), a1 = ld32(k1 + 64); MFMA8(p0, a0, q1); MFMA8(p1, a1, q1); }
  { const i32x8 a0 = ld32(k0 + 128), a1 = ld32(k1 + 128); MFMA8(p0, a0, q2); MFMA8(p1, a1, q2); }
  MFMA8_DONE();
}
constexpr float THR2 = THR * 1.4426950408889634f;
__device__ __forceinline__ void partialSM(f32x16& p0, f32x16& p1, float& m_reg, float& s_reg, float& mn, float& alpha) {
  float pmax = p0[0];
#pragma unroll
  for (int r = 1; r < 16; ++r) pmax = fmaxf(pmax, p0[r]);
#pragma unroll
  for (int r = 0; r < 16; ++r) pmax = fmaxf(pmax, p1[r]);
  { auto rr = __builtin_amdgcn_permlane32_swap(__float_as_uint(pmax), __float_as_uint(pmax), false, false);
    pmax = fmaxf(__uint_as_float(rr[0]), __uint_as_float(rr[1])); }
  if (__builtin_expect(__all(pmax - m_reg <= THR2), 1)) { alpha = 1.f; }
  else { const float mnew = ceilf(fmaxf(m_reg, pmax)); alpha = __builtin_amdgcn_exp2f(m_reg - mnew); m_reg = mnew; s_reg = __builtin_amdgcn_exp2f(mnew - 4.f); }
  mn = s_reg;
#pragma unroll
  for (int r = 0; r < 16; ++r) p0[r] = __builtin_amdgcn_exp2f(p0[r]);
}
__device__ __forceinline__ void finishSM(f32x16& p0, f32x16& p1, float mn, float alpha, float& l_reg, i32x8& pf) {
#pragma unroll
  for (int r = 0; r < 16; ++r) p1[r] = __builtin_amdgcn_exp2f(p1[r]);
  const float sc = mn;
  int w[8];
#pragma unroll
  for (int i = 0; i < 4; ++i) {
      asm("v_cvt_scalef32_pk_fp8_f32 %0, %1, %2, %3" : "=v"(w[i]) : "v"(p0[4 * i]), "v"(p0[4 * i + 1]), "v"(sc));
      asm("v_cvt_scalef32_pk_fp8_f32 %0, %1, %2, %3" : "=v"(w[4 + i]) : "v"(p1[4 * i]), "v"(p1[4 * i + 1]), "v"(sc)); }
#pragma unroll
  for (int i = 0; i < 4; ++i) {
      asm("v_cvt_scalef32_pk_fp8_f32 %0, %1, %2, %3 op_sel:[0,0,0,1]" : "+v"(w[i]) : "v"(p0[4 * i + 2]), "v"(p0[4 * i + 3]), "v"(sc));
      asm("v_cvt_scalef32_pk_fp8_f32 %0, %1, %2, %3 op_sel:[0,0,0,1]" : "+v"(w[4 + i]) : "v"(p1[4 * i + 2]), "v"(p1[4 * i + 3]), "v"(sc)); }
#pragma unroll
  for (int i = 0; i < 8; ++i) pf[i] = w[i];
}
__device__ __forceinline__ void pv(f32x16* o, const LAS char* Vs, const i32x8 pf, const i32x8& ones, int r32, int hi) {
  const LAS char* v0 = Vs + r32 * VP + hi * 32;
#pragma unroll
  for (int d0 = 0; d0 < 4; ++d0) { const i32x8 vf = ld32(v0 + d0 * 32 * VP);
    MFMA8(o[d0], pf, vf); }
  MFMA8(o[4], pf, ones);
  MFMA8_DONE();
}
__device__ __forceinline__ void attn_body(const bf16* __restrict__ Qb, const unsigned char* __restrict__ K8a, const unsigned char* __restrict__ V8a, const unsigned char* __restrict__ K8b,
                                          const unsigned char* __restrict__ V8b, int nA, int seq, bf16* __restrict__ Ob, LAS char* lds, const float* __restrict__ gqn, const float* __restrict__ rope) {
  constexpr int LDQ = 1536, LDO = 1024;
  const int tid = opaque_tid(), wid = tid >> 6, lane = tid & 63, r32 = lane & 31, hi = lane >> 5;
  LAS char* V_lds = lds; LAS char* K_lds = lds + NBUF * SHM_V;
  LAS float* ws = (LAS float*)(lds + NBUF * SHM_V + NBUF * SHM_K) + wid * 64; LAS float* li_l = ws; LAS float* al_l = ws + 32;
  LAS char* qs = lds + NBUF * SHM_V + NBUF * SHM_K + NWAVES * 64 * 4 + (wid * 32 + r32) * KP + hi * 32;
  const bool k1ok = (tid & 7) < 4;
  const int kg0 = (tid >> 3) * 1536 + (tid & 7) * 16, kl0 = (tid >> 3) * KP + (tid & 7) * 16;
  const int vg = tid * 16, vl = (tid >> 2) * VP + (tid & 3) * 16;
  const int kg1 = kg0 + (k1ok ? 128 : 0);
  u32x4 eK0, eK1, eV, oK0, oK1, oV;
#define SLOAD(S, k0) do { const bool inA = (k0) < nA; const unsigned char* Kp = inA ? K8a + (long)(k0) * 1536 : K8b + (long)((k0) - nA) * 1536; const unsigned char* Vp = inA ? V8a + (long)((k0) >> 6) * 65536 : V8b + (long)(((k0) - nA) >> 6) * 65536; \
    unsigned ov_ = (unsigned)vg, o0_ = (unsigned)kg0, o1_ = (unsigned)kg1; asm volatile("" : "+v"(ov_), "+v"(o0_), "+v"(o1_));     \
    S##V = *reinterpret_cast<const u32x4*>(Vp + ov_); S##K0 = *reinterpret_cast<const u32x4*>(Kp + o0_); S##K1 = *reinterpret_cast<const u32x4*>(Kp + o1_); } while (0)
#define SWRITE(b, S) do { *(LAS u32x4*)(V_lds + (b) * SHM_V + vl) = S##V; *(LAS u32x4*)(K_lds + (b) * SHM_K + kl0) = S##K0; if (k1ok) *(LAS u32x4*)(K_lds + (b) * SHM_K + kl0 + 128) = S##K1; } while (0)
#define SWAIT() asm volatile("s_waitcnt vmcnt(3)" ::: "memory")
#define RESC(a) do { if (__any((a) < 1.f)) { if (hi == 0) al_l[r32] = (a); asm volatile("s_waitcnt lgkmcnt(0)" ::: "memory"); \
    _Pragma("unroll") for (int d = 0; d < 5; ++d) _Pragma("unroll") for (int r = 0; r < 16; ++r) o[d][r] *= al_l[crow(r, hi)]; } } while (0)
#define SBAR8() __builtin_amdgcn_sched_barrier(0)
  f32x16 pA0, pA1, pB0, pB1; float mnA, mnB, alA, alB; i32x8 pf; const int NT = seq / KVBLK;
  SLOAD(e, 0); SLOAD(o, KVBLK);
  float m_reg = -1e30f, l_reg = 0, s_reg = 1.f;
  i32x8 qf[3];
  {
      const bf16* Qw = Qb + (long)(wid * 32 + r32) * LDQ + hi * 8;
      u32x4 qw[12];
#pragma unroll
      for (int d0 = 0; d0 < 12; ++d0) qw[d0] = *reinterpret_cast<const u32x4*>(Qw + d0 * 16);
      float ss = 0.f;
#pragma unroll
      for (int d0 = 0; d0 < 12; ++d0) { float f[8]; unpack8(qw[d0], f);
#pragma unroll
          for (int e = 0; e < 8; ++e) ss += f[e] * f[e]; }
      { auto rr = __builtin_amdgcn_permlane32_swap(__float_as_uint(ss), __float_as_uint(ss), false, false); ss = __uint_as_float(rr[0]) + __uint_as_float(rr[1]); }
      const float rstd = rsqrtf(ss * (1.f / 192) + EPS) * ATT_QS;
#pragma unroll
      for (int d0 = 0; d0 < 8; ++d0) { float f[8]; unpack8(qw[d0], f); const f32x4 g0 = *(const f32x4*)(gqn + d0 * 16 + hi * 8), g1 = *(const f32x4*)(gqn + d0 * 16 + hi * 8 + 4);
          qf[d0 >> 2][2 * (d0 & 3)] = (int)pk4_fp8(f[0] * rstd * g0[0], f[1] * rstd * g0[1], f[2] * rstd * g0[2], f[3] * rstd * g0[3]);
          qf[d0 >> 2][2 * (d0 & 3) + 1] = (int)pk4_fp8(f[4] * rstd * g1[0], f[5] * rstd * g1[1], f[6] * rstd * g1[2], f[7] * rstd * g1[3]); }
#pragma unroll
      for (int d0 = 8; d0 < 10; ++d0) {
          float x1[8], x2[8]; unpack8(qw[d0], x1); unpack8(qw[d0 + 2], x2);
          const float* ga = gqn + d0 * 16 + hi * 8; const float* gb2 = gqn + (d0 + 2) * 16 + hi * 8;
#pragma unroll
          for (int e = 0; e < 8; ++e) { x1[e] = x1[e] * rstd * ga[e]; x2[e] = x2[e] * rstd * gb2[e]; }
          if (rope) { const float* rt = rope + (size_t)(wid * 32 + r32) * 64 + ((d0 - 8) * 16 + hi * 8) * 2;
#pragma unroll
              for (int e = 0; e < 8; ++e) { const f32x2 cs = *(const f32x2*)(rt + 2 * e); const float a = x1[e], b = x2[e]; x1[e] = a * cs.x - b * cs.y; x2[e] = b * cs.x + a * cs.y; } }
          qf[2][2 * (d0 & 3)] = (int)pk4_fp8(x1[0], x1[1], x1[2], x1[3]); qf[2][2 * (d0 & 3) + 1] = (int)pk4_fp8(x1[4], x1[5], x1[6], x1[7]);
          qf[2][2 * ((d0 + 2) & 3)] = (int)pk4_fp8(x2[0], x2[1], x2[2], x2[3]); qf[2][2 * ((d0 + 2) & 3) + 1] = (int)pk4_fp8(x2[4], x2[5], x2[6], x2[7]); }
  }
  asm volatile("" : "+v"(qf[0]), "+v"(qf[1]), "+v"(qf[2]));
  f32x16 o[5] = {};
  i32x8 ones;
#pragma unroll
  for (int i = 0; i < 8; ++i) { int v1 = 0x38383838; asm volatile("" : "+v"(v1)); ones[i] = v1; }
  asm volatile("s_waitcnt vmcnt(3)" ::: "memory"); SWRITE(0, e); __syncthreads();
  qkt(pA0, pA1, K_lds, qf[0], qf[1], qf[2], r32, hi); partialSM(pA0, pA1, m_reg, s_reg, mnA, alA);
  if (2 < NT) SLOAD(e, 2 * KVBLK);
  SWAIT(); SWRITE(1, o); __syncthreads();
  int rb = 1;
#define NXT(i) ((i) == 2 ? 0 : (i) + 1)
#define PRV(i) ((i) == 0 ? 2 : (i) - 1)
  for (int j = 1; j + 1 < NT; j += 2) {
    SBAR8(); qkt(pB0, pB1, K_lds + rb * SHM_K, qf[0], qf[1], qf[2], r32, hi);
    finishSM(pA0, pA1, mnA, alA, l_reg, pf); SBAR8();
    if (j + 2 < NT) SLOAD(o, (j + 2) * KVBLK); SBAR8();
    pv(o, V_lds + PRV(rb) * SHM_V, pf, ones, r32, hi); partialSM(pB0, pB1, m_reg, s_reg, mnB, alB);
    SWAIT(); SWRITE(NXT(rb), e);
    RESC(alB); __syncthreads(); rb = NXT(rb);
    SBAR8(); qkt(pA0, pA1, K_lds + rb * SHM_K, qf[0], qf[1], qf[2], r32, hi);
    finishSM(pB0, pB1, mnB, alB, l_reg, pf); SBAR8();
    if (j + 3 < NT) SLOAD(e, (j + 3) * KVBLK); SBAR8();
    pv(o, V_lds + PRV(rb) * SHM_V, pf, ones, r32, hi); partialSM(pA0, pA1, m_reg, s_reg, mnA, alA);
    SWAIT(); SWRITE(NXT(rb), o);
    RESC(alA); __syncthreads(); rb = NXT(rb);
  }
  SBAR8(); qkt(pB0, pB1, K_lds + rb * SHM_K, qf[0], qf[1], qf[2], r32, hi);
  finishSM(pA0, pA1, mnA, alA, l_reg, pf); SBAR8();
  pv(o, V_lds + PRV(rb) * SHM_V, pf, ones, r32, hi); partialSM(pB0, pB1, m_reg, s_reg, mnB, alB);
  RESC(alB);
  finishSM(pB0, pB1, mnB, alB, l_reg, pf); SBAR8();
  pv(o, V_lds + rb * SHM_V, pf, ones, r32, hi);
#undef NXT
#undef PRV
  float rli[16];
#pragma unroll
  for (int r = 0; r < 16; ++r) rli[r] = __builtin_amdgcn_rcpf(o[4][r]) * (1.f / ATT_VS);
  bf16* Ow = Ob + (long)(wid * 32) * LDO;
#pragma unroll
  for (int r = 0; r < 16; ++r) { const int orow = crow(r, hi);
#pragma unroll
    for (int d0 = 0; d0 < 4; ++d0) Ow[(long)orow * LDO + d0 * 32 + r32] = (bf16)(cvtpk(o[d0][r] * rli[r], 0.f) & 0xffffu); }
#undef SLOAD
#undef SWRITE
#undef SWAIT
#undef RESC
#undef SBAR8
}
}

template <class Map, bool F8 = false>
__device__ __forceinline__ void conv_item(const float* W, int Ksrc, int N, bf16* WT, int Kd, LAS float* scr, int item, int lane, const Map& map) {
    const int nblk = N / 32, kb = item / nblk, nb = item % nblk, k0 = 64 * kb, n0 = 32 * nb;
    const bool live = k0 < Ksrc;
#pragma unroll 8
    for (int i = 0; i < 32; ++i) { const int kk = 2 * i + (lane >> 5); scr[kk * 33 + (lane & 31)] = live ? W[(size_t)(k0 + kk) * N + n0 + (lane & 31)] : 0.f; }
    LDS_WAIT(); asm volatile("" ::: "memory");
    const int c = lane & 7;
#pragma unroll
    for (int j = 0; j < 4; ++j) { const int n = (lane >> 3) + 8 * j; const LAS float* s = scr + (8 * c) * 33 + n;
        if constexpr (F8) { *(u32x2*)((unsigned char*)WT + (size_t)map(n0 + n) * Kd + k0 + 8 * c) =
                (u32x2){pk4_fp8(s[0 * 33] * F8_WGT, s[1 * 33] * F8_WGT, s[2 * 33] * F8_WGT, s[3 * 33] * F8_WGT), pk4_fp8(s[4 * 33] * F8_WGT, s[5 * 33] * F8_WGT, s[6 * 33] * F8_WGT, s[7 * 33] * F8_WGT)}; }
        else { u32x4 o; o.x = cvtpk(s[0 * 33], s[1 * 33]); o.y = cvtpk(s[2 * 33], s[3 * 33]); o.z = cvtpk(s[4 * 33], s[5 * 33]); o.w = cvtpk(s[6 * 33], s[7 * 33]);
            *(u32x4*)(WT + (size_t)map(n0 + n) * Kd + k0 + 8 * c) = o; } }
    LDS_WAIT(); asm volatile("" ::: "memory");
}
struct MapNat { int off; __device__ __forceinline__ int operator()(int n) const { return off + n; } };
struct MapLog { int off; __device__ __forceinline__ int operator()(int n) const { return off + (n & ~255) + phys_of_logical(n & 255); } };
struct MapPair { int off, nsel; __device__ __forceinline__ int operator()(int n) const { return off + (n >> 7) * 256 + phys_of_pair(n & 127, nsel); } };
struct MapUkv { __device__ __forceinline__ int operator()(int n) const { const int h = n >> 8, w = n & 255; const int l = h * 128 + (w & 127); return (w < 128 ? 1536 : 2560) + (l & ~255) + phys_of_logical(l & 255); } };

template <bool F8 = false, class Map>
__device__ __forceinline__ void conv_job(Frame& F, int& cursor, const float* W, int Ksrc, int N, bf16* WT, int Kd, const Map& map) {
    LAS float* scr = (LAS float*)(F.lds + F.wave * 16384);
    const int gw = F.vcu * NWAVES + F.wave, NGW = F.G * NWAVES;
    const int nitems = (Kd / 64) * (N / 32);
    int first = (gw - cursor) % NGW; if (first < 0) first += NGW;
    for (int it = first; it < nitems; it += NGW) conv_item<Map, F8>(W, Ksrc, N, WT, Kd, scr, it, F.lane, map);
    cursor = (cursor + nitems) % NGW;
}
__device__ __forceinline__ void conv_moe_layer(Frame& F, int& cur, int j) {
    KArgs ap = ARGS(); const float* w1 = ap->in[31]; const float* w3 = ap->in[32]; const float* w2 = ap->in[33];
    unsigned char* wm = ap->ws + WS_WMOE;
    LAS float* scr = (LAS float*)(F.lds + F.wave * 16384);
    const int gw = F.vcu * NWAVES + F.wave, NGW = F.G * NWAVES, lane = F.lane;
    constexpr int PER_M = (1024 / 64) * (EH / 32), PER_E = 3 * PER_M, TOTAL = NE * PER_E;
    static_assert(PER_M == (EH / 64) * (1024 / 32), "MoE conversion items");
    f32x4 nx[8];
#define MOE_DECODE(t) const int e_ = (t) / PER_E, r_ = (t) - e_ * PER_E, m_ = r_ / PER_M, it_ = r_ - m_ * PER_M; \
        const int N_ = m_ < 2 ? EH : 1024, nblk_ = N_ / 32, kb_ = it_ / nblk_, nb_ = it_ - kb_ * nblk_, k0_ = 64 * kb_, n0_ = 32 * nb_; \
        const float* src_ = (m_ == 0 ? w1 : m_ == 1 ? w3 : w2) + ((size_t)j * NE + e_) * 1024 * EH
#define MOE_ISSUE(t) do { MOE_DECODE(t); const float* p_ = src_ + (size_t)(k0_ + (lane >> 3)) * N_ + n0_ + 4 * (lane & 7); \
        _Pragma("unroll") for (int i = 0; i < 8; ++i) nx[i] = __builtin_nontemporal_load((const f32x4*)(p_ + (size_t)(8 * i) * N_)); } while (0)
    int t = gw;
    if (t < TOTAL) MOE_ISSUE(t);
    for (; t < TOTAL; t += NGW) {
        f32x4 x[8];
#pragma unroll
        for (int i = 0; i < 8; ++i) x[i] = nx[i];
        if (t + NGW < TOTAL) MOE_ISSUE(t + NGW);
#pragma unroll
        for (int i = 0; i < 8; ++i) { LAS float* d = scr + (8 * i + (lane >> 3)) * 33 + 4 * (lane & 7); d[0] = x[i][0]; d[1] = x[i][1]; d[2] = x[i][2]; d[3] = x[i][3]; }
        LDS_WAIT(); asm volatile("" ::: "memory");
        { MOE_DECODE(t); const int c = lane & 7;
          unsigned char* dst = m_ < 2 ? wm + WM_13 + (size_t)e_ * 7168 * 1024 : wm + WM_2 + (size_t)e_ * 1024 * 3584; const int Kd = m_ < 2 ? 1024 : 3584;
#pragma unroll
          for (int q = 0; q < 4; ++q) { const int n = (lane >> 3) + 8 * q; const LAS float* sp = scr + (8 * c) * 33 + n; const int nn = n0_ + n;
              const int row = m_ < 2 ? (nn >> 7) * 256 + phys_of_pair(nn & 127, m_) : nn;
              *(u32x2*)(dst + (size_t)row * Kd + k0_ + 8 * c) =
                  (u32x2){pk4_fp8(sp[0 * 33] * F8_WGT, sp[1 * 33] * F8_WGT, sp[2 * 33] * F8_WGT, sp[3 * 33] * F8_WGT), pk4_fp8(sp[4 * 33] * F8_WGT, sp[5 * 33] * F8_WGT, sp[6 * 33] * F8_WGT, sp[7 * 33] * F8_WGT)}; } }
        LDS_WAIT(); asm volatile("" ::: "memory");
    }
#undef MOE_DECODE
#undef MOE_ISSUE
}
__device__ __forceinline__ void rope_sincos(int pos, int f, float& c, float& s) {
    const double inv = exp2(-(double)f * (13.287712379549449 / 16.0));
    const double a = (double)pos * inv;
    const double k = rint(a * 0.6366197723675814);
    const double x = fma(-k, 1.5707963267948966, a) - k * 6.123233995736766e-17;
    const double x2 = x * x;
    const double sn = x * (1.0 + x2 * (-1.0 / 6 + x2 * (1.0 / 120 + x2 * (-1.0 / 5040 + x2 * (1.0 / 362880 + x2 * (-1.0 / 39916800 + x2 * (1.0 / 6227020800.0)))))));
    const double cs = 1.0 + x2 * (-0.5 + x2 * (1.0 / 24 + x2 * (-1.0 / 720 + x2 * (1.0 / 40320 + x2 * (-1.0 / 3628800 + x2 * (1.0 / 479001600.0 + x2 * (-1.0 / 87178291200.0)))))));
    const int q = ((int)k) & 3;
    const double sv = (q == 0) ? sn : (q == 1) ? cs : (q == 2) ? -sn : -cs;
    const double cv = (q == 0) ? cs : (q == 1) ? -sn : (q == 2) ? -cs : sn;
    c = (float)cv; s = (float)sv;
}
__device__ __forceinline__ void prologue(Frame& F) {
    int cur = 0;
    __syncthreads();
    {
        LAS float* sl = (LAS float*)F.lds;
        LAS float* red = (LAS float*)(F.lds + 40960);
        KArgs a = ARGS();
        const float* c = a->in[1]; const float* cc = a->in[3]; const float* aw = a->in[4]; const float* ab = a->in[5];
        float* mod = (float*)(a->ws + WS_MOD);
        bool have = false;
        for (int uidx = F.bx; uidx < 4 * 48; uidx += F.G) {
            if (!have) { for (int i = F.tid; i < 9 * 1024; i += NTHR) { const float x = i < 8192 ? c[i] : cc[i - 8192]; sl[i] = x / (1.f + expf(-x)); } __syncthreads(); have = true; }
            const int li = uidx / 48, cb = (uidx % 48) * 128, cg = F.tid & 31, ks = F.tid >> 5;
            float accv[9][4];
#pragma unroll
            for (int v = 0; v < 9; ++v)
#pragma unroll
                for (int q = 0; q < 4; ++q) accv[v][q] = 0.f;
            const float* wp = aw + ((size_t)li * 1024 + ks * 64) * 6144 + cb + cg * 4;
#pragma unroll 4
            for (int k = 0; k < 64; ++k) { const f32x4 w = *(const f32x4*)(wp + (size_t)k * 6144);
#pragma unroll
                for (int v = 0; v < 9; ++v) { const float sv = sl[v * 1024 + ks * 64 + k]; accv[v][0] += sv * w[0]; accv[v][1] += sv * w[1]; accv[v][2] += sv * w[2]; accv[v][3] += sv * w[3]; } }
#pragma unroll
            for (int v = 0; v < 9; ++v) *(LAS f32x4*)(red + (ks * 9 + v) * 128 + cg * 4) = (f32x4){accv[v][0], accv[v][1], accv[v][2], accv[v][3]};
            __syncthreads();
            for (int o = F.tid; o < 9 * 128; o += NTHR) { const int v = o >> 7, n = o & 127; float s = ab[(size_t)li * 6144 + cb + n];
#pragma unroll
                for (int k2 = 0; k2 < 16; ++k2) s += red[(k2 * 9 + v) * 128 + n];
                mod[((size_t)li * 9 + v) * 6144 + cb + n] = s; }
            __syncthreads();
        }
        __syncthreads();
    }
    {
        KArgs a = ARGS(); float* rt = (float*)(a->ws + WS_ROPE);
        for (int i = F.bx * NTHR + F.tid; i < SEQ * 32; i += F.G * NTHR) { const int pos = i >> 5, jj = i & 31; float cs, sn; rope_sincos(jj < 16 ? (pos >> 6) : (pos & 63), jj & 15, cs, sn); rt[2 * i] = cs; rt[2 * i + 1] = sn; }
    }
    {
        KArgs a = ARGS(); float* spt = (float*)(a->ws + WS_SPT); const float* lam = a->in[25];
        for (int i = F.bx * NTHR + F.tid; i < 2 * 2 * 1024; i += F.G * NTHR) spt[i] = -8.0f * 1.4426950408889634f * log1pf(expf(-lam[i]));
    }
#pragma unroll 1
    for (int j = 0; j < 2; ++j) {
        KArgs ap = ARGS(); bf16* wsm = (bf16*)(ap->ws + WS_WSM);
        bf16* wm = wsm + W_MLA + j * W_MLA_SZ;
        conv_job(F, cur, ap->in[8] + (size_t)j * 1024 * 256, 1024, 256, wm + W_MLA_1, 1024, MapLog{0});
        conv_job(F, cur, ap->in[11] + (size_t)j * 1024 * 192, 1024, 192, wm + W_MLA_1, 1024, MapLog{256});
        conv_job(F, cur, ap->in[10] + (size_t)j * 256 * 1536, 256, 1536, wm + W_MLA_CAT, 256, MapLog{0});
        conv_job(F, cur, ap->in[13] + (size_t)j * 128 * 2048, 128, 2048, wm + W_MLA_CAT, 256, MapUkv{});
        conv_job(F, cur, ap->in[16] + (size_t)j * 1024 * 1024, 1024, 1024, wm + W_MLA_O, 1024, MapNat{0});
        bf16* wr = wsm + W_RG + j * W_RG_SZ;
        conv_job(F, cur, ap->in[17] + (size_t)j * 1024 * 1024, 1024, 1024, wr + W_RG_IG, 1024, MapLog{0});
        conv_job(F, cur, ap->in[18] + (size_t)j * 1024 * 1024, 1024, 1024, wr + W_RG_IG, 1024, MapLog{1024});
        for (int dh = 0; dh < 8; ++dh) {
            conv_job(F, cur, ap->in[21] + ((size_t)j * 8 + dh) * 65536, 256, 256, wr + W_RG_AX + (size_t)dh * 2 * 65536, 256, MapPair{0, 0});
            conv_job(F, cur, ap->in[23] + ((size_t)j * 8 + dh) * 65536, 256, 256, wr + W_RG_AX + (size_t)dh * 2 * 65536, 256, MapPair{0, 1});
        }
        conv_job(F, cur, ap->in[26] + (size_t)j * 1024 * 1024, 1024, 1024, wr + W_RG_OUT, 1024, MapNat{0});
        bf16* wf = wsm + W_FFN + j * W_FFN_SZ;
        if ((FFN_F8_MASK >> j) & 1) {
            conv_job<true>(F, cur, ap->in[27] + (size_t)j * 1024 * FF, 1024, FF, wf + W_FFN_13, 1024, MapPair{0, 0});
            conv_job<true>(F, cur, ap->in[28] + (size_t)j * 1024 * FF, 1024, FF, wf + W_FFN_13, 1024, MapPair{0, 1});
            conv_job<true>(F, cur, ap->in[29] + (size_t)j * FF * 1024, FF, 1024, wf + W_FFN_2, FF, MapNat{0});
        } else {
            conv_job(F, cur, ap->in[27] + (size_t)j * 1024 * FF, 1024, FF, wf + W_FFN_13, 1024, MapPair{0, 0});
            conv_job(F, cur, ap->in[28] + (size_t)j * 1024 * FF, 1024, FF, wf + W_FFN_13, 1024, MapPair{0, 1});
            conv_job(F, cur, ap->in[29] + (size_t)j * FF * 1024, FF, 1024, wf + W_FFN_2, FF, MapNat{0});
        }
        { const int gw = F.vcu * NWAVES + F.wave, NGW = F.G * NWAVES;
          for (int r = gw; r < 64; r += NGW) { const int row = 256 + phys_of_logical(192 + r); bf16* p = wm + W_MLA_1 + (size_t)row * 1024;
              for (int k = F.lane * 8; k < 1024; k += 512) *(u32x4*)(p + k) = (u32x4){0u, 0u, 0u, 0u}; } }
    }
    conv_moe_layer(F, cur, 0);
}

template <bool ROUTE, int R, bool F8OUT = ROUTE, bool XF32 = false>
__device__ __forceinline__ void norm_pass(Frame& F, const float* xL, const float* xC, const bf16* xb, int nrows, const float* g, const float* mod  , int chunk_sh, bf16* H,
                                          const float* wrt, unsigned* cnt, int* rE, int* rRank, float* rG) {
    const int lane = F.lane;
    const int rpb = (nrows + F.G - 1) / F.G;
    const int gw = F.vcu * NWAVES + F.wave, NGW = F.G * NWAVES;
    const int rpw = (nrows + NGW - 1) / NGW;
    const int rbeg = ROUTE ? F.vcu * rpb : 0, rfirst = ROUTE ? rbeg + F.wave : gw * rpw, rstride = ROUTE ? NWAVES : 1;
    const int rend = ROUTE ? (rbeg + rpb < nrows ? rbeg + rpb : nrows) : (rfirst + rpw < nrows ? rfirst + rpw : nrows);
    LAS int* sel = (LAS int*)F.lds;
    LAS float* wl = (LAS float*)(F.lds + 4096);
    if (ROUTE) {
        for (int x = F.tid; x < 2048; x += NTHR) { const int slot = x >> 6, L = x & 63, jj = slot >> 4, q = (slot >> 1) & 7, hf = slot & 1;
            *(LAS f32x4*)(wl + (size_t)x * 4) = *(const f32x4*)(wrt + (size_t)(8 * L + 512 * jj + q) * 8 + hf * 4); }
        LDS_WAIT(); __syncthreads();
    }
    float gg[2][8];
#pragma unroll
    for (int jj = 0; jj < 2; ++jj) { const f32x4 a = *(const f32x4*)(g + 8 * lane + 512 * jj), b = *(const f32x4*)(g + 8 * lane + 512 * jj + 4);
        gg[jj][0] = a[0]; gg[jj][1] = a[1]; gg[jj][2] = a[2]; gg[jj][3] = a[3]; gg[jj][4] = b[0]; gg[jj][5] = b[1]; gg[jj][6] = b[2]; gg[jj][7] = b[3]; }
    u32x4 nx[XF32 ? 1 : R][2]; f32x4 nf[XF32 ? R : 1][2][2]; int curvec = -1; float mA[2][8], mB[2][8];
#define NP_LOADX(base) do { _Pragma("unroll") for (int r = 0; r < R; ++r) { const int rr = (base) + r * rstride; const int rw = rr < rend ? rr : (base); \
        _Pragma("unroll") for (int jj = 0; jj < 2; ++jj) nx[r][jj] = __builtin_nontemporal_load((const u32x4*)(xb + (size_t)rw * D + 8 * lane + 512 * jj)); } } while (0)
#define NP_LOADF(base) do { _Pragma("unroll") for (int r = 0; r < R; ++r) { const int rr = (base) + r * rstride; const int rw = rr < rend ? rr : (base); \
        const float* xr = rw < TL ? xL + (size_t)rw * D : xC + (size_t)(rw - TL) * D; \
        _Pragma("unroll") for (int jj = 0; jj < 2; ++jj) { nf[XF32 ? r : 0][jj][0] = __builtin_nontemporal_load((const f32x4*)(xr + 8 * lane + 512 * jj)); nf[XF32 ? r : 0][jj][1] = __builtin_nontemporal_load((const f32x4*)(xr + 8 * lane + 512 * jj + 4)); } } } while (0)
    constexpr bool PF = !ROUTE;
    if (PF && rfirst < rend) { if constexpr (!XF32) NP_LOADX(rfirst); else NP_LOADF(rfirst); }
    for (int row0 = rfirst; row0 < rend; row0 += R * rstride) {
        float v[XF32 ? R : 1][2][8]; u32x4 cu[XF32 ? 1 : R][2]; float ss[R]; int rows[R];
#define NP_GETV(r, jj, f) do { if constexpr (XF32) { _Pragma("unroll") for (int e_ = 0; e_ < 8; ++e_) f[e_] = v[XF32 ? (r) : 0][jj][e_]; } else unpack8(cu[XF32 ? 0 : (r)][jj], f); } while (0)
        const int nrow0 = row0 + R * rstride;
#pragma unroll
        for (int r = 0; r < R; ++r) { const int rr = row0 + r * rstride; rows[r] = rr < rend ? rr : row0; }
        if constexpr (XF32) {
#pragma unroll
            for (int r = 0; r < R; ++r)
#pragma unroll
                for (int jj = 0; jj < 2; ++jj) { const f32x4 a = nf[r][jj][0], b = nf[r][jj][1];
                    v[r][jj][0] = a[0]; v[r][jj][1] = a[1]; v[r][jj][2] = a[2]; v[r][jj][3] = a[3]; v[r][jj][4] = b[0]; v[r][jj][5] = b[1]; v[r][jj][6] = b[2]; v[r][jj][7] = b[3]; }
            if (nrow0 < rend) NP_LOADF(nrow0);
        } else {
            if constexpr (!PF) NP_LOADX(row0);
#pragma unroll
            for (int r = 0; r < R; ++r)
#pragma unroll
                for (int jj = 0; jj < 2; ++jj) cu[r][jj] = nx[r][jj];
            if (PF && nrow0 < rend) NP_LOADX(nrow0);
        }
        const int vec0 = row_vec(row0);
        if (vec0 != curvec) { curvec = vec0; const float* mv0 = mod + (size_t)vec0 * 6144 + chunk_sh * 1024;
#pragma unroll
            for (int jj = 0; jj < 2; ++jj) { const int c = 8 * lane + 512 * jj;
                const f32x4 sh0 = *(const f32x4*)(mv0 + c), sh1 = *(const f32x4*)(mv0 + c + 4), sc0 = *(const f32x4*)(mv0 + 1024 + c), sc1 = *(const f32x4*)(mv0 + 1024 + c + 4);
#pragma unroll
                for (int e = 0; e < 8; ++e) { mA[jj][e] = gg[jj][e] * ((e < 4 ? sc0[e & 3] : sc1[e & 3]) + 1.f); mB[jj][e] = e < 4 ? sh0[e & 3] : sh1[e & 3]; } } }
#pragma unroll
        for (int r = 0; r < R; ++r) { float s = 0.f;
#pragma unroll
            for (int jj = 0; jj < 2; ++jj) { float f[8]; NP_GETV(r, jj, f);
#pragma unroll
                for (int e = 0; e < 8; ++e) s += f[e] * f[e]; }
            ss[r] = s; }
#pragma unroll
        for (int r = 0; r < R; ++r) ss[r] = wave_sum(ss[r]);
#pragma unroll
        for (int r = 0; r < R; ++r) { const int row = rows[r]; const bool live = (row0 + r * rstride) < rend;
            const float rstd = rsqrtf(ss[r] * (1.f / D) + EPS);
            const bool same = row_vec(row) == vec0;
            const float* mv = mod + (size_t)row_vec(row) * 6144 + chunk_sh * 1024;
            float lg[8];
            if (ROUTE) {
#pragma unroll
                for (int e = 0; e < 8; ++e) lg[e] = 0.f; }
#pragma unroll
            for (int jj = 0; jj < 2; ++jj) { const int c = 8 * lane + 512 * jj;
                float h[8], f[8]; NP_GETV(r, jj, f);
                if (same) {
#pragma unroll
                    for (int e = 0; e < 8; ++e) h[e] = (f[e] * rstd) * mA[jj][e] + mB[jj][e];
                } else {
                    const f32x4 sh0 = *(const f32x4*)(mv + c), sh1 = *(const f32x4*)(mv + c + 4), sc0 = *(const f32x4*)(mv + 1024 + c), sc1 = *(const f32x4*)(mv + 1024 + c + 4);
#pragma unroll
                    for (int e = 0; e < 8; ++e) h[e] = (f[e] * rstd) * gg[jj][e] * ((e < 4 ? sc0[e & 3] : sc1[e & 3]) + 1.f) + (e < 4 ? sh0[e & 3] : sh1[e & 3]);
                }
                if (ROUTE) {
#pragma unroll
                    for (int q = 0; q < 8; ++q) { const f32x4 w0 = *(const LAS f32x4*)(wl + (((jj * 8 + q) * 2 + 0) * 64 + lane) * 4), w1 = *(const LAS f32x4*)(wl + (((jj * 8 + q) * 2 + 1) * 64 + lane) * 4);
                        lg[0] += h[q] * w0[0]; lg[1] += h[q] * w0[1]; lg[2] += h[q] * w0[2]; lg[3] += h[q] * w0[3]; lg[4] += h[q] * w1[0]; lg[5] += h[q] * w1[1]; lg[6] += h[q] * w1[2]; lg[7] += h[q] * w1[3]; } }
                if (live) { if (F8OUT) *(u32x2*)((unsigned char*)H + (size_t)row * D + c) = (u32x2){pk4_fp8(h[0] * F8_ACT, h[1] * F8_ACT, h[2] * F8_ACT, h[3] * F8_ACT), pk4_fp8(h[4] * F8_ACT, h[5] * F8_ACT, h[6] * F8_ACT, h[7] * F8_ACT)};
                            else *(u32x4*)(H + (size_t)row * D + c) = pack8(h); } }
            if (ROUTE) {
#pragma unroll
                for (int e = 0; e < 8; ++e) lg[e] = wave_sum(lg[e]);
                int e1 = 0; float l1 = lg[0];
#pragma unroll
                for (int e = 1; e < 8; ++e) if (lg[e] > l1) { l1 = lg[e]; e1 = e; }
                int e2 = -1; float l2 = -3.0e38f;
#pragma unroll
                for (int e = 0; e < 8; ++e) if (e != e1 && lg[e] > l2) { l2 = lg[e]; e2 = e; }
                const float ga = __builtin_amdgcn_rcpf(1.f + __builtin_amdgcn_exp2f((l2 - l1) * 1.4426950408889634f)), gb = 1.f - ga;
                const int ea = e1 < e2 ? e1 : e2, eb = e1 < e2 ? e2 : e1; const float g0 = e1 < e2 ? ga : gb, g1 = e1 < e2 ? gb : ga;
                if (lane == 0 && live) { sel[row - rbeg] = ea | (eb << 4); rE[2 * row] = ea; rE[2 * row + 1] = eb; rG[2 * row] = g0; rG[2 * row + 1] = g1; }
            }
        }
    }
#undef NP_LOADX
#undef NP_LOADF
#undef NP_GETV
#undef NP_LOADM
    if (ROUTE) {
        LDS_WAIT(); __syncthreads();
        if (F.tid < 16) {
            const int sh = (F.tid >> 3) * 4, e = F.tid & 7; const int n = rend - rbeg;
            int c = 0;
            for (int i = 0; i < n; ++i) if (((sel[i] >> sh) & 15) == e) { rRank[2 * (rbeg + i) + (F.tid >> 3)] = c; ++c; }
            ((int*)cnt)[F.vcu * 16 + F.tid] = c;
        }
        __syncthreads();
    }
}
__device__ __forceinline__ void moe_lists(Frame& F, int nrows, unsigned* cnt, const int* blkcnt, const int* rE, const int* rRank, const float* rG, int* tok, float* gvv) {
    const int gt = F.bx * NTHR + F.tid, NGT = F.G * NTHR;
    const int rpb = (nrows + F.G - 1) / F.G;
    LAS int* pre = (LAS int*)F.lds;
    LAS int* tot = pre + 256 * 16;
    LAS int* tb = tot + 16;
    for (int i = F.tid; i < F.G * 16; i += NTHR) pre[i] = blkcnt[i];
    LDS_WAIT(); __syncthreads();
    if (F.tid < 16) { int run = 0; for (int b = 0; b < F.G; ++b) { const int v = pre[b * 16 + F.tid]; pre[b * 16 + F.tid] = run; run += v; } tot[F.tid] = run;
        if (F.bx == 0) cnt[64 * F.tid] = (unsigned)run; }
    LDS_WAIT(); __syncthreads();
    if (F.tid == 0) {
#pragma unroll 1
        for (int s = 0; s < 2; ++s) { int a = 0;
#pragma unroll 1
            for (int e = 0; e < NE; ++e) { tb[s * 8 + e] = a * 256; a += (tot[s * 8 + e] + 255) >> 8; } }
    }
    LDS_WAIT(); __syncthreads();
    for (int i = gt; i < nrows * 2; i += NGT) { const int s = i & 1, row = i >> 1, se = s * 8 + rE[i]; const int pos = tb[se] + pre[(row / rpb) * 16 + se] + rRank[i];
        tok[s * MOE_ROWS + pos] = row; gvv[s * MOE_ROWS + pos] = rG[i]; }
#pragma unroll 1
    for (int se = 0; se < 16; ++se) { const int c = tot[se], base = tb[se], end = (c + 255) & ~255, so = (se >> 3) * MOE_ROWS;
        for (int p = c + gt; p < end; p += NGT) { tok[so + base + p] = -1; gvv[so + base + p] = 0.f; } }
    __syncthreads();
}
__device__ __forceinline__ void qkva_norm_pass(Frame& F, int nrows, bf16* QKVA, const float* gq, const float* gkv) {
    constexpr int R = 4;
    const int gw = F.vcu * NWAVES + F.wave, NGW = F.G * NWAVES, lane = F.lane;
    float gl[8];
    { const float* gp = lane < 32 ? gq + lane * 8 : gkv + ((lane < 48 ? lane : 32) - 32) * 8;
#pragma unroll
      for (int i = 0; i < 8; ++i) gl[i] = gp[i]; }
    for (int row0 = gw; row0 < nrows; row0 += R * NGW) {
        u32x4 w[R]; float sq[R], sc[R];
#pragma unroll
        for (int r = 0; r < R; ++r) { const int rr = row0 + r * NGW; w[r] = *(const u32x4*)(QKVA + (size_t)(rr < nrows ? rr : row0) * 512 + lane * 8); }
#pragma unroll
        for (int r = 0; r < R; ++r) { float f[8]; unpack8(w[r], f); float s = 0.f;
#pragma unroll
            for (int i = 0; i < 8; ++i) s += f[i] * f[i];
            sq[r] = lane < 32 ? s : 0.f; sc[r] = (lane >= 32 && lane < 48) ? s : 0.f; }
#pragma unroll
        for (int o = 1; o < 64; o <<= 1) {
#pragma unroll
            for (int r = 0; r < R; ++r) { sq[r] += __shfl_xor(sq[r], o); sc[r] += __shfl_xor(sc[r], o); } }
#pragma unroll
        for (int r = 0; r < R; ++r) { const int rr = row0 + r * NGW;
            if (lane < 48 && rr < nrows) { float f[8]; unpack8(w[r], f); const float rstd = lane < 32 ? rsqrtf(sq[r] * (1.f / 256) + EPS) : rsqrtf(sc[r] * (1.f / 128) + EPS);
#pragma unroll
                for (int i = 0; i < 8; ++i) f[i] = f[i] * rstd * gl[i];
                *(u32x4*)(QKVA + (size_t)rr * 512 + lane * 8) = pack8(f); } }
    }
}
__device__ __forceinline__ void k_final_pass(Frame& F, int nrows, bf16* Kb, const bf16* QKVA, const float* gkn, const float* rope) {
    constexpr int R = 4;
    const int gw = F.vcu * NWAVES + F.wave, NGW = F.G * NWAVES, lane = F.lane, h = lane >> 3, l = lane & 7;
    float gn[16], gr[8];
#pragma unroll
    for (int i = 0; i < 16; ++i) gn[i] = gkn[l * 16 + i];
#pragma unroll
    for (int i = 0; i < 8; ++i) gr[i] = gkn[128 + l * 8 + i];
    for (int row0 = gw; row0 < nrows; row0 += R * NGW) {
        u32x4 wa[R], wb[R], wr[R]; float ss[R];
#pragma unroll
        for (int r = 0; r < R; ++r) { const int rr = row0 + r * NGW; const int row = rr < nrows ? rr : row0; const bf16* kp = Kb + (size_t)row * 1536 + h * 192;
            wa[r] = *(const u32x4*)(kp + l * 16); wb[r] = *(const u32x4*)(kp + l * 16 + 8); wr[r] = *(const u32x4*)(QKVA + (size_t)row * 512 + 384 + l * 8); }
#pragma unroll
        for (int r = 0; r < R; ++r) { float a[8], b[8], q[8]; unpack8(wa[r], a); unpack8(wb[r], b); unpack8(wr[r], q); float s = 0.f;
#pragma unroll
            for (int i = 0; i < 8; ++i) s += a[i] * a[i] + b[i] * b[i] + q[i] * q[i];
            ss[r] = s; }
#pragma unroll
        for (int o = 1; o < 8; o <<= 1) {
#pragma unroll
            for (int r = 0; r < R; ++r) ss[r] += __shfl_xor(ss[r], o); }
#pragma unroll
        for (int r = 0; r < R; ++r) { const int rr = row0 + r * NGW; const int row = rr < nrows ? rr : row0;
            float a[8], b[8], q[8]; unpack8(wa[r], a); unpack8(wb[r], b); unpack8(wr[r], q);
            const float rstd = rsqrtf(ss[r] * (1.f / 192) + EPS);
#pragma unroll
            for (int i = 0; i < 8; ++i) { a[i] = a[i] * rstd * gn[i]; b[i] = b[i] * rstd * gn[8 + i]; q[i] = q[i] * rstd * gr[i]; }
            if (row < TL) { const int pos = row & (SEQ - 1); const float* rt = rope + ((size_t)pos * 32 + (l & 3) * 8) * 2;
#pragma unroll
                for (int i = 0; i < 8; ++i) { const float other = __shfl_xor(q[i], 4); const f32x2 cs = *(const f32x2*)(rt + 2 * i);
                    q[i] = l < 4 ? q[i] * cs.x - other * cs.y : q[i] * cs.x + other * cs.y; } }
            if (rr < nrows) { bf16* kp = Kb + (size_t)row * 1536 + h * 192; *(u32x4*)(kp + l * 16) = pack8(a); *(u32x4*)(kp + l * 16 + 8) = pack8(b); *(u32x4*)(kp + 128 + l * 8) = pack8(q); } }
    }
}
__device__ __forceinline__ void conv_pass(Frame& F, int nrows, const bf16* UP, bf16* U, const float* cw, const float* cb) {
    constexpr int R = 2;
    const int gw = F.vcu * NWAVES + F.wave, NGW = F.G * NWAVES, lane = F.lane;
#pragma unroll 1
    for (int half = 0; half < 2; ++half) { const int c = lane * 8 + half * 512;
        float cwv[4][8], cbv[8];
#pragma unroll
        for (int k = 0; k < 4; ++k) { const f32x4 a = *(const f32x4*)(cw + k * 1024 + c), b2 = *(const f32x4*)(cw + k * 1024 + c + 4);
            cwv[k][0] = a[0]; cwv[k][1] = a[1]; cwv[k][2] = a[2]; cwv[k][3] = a[3]; cwv[k][4] = b2[0]; cwv[k][5] = b2[1]; cwv[k][6] = b2[2]; cwv[k][7] = b2[3]; }
        { const f32x4 a = *(const f32x4*)(cb + c), b2 = *(const f32x4*)(cb + c + 4); cbv[0] = a[0]; cbv[1] = a[1]; cbv[2] = a[2]; cbv[3] = a[3]; cbv[4] = b2[0]; cbv[5] = b2[1]; cbv[6] = b2[2]; cbv[7] = b2[3]; }
        u32x4 nw[R][4];
#define CV_LOAD(base) do { _Pragma("unroll") for (int r = 0; r < R; ++r) { const int rr = (base) + r * NGW; const int row = rr < nrows ? rr : (base); \
            const int len = row < TL ? SEQ : CTXL; const int n = row < TL ? (row & (SEQ - 1)) : ((row - TL) & (CTXL - 1)); \
            _Pragma("unroll") for (int k = 0; k < 4; ++k) { const int nn = n + k - 2; nw[r][k] = (nn >= 0 && nn < len) ? *(const u32x4*)(UP + (size_t)(row + k - 2) * D + c) : (u32x4){0u, 0u, 0u, 0u}; } } } while (0)
        if (gw < nrows) CV_LOAD(gw);
        for (int row0 = gw; row0 < nrows; row0 += R * NGW) {
            u32x4 w[R][4];
#pragma unroll
            for (int r = 0; r < R; ++r)
#pragma unroll
                for (int k = 0; k < 4; ++k) w[r][k] = nw[r][k];
            if (row0 + R * NGW < nrows) CV_LOAD(row0 + R * NGW);
#pragma unroll
            for (int r = 0; r < R; ++r) { const int rr = row0 + r * NGW;
                float o[8];
#pragma unroll
                for (int i = 0; i < 8; ++i) o[i] = cbv[i];
#pragma unroll
                for (int k = 0; k < 4; ++k) { float f[8]; unpack8(w[r][k], f);
#pragma unroll
                    for (int i = 0; i < 8; ++i) o[i] += f[i] * cwv[k][i]; }
                if (rr < nrows) *(u32x4*)(U + (size_t)rr * D + c) = pack8(o); }
        }
#undef CV_LOAD
    }
}

__device__ __forceinline__ f32x4 ld_bf16x4(const bf16* p) { const u32x2 w = *(const u32x2*)p; return (f32x4){bf2f(w.x & 0xffffu), __uint_as_float(w.x & 0xffff0000u), bf2f(w.y & 0xffffu), __uint_as_float(w.y & 0xffff0000u)}; }
__device__ __forceinline__ void reduce_resid(Frame& F, const Split sp, int nM, int nN, const float* part, const float* inL, const float* inC, bf16* xb, const float* gate, float scale) {
    const int gt = F.bx * NTHR + F.tid, NGT = F.G * NTHR;
    for (int idx = gt; idx < sp.Lf * 16384; idx += NGT) { const int l = idx >> 14, e = idx & 16383, r = e >> 6, c4 = (e & 63) * 4;
        int pm, pn; pg8::tile_of(sp.F + l, nM, nN, pm, pn);
        const float* pp = part + (size_t)(l * sp.S) * 65536 + r * 256 + c4; f32x4 a = *(const f32x4*)pp;
        for (int k = 1; k < sp.S; ++k) a += *(const f32x4*)(pp + (size_t)k * 65536);
        const int row = pm * 256 + r, col = pn * 256 + c4; const bool lat = row < TL;
        const f32x4 x = inL ? *(const f32x4*)((lat ? inL + (size_t)row * D : inC + (size_t)(row - TL) * D) + col) : ld_bf16x4(xb + (size_t)row * D + col);
        const f32x4 g = *(const f32x4*)(gate + (size_t)row_vec(row) * 6144 + col);
        const f32x4 y = x + (g * scale) * a;
        *(u32x2*)(xb + (size_t)row * D + col) = (u32x2){cvtpk(y[0], y[1]), cvtpk(y[2], y[3])}; }
}
__device__ __forceinline__ void reduce_moe(Frame& F, const Split sp, int nM, const float* part, bf16* xb, float* fin, const float* g2, const int* tok, const float* gv) {
    const int gt = F.bx * NTHR + F.tid, NGT = F.G * NTHR;
    for (int idx = gt; idx < sp.Lf * 16384; idx += NGT) { const int l = idx >> 14, e = idx & 16383, r = e >> 6, c4 = (e & 63) * 4;
        int pm, pn; pg8::tile_of(sp.F + l, nM, 4, pm, pn);
        const int pos = pm * 256 + r; const int tk = tok[pos]; if (tk < 0) continue;
        const float* pp = part + (size_t)(l * sp.S) * 65536 + r * 256 + c4; f32x4 a = *(const f32x4*)pp;
        for (int k = 1; k < sp.S; ++k) a += *(const f32x4*)(pp + (size_t)k * 65536);
        const int col = pn * 256 + c4; bf16* xr = xb + (size_t)tk * D + col;
        const f32x4 g = *(const f32x4*)(g2 + (size_t)row_vec(tk) * 6144 + col);
        const f32x4 y = ld_bf16x4(xr) + (g * (gv[pos] * F8_INV)) * a;
        if (fin) *(f32x4*)(fin + (size_t)tk * D + col) = y; else *(u32x2*)xr = (u32x2){cvtpk(y[0], y[1]), cvtpk(y[2], y[3])}; }
}
#ifdef PROBE
constexpr int CW_PROBE = 20480;
__device__ __forceinline__ void probe_buf(int id, const void* p, size_t nelem, bool f32v, unsigned* word) {
    int bxx = blockIdx.x; asm volatile("" : "+s"(bxx));
    const unsigned gt = (unsigned)bxx * NTHR + (unsigned)opaque_tid(), NGT = gridDim.x * NTHR;
    const unsigned nw = (unsigned)(f32v ? nelem : nelem / 2);
    const unsigned* q = (const unsigned*)p;
    bool bad = false;
    if (f32v) { for (unsigned i = gt; i < nw; i += NGT) bad |= ((q[i] & 0x7f800000u) == 0x7f800000u); }
    else { for (unsigned i = gt; i < nw; i += NGT) { const unsigned w = q[i]; bad |= ((w & 0x7f80u) == 0x7f80u) | ((w & 0x7f800000u) == 0x7f800000u); } }
    if (bad) atomicMax(word, (unsigned)(1000 - id));
}
#define PROBE_CHECK(id, ptr, nelem, f32v) do { KArgs ap = ARGS(); probe_buf(id, ptr, nelem, f32v, (unsigned*)WSP(WS_CTL) + CW_PROBE); } while (0)
#else
#define PROBE_CHECK(id, ptr, nelem, f32v) do { } while (0)
#endif
#ifndef PH_MASK
#define PH_MASK 0xffffffffu
#endif
#define PH(k) ((((unsigned)(PH_MASK)) >> (k)) & 1u)
#ifndef REP_MASK
#define REP_MASK 0u
#endif
#define REPS(k) (((((unsigned)(REP_MASK)) >> (k)) & 1u) ? 2 : 1)
__global__ void __launch_bounds__(NTHR, 2) fwd_kernel(Args args) {
    extern __shared__ __attribute__((aligned(16))) unsigned char lds_raw[];
#define MKFRAME() Frame F; F.lds = (LAS unsigned char*)lds_raw; F.tid = opaque_tid(); F.lane = F.tid & 63; F.wave = __builtin_amdgcn_readfirstlane(F.tid >> 6); \
    F.G = gridDim.x; F.bx = blockIdx.x; asm volatile("" : "+s"(F.G), "+s"(F.bx)); F.vcu = (F.bx & 7) * (F.G >> 3) + (F.bx >> 3)
    volatile LAS unsigned* MISC = (volatile LAS unsigned*)((LAS unsigned char*)lds_raw + MISC_OFF);
    if (threadIdx.x < 64) MISC[threadIdx.x] = 0u;
    __syncthreads();
    (void)xcd_barrier_post((unsigned*)(args.ws + WS_CTL) + CW_BAR, MISC + 8);
#define GRID_BAR() do { KArgs _ap = ARGS(); XcdBarrier _b; _b.bar = (unsigned*)(_ap->ws + WS_CTL) + CW_BAR; _b.x = xb_xcc_id(); _b.st = (volatile LAS unsigned*)((LAS unsigned char*)lds_raw + MISC_OFF) + 8; xcd_barrier(_b); } while (0)
#ifdef TSEL
#define PHASE_END(k) do { GRID_BAR(); if (blockIdx.x == 0 && threadIdx.x == 0) { const unsigned now = (unsigned)wall_clock64(); if ((((unsigned)(TSEL)) >> (k)) & 1u) MISC[16] += (now - MISC[17]) * (unsigned)(TMUL); MISC[17] = now; } } while (0)
#else
#define PHASE_END(k) GRID_BAR()
#endif
#define RING ((LAS unsigned char*)lds_raw)
#define EPISCR ((LAS unsigned char*)lds_raw + EPI_OFF)
#define WSP(off) (ap->ws + (off))
#define MODP(li) ((const float*)WSP(WS_MOD) + (size_t)(li) * 9 * 6144)
#define XBP ((bf16*)WSP(WS_XB))
#define HP ((bf16*)WSP(WS_H))
#define ARP(off) ((bf16*)(WSP(WS_ARENA) + (off)))
#define WSMP ((bf16*)WSP(WS_WSM))

#ifdef TSEL
    GRID_BAR(); if (blockIdx.x == 0 && threadIdx.x == 0) { MISC[16] = 0u; MISC[17] = (unsigned)wall_clock64(); }
#endif
    if constexpr (PH(0)) _Pragma("unroll 1") for (int rep_ = 0; rep_ < REPS(0); ++rep_) { MKFRAME(); prologue(F); }
    PHASE_END(0);
            PROBE_CHECK(1, WSP(WS_MOD), (size_t)4 * 9 * 6144, true); PROBE_CHECK(2, WSP(WS_ROPE), (size_t)SEQ * 64, true); PROBE_CHECK(3, WSP(WS_WSM), (W_FFN + 2 * W_FFN_SZ), false); PROBE_CHECK(4, WSP(WS_WMOE), WM_SZ, false);

#pragma unroll 1
    for (int j = 0; j < 2; ++j) {
        {
            const int li = 2 * j;
            if constexpr (PH(1)) _Pragma("unroll 1") for (int rep_ = 0; rep_ < REPS(1); ++rep_) { KArgs ap = ARGS(); MKFRAME();
                if (j == 0) norm_pass<false, 3, false, true>(F, ap->in[0], ap->in[2], XBP, T, ap->in[6] + li * 1024, MODP(li), 0, HP, nullptr, nullptr, nullptr, nullptr, nullptr);
                else norm_pass<false, 3>(F, nullptr, nullptr, XBP, T, ap->in[6] + li * 1024, MODP(li), 0, HP, nullptr, nullptr, nullptr, nullptr, nullptr);
                if (j == 1) { int cur = 0; conv_moe_layer(F, cur, 1); } }
            PHASE_END(1);
            PROBE_CHECK(10 + 20 * j, HP, (size_t)T * 1024, false);
            if constexpr (PH(2)) _Pragma("unroll 1") for (int rep_ = 0; rep_ < REPS(2); ++rep_) { KArgs ap = ARGS(); MKFRAME();
              SchedPlain S{(const char*)HP, (const char*)(WSMP + W_MLA + j * W_MLA_SZ + W_MLA_1), 2048, 2048, T / 256, 2, F.G, F.bx, 1 << 30, 16, make_split(T / 256 * 2, F.G, 8, false)};
              EpiStore1 E{{}, ARP(AR_QKVA), ap->in[9] + j * 256, ap->in[12] + j * 128, EPISCR};
              pg8::gemm_phase(RING, 1024, 1024, S, E); }
            PHASE_END(2);
            PROBE_CHECK(11 + 20 * j, ARP(AR_QKVA), (size_t)T * 512, false);
            if constexpr (PH(4)) _Pragma("unroll 1") for (int rep_ = 0; rep_ < REPS(4); ++rep_) { KArgs ap = ARGS(); MKFRAME();
              SchedA3 S{(const char*)ARP(AR_QKVA), (const char*)(WSMP + W_MLA + j * W_MLA_SZ + W_MLA_CAT), T / 256, F.G, F.bx};
              EpiStoreQKV E{{}, ARP(AR_Q), (unsigned char*)ARP(AR_K), (unsigned char*)ARP(AR_V), ARP(AR_QKVA), ap->in[15] + j * 192, (const float*)WSP(WS_ROPE), EPISCR};
              pg8::gemm_phase(RING, 256, 256, S, E); }
            PHASE_END(4);
            PROBE_CHECK(13 + 20 * j, ARP(AR_Q), (size_t)T * 1536, false); PROBE_CHECK(14 + 20 * j, ARP(AR_V), (size_t)T * 1024, false);
            if constexpr (PH(6)) _Pragma("unroll 1") for (int rep_ = 0; rep_ < REPS(6); ++rep_) { KArgs ap = ARGS(); MKFRAME(); bf16* AO = HP; const bf16* Qb = ARP(AR_Q); const unsigned char* K8 = (const unsigned char*)ARP(AR_K); const unsigned char* V8 = (const unsigned char*)ARP(AR_V); const float* gqn = ap->in[14] + j * 192; const float* ropeT = (const float*)WSP(WS_ROPE);
              const int nlat = NB * NH * 32, ntot = nlat + NB * NH;
              for (int u = F.vcu; u < ntot; u += F.G) {
                  __syncthreads();
                  if (u < nlat) { const int bh = u >> 5, qb = u & 31, b = bh >> 3, h = bh & 7; const size_t r0 = (size_t)b * SEQ, rc = (size_t)TL + (size_t)b * CTXL, rq = r0 + qb * 256;
                      const unsigned char* vbase = V8 + ((size_t)b * 132 * 8 + h) * 8192;
                      att8::attn_body(Qb + rq * 1536 + h * 192, K8 + r0 * 1536 + h * 192, vbase, K8 + rc * 1536 + h * 192, vbase + (size_t)128 * 65536, SEQ, SEQ + CTXL, AO + rq * 1024 + h * 128, (LAS char*)lds_raw, gqn, ropeT + (size_t)(qb * 256) * 64);
                  } else { const int bh = u - nlat, b = bh >> 3, h = bh & 7; const size_t rc = (size_t)TL + (size_t)b * CTXL;
                      const unsigned char* vbase = V8 + ((size_t)b * 132 * 8 + h) * 8192 + (size_t)128 * 65536;
                      att8::attn_body(Qb + rc * 1536 + h * 192, K8 + rc * 1536 + h * 192, vbase, K8 + rc * 1536 + h * 192, vbase, CTXL, CTXL, AO + rc * 1024 + h * 128, (LAS char*)lds_raw, gqn, nullptr);
                  }
              }
              __syncthreads(); }
            PHASE_END(6);
            PROBE_CHECK(17 + 20 * j, HP, (size_t)T * 1024, false);
            if constexpr (PH(7)) _Pragma("unroll 1") for (int rep_ = 0; rep_ < REPS(7); ++rep_) { KArgs ap = ARGS(); MKFRAME();
              const Split sp = make_split(T / 256 * 4, F.G, 8, false);
              SchedPlain S{(const char*)HP, (const char*)(WSMP + W_MLA + j * W_MLA_SZ + W_MLA_O), 2048, 2048, T / 256, 4, F.G, F.bx, 1 << 30, 16, sp};
              EpiResid E{{}, j == 0 ? ap->in[0] : nullptr, j == 0 ? ap->in[2] : nullptr, XBP, MODP(li) + 2 * 1024, (float*)ARP(AR_PART), 1.f};
              pg8::gemm_phase(RING, 1024, 1024, S, E);
              if (sp.Lf) { GRID_BAR(); reduce_resid(F, sp, T / 256, 4, (const float*)ARP(AR_PART), j == 0 ? ap->in[0] : nullptr, j == 0 ? ap->in[2] : nullptr, XBP, MODP(li) + 2 * 1024, 1.f); } }
            PHASE_END(7);
            PROBE_CHECK(18 + 20 * j, XLP, (size_t)TL * 1024, true); PROBE_CHECK(19 + 20 * j, XCP, (size_t)TC * 1024, true);
            if constexpr (PH(8)) _Pragma("unroll 1") for (int rep_ = 0; rep_ < REPS(8); ++rep_) { KArgs ap = ARGS(); MKFRAME();
              if ((FFN_F8_MASK >> j) & 1) norm_pass<false, 3, true>(F, nullptr, nullptr, XBP, T, ap->in[7] + li * 1024, MODP(li), 3, HP, nullptr, nullptr, nullptr, nullptr, nullptr);
              else norm_pass<false, 3, false>(F, nullptr, nullptr, XBP, T, ap->in[7] + li * 1024, MODP(li), 3, HP, nullptr, nullptr, nullptr, nullptr, nullptr); }
            PHASE_END(8);
            PROBE_CHECK(20 + 20 * j, HP, (size_t)T * 1024, false);
            if constexpr (PH(9)) _Pragma("unroll 1") for (int rep_ = 0; rep_ < REPS(9); ++rep_) { KArgs ap = ARGS(); MKFRAME();
              if ((FFN_F8_MASK >> j) & 1) {
                SchedPlain S{(const char*)HP, (const char*)(WSMP + W_FFN + j * W_FFN_SZ + W_FFN_13), 1024, 1024, T / 256, 22, F.G, F.bx, 1 << 30, 8, make_split(T / 256 * 22, F.G, 4, false)};
                EpiSwiglu8 E{{}, (unsigned char*)ARP(AR_HID), FF};
                pg8::gemm_phase_f8(RING, 1024, S, E);
              } else {
                SchedPlain S{(const char*)HP, (const char*)(WSMP + W_FFN + j * W_FFN_SZ + W_FFN_13), 2048, 2048, T / 256, 22, F.G, F.bx, 1 << 30, 16, make_split(T / 256 * 22, F.G, 8, false)};
                EpiSwiglu E{{}, ARP(AR_HID), FF};
                pg8::gemm_phase(RING, 1024, 1024, S, E);
              } }
            PHASE_END(9);
            PROBE_CHECK(21 + 20 * j, ARP(AR_HID), (size_t)T * FF, false);
            if constexpr (PH(10)) _Pragma("unroll 1") for (int rep_ = 0; rep_ < REPS(10); ++rep_) { KArgs ap = ARGS(); MKFRAME();
              if ((FFN_F8_MASK >> j) & 1) {
                const Split sp = make_split(T / 256 * 4, F.G, FF / 256, true);
                SchedPlain S{(const char*)ARP(AR_HID), (const char*)(WSMP + W_FFN + j * W_FFN_SZ + W_FFN_2), FF, FF, T / 256, 4, F.G, F.bx, 1 << 30, FF / 128, sp};
                EpiResid E{{}, nullptr, nullptr, XBP, MODP(li) + 5 * 1024, (float*)ARP(AR_PART), F8_INV};
                pg8::gemm_phase_f8(RING, FF, S, E);
                if (sp.Lf) { GRID_BAR(); reduce_resid(F, sp, T / 256, 4, (const float*)ARP(AR_PART), nullptr, nullptr, XBP, MODP(li) + 5 * 1024, F8_INV); }
              } else {
                const Split sp = make_split(T / 256 * 4, F.G, FF / 128, true);
                SchedPlain S{(const char*)ARP(AR_HID), (const char*)(WSMP + W_FFN + j * W_FFN_SZ + W_FFN_2), FF * 2, FF * 2, T / 256, 4, F.G, F.bx, 1 << 30, FF / 64, sp};
                EpiResid E{{}, nullptr, nullptr, XBP, MODP(li) + 5 * 1024, (float*)ARP(AR_PART), 1.f};
                pg8::gemm_phase(RING, FF, FF, S, E);
                if (sp.Lf) { GRID_BAR(); reduce_resid(F, sp, T / 256, 4, (const float*)ARP(AR_PART), nullptr, nullptr, XBP, MODP(li) + 5 * 1024, 1.f); }
              } }
            PHASE_END(10);
            PROBE_CHECK(22 + 20 * j, XLP, (size_t)TL * 1024, true);
        }
        {
            const int li = 2 * j + 1;
            const int nrows_out = li < 3 ? T : TL;
            if constexpr (PH(11)) _Pragma("unroll 1") for (int rep_ = 0; rep_ < REPS(11); ++rep_) { KArgs ap = ARGS(); MKFRAME(); norm_pass<false, 3>(F, nullptr, nullptr, XBP, T, ap->in[6] + li * 1024, MODP(li), 0, HP, nullptr, nullptr, nullptr, nullptr, nullptr); }
            PHASE_END(11);
            PROBE_CHECK(50 + 20 * j, HP, (size_t)T * 1024, false);
            if constexpr (PH(12)) _Pragma("unroll 1") for (int rep_ = 0; rep_ < REPS(12); ++rep_) { KArgs ap = ARGS(); MKFRAME();
              SchedPlain S{(const char*)HP, (const char*)(WSMP + W_RG + j * W_RG_SZ + W_RG_IG), 2048, 2048, T / 256, 8, F.G, F.bx, 4, 16, make_split(T / 256 * 8, F.G, 8, false)};
              EpiStoreUG E{{}, ARP(AR_UPRE), ARP(AR_GATE)};
              pg8::gemm_phase(RING, 1024, 1024, S, E); }
            PHASE_END(12);
            PROBE_CHECK(51 + 20 * j, ARP(AR_UPRE), (size_t)T * 1024, false); PROBE_CHECK(52 + 20 * j, ARP(AR_GATE), (size_t)T * 1024, false);
            if constexpr (PH(13)) _Pragma("unroll 1") for (int rep_ = 0; rep_ < REPS(13); ++rep_) { KArgs ap = ARGS(); MKFRAME(); conv_pass(F, T, ARP(AR_UPRE), ARP(AR_U), ap->in[19] + j * 4096, ap->in[20] + j * 1024); }
            PHASE_END(13);
            PROBE_CHECK(53 + 20 * j, ARP(AR_U), (size_t)T * 1024, false);
#define SCANFLAGS ((unsigned*)WSP(WS_CTL) + CW_SCANF + j * 2 * 264 * 8)
            if constexpr (PH(15)) _Pragma("unroll 1") for (int rep_ = 0; rep_ < REPS(15); ++rep_) { KArgs ap = ARGS(); MKFRAME();
              SchedScan S{(const char*)ARP(AR_U), (const char*)(WSMP + W_RG + j * W_RG_SZ + W_RG_AX), 0, F.G, F.bx};
              EpiScan<0> E{ARP(AR_U), ap->in[22] + j * 2048, ap->in[24] + j * 2048, (const float*)WSP(WS_SPT) + j * 2048, (float*)WSP(WS_AGG), SCANFLAGS, (unsigned*)WSP(WS_CTL) + CW_ERR, HP, ARP(AR_GATE), li < 3 ? 1 : 0, EPISCR};
              { LAS float* tab_ = (LAS float*)(EPISCR + 4096); const float* b0_ = ap->in[22] + j * 2048 + 0 * 1024; const float* b1_ = ap->in[24] + j * 2048 + 0 * 1024; const float* b2_ = (const float*)WSP(WS_SPT) + j * 2048 + 0 * 1024;
                for (int i_ = F.tid; i_ < 1024; i_ += NTHR) { tab_[i_] = b0_[i_]; tab_[1024 + i_] = b1_[i_]; tab_[2048 + i_] = b2_[i_]; }
                LDS_WAIT(); __syncthreads(); }
              pg8::gemm_phase(RING, 256, 256, S, E); }
            PHASE_END(15);
            if constexpr (PH(16)) _Pragma("unroll 1") for (int rep_ = 0; rep_ < REPS(16); ++rep_) { KArgs ap = ARGS(); MKFRAME();
              SchedScan S{(const char*)ARP(AR_U), (const char*)(WSMP + W_RG + j * W_RG_SZ + W_RG_AX), 1, F.G, F.bx};
              EpiScan<1> E{ARP(AR_U), ap->in[22] + j * 2048, ap->in[24] + j * 2048, (const float*)WSP(WS_SPT) + j * 2048, (float*)WSP(WS_AGG), SCANFLAGS, (unsigned*)WSP(WS_CTL) + CW_ERR, HP, ARP(AR_GATE), li < 3 ? 1 : 0, EPISCR};
              { LAS float* tab_ = (LAS float*)(EPISCR + 4096); const float* b0_ = ap->in[22] + j * 2048 + 1 * 1024; const float* b1_ = ap->in[24] + j * 2048 + 1 * 1024; const float* b2_ = (const float*)WSP(WS_SPT) + j * 2048 + 1 * 1024;
                for (int i_ = F.tid; i_ < 1024; i_ += NTHR) { tab_[i_] = b0_[i_]; tab_[1024 + i_] = b1_[i_]; tab_[2048 + i_] = b2_[i_]; }
                LDS_WAIT(); __syncthreads(); }
              pg8::gemm_phase(RING, 256, 256, S, E); }
            PHASE_END(16);
            if constexpr (PH(17)) _Pragma("unroll 1") for (int rep_ = 0; rep_ < REPS(17); ++rep_) { KArgs ap = ARGS(); MKFRAME();
              const Split sp = make_split(nrows_out / 256 * 4, F.G, 8, false);
              SchedPlain S{(const char*)HP, (const char*)(WSMP + W_RG + j * W_RG_SZ + W_RG_OUT), 2048, 2048, nrows_out / 256, 4, F.G, F.bx, 1 << 30, 16, sp};
              EpiResid E{{}, nullptr, nullptr, XBP, MODP(li) + 2 * 1024, (float*)ARP(AR_PART), 1.f};
              pg8::gemm_phase(RING, 1024, 1024, S, E);
              if (sp.Lf) { GRID_BAR(); reduce_resid(F, sp, nrows_out / 256, 4, (const float*)ARP(AR_PART), nullptr, nullptr, XBP, MODP(li) + 2 * 1024, 1.f); } }
            PHASE_END(17);
            PROBE_CHECK(57 + 20 * j, XLP, (size_t)TL * 1024, true);
#define CNTP ((unsigned*)WSP(WS_CTL) + CW_CNT + j * 16 * 64)
#define RTP(off) (WSP(WS_ROUTE) + (off))
            if constexpr (PH(18)) _Pragma("unroll 1") for (int rep_ = 0; rep_ < REPS(18); ++rep_) { KArgs ap = ARGS(); MKFRAME();
              norm_pass<true, 3>(F, nullptr, nullptr, XBP, nrows_out, ap->in[7] + li * 1024, MODP(li), 3, HP, ap->in[30] + (size_t)j * 1024 * 8, (unsigned*)RTP(RT_BLK), (int*)RTP(RT_E), (int*)RTP(RT_RANK), (float*)RTP(RT_G)); }
            PHASE_END(18);
            PROBE_CHECK(58 + 20 * j, HP, (size_t)nrows_out * 1024, false);
            if constexpr (PH(19)) _Pragma("unroll 1") for (int rep_ = 0; rep_ < REPS(19); ++rep_) { KArgs ap = ARGS(); MKFRAME(); moe_lists(F, nrows_out, CNTP, (const int*)RTP(RT_BLK), (const int*)RTP(RT_E), (const int*)RTP(RT_RANK), (const float*)RTP(RT_G), (int*)RTP(RT_TOK), (float*)RTP(RT_GV)); }
            PHASE_END(19);
#pragma unroll 1
            for (int s = 0; s < 2; ++s) {
                if constexpr (PH(20)) _Pragma("unroll 1") for (int rep_ = 0; rep_ < REPS(20); ++rep_) { KArgs ap = ARGS(); MKFRAME(); MoeTiles mt; moe_tiles(CNTP + 64 * 8 * s, mt);
                  SchedMoeUp S{(const char*)HP, (const char*)(WSP(WS_WMOE) + WM_13), (const int*)RTP(RT_TOK) + s * MOE_ROWS, mt, F.G, F.bx};
                  EpiSwiglu8 E{{}, (unsigned char*)ARP(AR_HID), EH};
                  pg8::gemm_phase_f8(RING, 1024, S, E); }
                PHASE_END(20);
                if constexpr (PH(21)) _Pragma("unroll 1") for (int rep_ = 0; rep_ < REPS(21); ++rep_) { KArgs ap = ARGS(); MKFRAME(); MoeTiles mt; moe_tiles(CNTP + 64 * 8 * s, mt);
                  const Split sp = make_split(mt.ts[NE] * 4, F.G, 14, true);
                  SchedMoeDown S{(const char*)ARP(AR_HID), (const char*)(WSP(WS_WMOE) + WM_2), mt, F.G, F.bx, sp};
                  EpiMoeDown E{{}, XBP, (li == 3 && s == 1) ? ap->out : nullptr, MODP(li) + 5 * 1024, (const int*)RTP(RT_TOK) + s * MOE_ROWS, (const float*)RTP(RT_GV) + s * MOE_ROWS, (float*)ARP(AR_PART)};
                  pg8::gemm_phase_f8(RING, EH, S, E);
                  if (sp.Lf) { GRID_BAR(); reduce_moe(F, sp, mt.ts[NE], (const float*)ARP(AR_PART), XBP, (li == 3 && s == 1) ? ap->out : nullptr, MODP(li) + 5 * 1024, (const int*)RTP(RT_TOK) + s * MOE_ROWS, (const float*)RTP(RT_GV) + s * MOE_ROWS); } }
                PHASE_END(21);
            PROBE_CHECK(60 + 20 * j + s, XLP, (size_t)TL * 1024, true);
            }
        }
    }
#ifdef TSEL
    {   KArgs ap = ARGS(); unsigned* w = (unsigned*)WSP(WS_CTL) + 24576;
        if (blockIdx.x == 0 && threadIdx.x == 0) __hip_atomic_store(w, MISC[16], __ATOMIC_RELAXED, __HIP_MEMORY_SCOPE_AGENT);
        GRID_BAR();
        const unsigned dur = __hip_atomic_load(w, __ATOMIC_RELAXED, __HIP_MEMORY_SCOPE_AGENT); const unsigned t0 = (unsigned)wall_clock64();
        while ((unsigned)wall_clock64() - t0 < dur) __builtin_amdgcn_s_sleep(8);
    }
#endif
#ifdef PROBE
    {
        KArgs ap = ARGS(); const unsigned w = *((volatile unsigned*)WSP(WS_CTL) + CW_PROBE); const int id = w ? 1000 - (int)w : 89;
        float* o = ap->out; const unsigned gt = blockIdx.x * NTHR + (unsigned)opaque_tid(), NGT = gridDim.x * NTHR;
        for (unsigned i = gt; i < (unsigned)TL * D; i += NGT) o[i] = (i == 0) ? (float)(10 + id) * 1.0e4f : 0.f;
    }
#endif
}

extern "C" void kernel_launch(void* const* d_in, const int* in_sizes, int n_in, void* d_out, int out_size, void* d_ws, size_t ws_size, hipStream_t stream) {
    static int grid = 0;
    if (grid == 0) {
        if (n_in != 34 || out_size != TL * D || ws_size < WS_END) { fprintf(stderr, "kernel_launch: unexpected shapes: n_in %d out %d ws %zu (need %zu)\n", n_in, out_size, ws_size, (size_t)WS_END); grid = -1; return; }
        int dev = 0, cus = 0, per_cu = 0;
        if (hipGetDevice(&dev) != hipSuccess || hipDeviceGetAttribute(&cus, hipDeviceAttributeMultiprocessorCount, dev) != hipSuccess) { grid = -1; return; }
        if (hipFuncSetAttribute((const void*)fwd_kernel, hipFuncAttributeMaxDynamicSharedMemorySize, LDS_BYTES) != hipSuccess) { fprintf(stderr, "kernel_launch: hipFuncSetAttribute failed\n"); grid = -1; return; }
        if (hipOccupancyMaxActiveBlocksPerMultiprocessor(&per_cu, (const void*)fwd_kernel, NTHR, LDS_BYTES) != hipSuccess || per_cu < 1) { fprintf(stderr, "kernel_launch: occupancy query says %d\n", per_cu); (void)hipGetLastError(); }
        grid = cus & ~7;
    }
    if (grid < 0) return;
    (void)hipMemsetAsync((char*)d_ws + WS_CTL, 0, CTL_BYTES, stream);
    Args a{};
    for (int i = 0; i < 34; ++i) a.in[i] = (const float*)d_in[i];
    a.out = (float*)d_out; a.ws = (unsigned char*)d_ws;
    hipLaunchKernelGGL(fwd_kernel, dim3(grid), dim3(NTHR), LDS_BYTES, stream, a);
    const hipError_t le = hipPeekAtLastError();
    if (le != hipSuccess) fprintf(stderr, "kernel_launch: launch failed: %s\n", hipGetErrorName(le));
}
```
